# Optimizing an MI355X kernel written in HIP

```python
import math
import jax, jax.numpy as jnp
from jax import lax
import numpy as np

D_MODEL = 1024
BATCH = 4
SEQ = 4096
DEPTH = 4

GRID_W = 64
EPS = 1e-6
NA_HEADS = 8
NA_HEAD_DIM = 64
NA_WIN_R = 8
NA_WIN_C = 16
NA_QCOLS = 16
NA_KCOLS = 2 * NA_WIN_C
GLA_HEADS = 4
GLA_DK = 64
GLA_DV = 128
GLA_GATE_RANK = 16
GLA_GATE_TAU = 16.0
GLA_CHUNK = 64
MLA_HEADS = 4
MLA_Q_RANK = 256
MLA_KV_RANK = 256
MLA_NOPE = 128
MLA_ROPE = 64
MLA_V = 128
MLA_QBLOCK = 128
ROPE_THETA = 10000.0
D_FF = 2816
N_BRANCH = 3
NA_W = NA_HEADS * NA_HEAD_DIM
GLA_QK_W = GLA_HEADS * GLA_DK
GLA_V_W = GLA_HEADS * GLA_DV
MLA_QK_HEAD = MLA_NOPE + MLA_ROPE
MLA_V_W = MLA_HEADS * MLA_V
IN_SPLITS = (NA_W, NA_W, NA_W,
             GLA_QK_W, GLA_QK_W, GLA_V_W, GLA_V_W, GLA_GATE_RANK, GLA_GATE_RANK,
             MLA_Q_RANK, MLA_KV_RANK, MLA_ROPE,
             N_BRANCH * D_MODEL)
D_IN = 6752

kernel_name = "hybrid_na_gla_mla_macaron_encoder"


def rms_norm(x, g):
    xf = x.astype(jnp.float32)
    y = xf * lax.rsqrt(jnp.mean(xf * xf, axis=-1, keepdims=True) + EPS)
    return (y * g.astype(jnp.float32)).astype(x.dtype)


def swiglu(h, w1, w3, w2):
    return (jax.nn.silu(h @ w1) * (h @ w3)) @ w2


def split_cols(z, sizes):
    out, start = [], 0
    for n in sizes:
        out.append(z[..., start:start + n])
        start += n
    return out


def neighborhood_attention(q, k, v, rpb):
    B, S, H, d = q.shape
    rows = S // GRID_W
    win_r = min(NA_WIN_R, rows)
    nj = GRID_W // NA_QCOLS
    r = np.arange(rows)
    r0 = np.clip(r - win_r // 2, 0, rows - win_r)
    ridx = r0[:, None] + np.arange(win_r)
    j = np.arange(nj)
    k0 = np.clip(j * NA_QCOLS - NA_WIN_C // 2, 0, GRID_W - NA_KCOLS)
    cidx = k0[:, None] + np.arange(NA_KCOLS)
    qc = j[:, None] * NA_QCOLS + np.arange(NA_QCOLS)
    c0 = np.clip(qc - NA_WIN_C // 2, 0, GRID_W - NA_WIN_C)
    col_ok = (cidx[:, None, :] >= c0[..., None]) & (cidx[:, None, :] < c0[..., None] + NA_WIN_C)
    mask = np.broadcast_to(col_ok[:, :, None, :], (nj, NA_QCOLS, win_r, NA_KCOLS)).reshape(nj, NA_QCOLS, win_r * NA_KCOLS)
    dr = ridx - r[:, None] + (NA_WIN_R - 1)
    dc = np.clip(cidx[:, None, :] - qc[:, :, None] + (NA_WIN_C - 1), 0, 2 * NA_WIN_C - 2)
    bias = rpb[:, dr[:, None, None, :, None], dc[None, :, :, None, :]]
    bias = bias.reshape(H, rows, nj, NA_QCOLS, win_r * NA_KCOLS)

    ri = ridx[:, None, :, None]
    ci = cidx[None, :, None, :]
    kg = k.reshape(B, rows, GRID_W, H, d)[:, ri, ci].reshape(B, rows, nj, win_r * NA_KCOLS, H, d)
    vg = v.reshape(B, rows, GRID_W, H, d)[:, ri, ci].reshape(B, rows, nj, win_r * NA_KCOLS, H, d)
    qg = q.reshape(B, rows, nj, NA_QCOLS, H, d)
    s = jnp.einsum('brjqhd,brjkhd->bhrjqk', qg, kg).astype(jnp.float32) * (d ** -0.5)
    s = jnp.where(mask, s + bias.astype(jnp.float32), -1e30)
    p = jax.nn.softmax(s, axis=-1).astype(v.dtype)
    o = jnp.einsum('bhrjqk,brjkhd->brjqhd', p, vg)
    return o.reshape(B, S, H * d)


def gla_chunked(q, k, v, g, strict):
    B, H, S, dk = q.shape
    dv = v.shape[-1]
    n = S // GLA_CHUNK
    q = q.reshape(B, H, n, GLA_CHUNK, dk)
    k = k.reshape(B, H, n, GLA_CHUNK, dk)
    g = g.reshape(B, H, n, GLA_CHUNK, dk)
    v = v.reshape(B, H, n, GLA_CHUNK, dv)
    b = jnp.cumsum(g, axis=3)
    b_last = b[:, :, :, -1:, :]
    qe = q * jnp.exp(b)
    ke = k * jnp.exp(-b)
    k_end = k * jnp.exp(b_last - b)
    tri = np.tril(np.ones((GLA_CHUNK, GLA_CHUNK), dtype=bool), -1 if strict else 0)
    a = jnp.where(tri, jnp.einsum('bhnid,bhnjd->bhnij', qe, ke), 0.0)
    o_intra = jnp.einsum('bhnij,bhnjv->bhniv', a, v)
    upd = jnp.einsum('bhncd,bhncv->bhndv', k_end, v)
    decay = jnp.exp(b_last[:, :, :, 0, :])

    def step(state, inp):
        dec, u = inp
        return dec[..., None] * state + u, state

    init = jnp.zeros((B, H, dk, dv), q.dtype)
    _, s_prev = lax.scan(step, init, (jnp.moveaxis(decay, 2, 0), jnp.moveaxis(upd, 2, 0)))
    s_prev = jnp.moveaxis(s_prev, 0, 2)
    o = o_intra + jnp.einsum('bhnid,bhndv->bhniv', qe, s_prev)
    return o.reshape(B, H, S, dv)


def gla_bidirectional(q, k, v, g_fwd, g_bwd):
    t = lambda a: jnp.swapaxes(a.astype(jnp.float32), 1, 2)
    q, k, v, g_fwd, g_bwd = t(q), t(k), t(v), t(g_fwd), t(g_bwd)
    q = q * (GLA_DK ** -0.5)
    flip = lambda a: a[:, :, ::-1]
    o_f = gla_chunked(q, k, v, g_fwd, False)
    o_b = flip(gla_chunked(flip(q), flip(k), flip(v), flip(g_bwd), True))
    return jnp.swapaxes(o_f + o_b, 1, 2)


def rope_tables(S):
    half = MLA_ROPE // 2
    inv = ROPE_THETA ** (-jnp.arange(half, dtype=jnp.float32) / half)
    ang = jnp.arange(S, dtype=jnp.float32)[:, None] * inv[None, :]
    return jnp.cos(ang), jnp.sin(ang)


def apply_rope(x, cos, sin):
    xf = x.astype(jnp.float32)
    x1, x2 = xf[..., :MLA_ROPE // 2], xf[..., MLA_ROPE // 2:]
    c, s = cos[None, :, None, :], sin[None, :, None, :]
    return jnp.concatenate([x1 * c - x2 * s, x1 * s + x2 * c], axis=-1).astype(x.dtype)


def blocked_softmax_attention(q, k, v, scale):
    B, S, H, dq = q.shape
    nb = S // MLA_QBLOCK
    qb = jnp.moveaxis(q.reshape(B, nb, MLA_QBLOCK, H, dq), 1, 0)

    def one(qblk):
        s = jnp.einsum('bqhd,bkhd->bhqk', qblk, k).astype(jnp.float32) * scale
        p = jax.nn.softmax(s, axis=-1).astype(v.dtype)
        return jnp.einsum('bhqk,bkhd->bqhd', p, v)

    o = lax.map(one, qb)
    return jnp.moveaxis(o, 0, 1).reshape(B, S, H * v.shape[-1])


def mla_attention(c_q, c_kv, k_rope, cq_norm, ckv_norm, w_uq, w_ukv, q_norm, k_norm, cos, sin):
    B, S, _ = c_q.shape
    q = (rms_norm(c_q, cq_norm) @ w_uq).reshape(B, S, MLA_HEADS, MLA_QK_HEAD)
    kv = (rms_norm(c_kv, ckv_norm) @ w_ukv).reshape(B, S, MLA_HEADS, MLA_NOPE + MLA_V)
    k_nope, v = kv[..., :MLA_NOPE], kv[..., MLA_NOPE:]
    k_r = jnp.broadcast_to(k_rope[:, :, None, :], (B, S, MLA_HEADS, MLA_ROPE))
    k = jnp.concatenate([k_nope, k_r], axis=-1)
    q = rms_norm(q, q_norm)
    k = rms_norm(k, k_norm)
    q = jnp.concatenate([q[..., :MLA_NOPE], apply_rope(q[..., MLA_NOPE:], cos, sin)], axis=-1)
    k = jnp.concatenate([k[..., :MLA_NOPE], apply_rope(k[..., MLA_NOPE:], cos, sin)], axis=-1)
    return blocked_softmax_attention(q, k, v, MLA_QK_HEAD ** -0.5)


def setup_inputs(seed: int = 0) -> dict:
    key = jax.random.key(seed)
    ks = iter(jax.random.split(key, 32))
    L = DEPTH
    f32 = jnp.float32

    def w(shape, fan_in):
        return jax.random.normal(next(ks), shape, f32) * (fan_in ** -0.5)

    def gain(shape):
        return 1.0 + 0.05 * jax.random.normal(next(ks), shape, f32)

    def small(shape, scale, offset=0.0):
        return offset + scale * jax.random.normal(next(ks), shape, f32)

    return {
        "x": jax.random.normal(next(ks), (BATCH, SEQ, D_MODEL), f32),
        "ffn1_norm": gain((L, D_MODEL)),
        "ffn1_w1": w((L, D_MODEL, D_FF), D_MODEL),
        "ffn1_w3": w((L, D_MODEL, D_FF), D_MODEL),
        "ffn1_w2": w((L, D_FF, D_MODEL), D_FF),
        "mix_norm": gain((L, D_MODEL)),
        "w_in": w((L, D_MODEL, D_IN), D_MODEL),
        "na_q_norm": gain((L, NA_HEAD_DIM)),
        "na_k_norm": gain((L, NA_HEAD_DIM)),
        "na_rpb": small((L, NA_HEADS, 2 * NA_WIN_R - 1, 2 * NA_WIN_C - 1), 0.1),
        "gla_gf_up": w((L, GLA_GATE_RANK, GLA_QK_W), GLA_GATE_RANK),
        "gla_gf_bias": small((L, GLA_QK_W), 0.1, 2.0),
        "gla_gb_up": w((L, GLA_GATE_RANK, GLA_QK_W), GLA_GATE_RANK),
        "gla_gb_bias": small((L, GLA_QK_W), 0.1, 2.0),
        "gla_out_norm": gain((L, GLA_DV)),
        "mla_cq_norm": gain((L, MLA_Q_RANK)),
        "mla_ckv_norm": gain((L, MLA_KV_RANK)),
        "mla_w_uq": w((L, MLA_Q_RANK, MLA_HEADS * MLA_QK_HEAD), MLA_Q_RANK),
        "mla_w_ukv": w((L, MLA_KV_RANK, MLA_HEADS * (MLA_NOPE + MLA_V)), MLA_KV_RANK),
        "mla_q_norm": gain((L, MLA_QK_HEAD)),
        "mla_k_norm": gain((L, MLA_QK_HEAD)),
        "w_br_na": w((L, NA_W, D_MODEL), NA_W),
        "w_br_gla": w((L, GLA_V_W, D_MODEL), GLA_V_W),
        "w_br_mla": w((L, MLA_V_W, D_MODEL), MLA_V_W),
        "w_out": w((L, D_MODEL, D_MODEL), D_MODEL),
        "ffn2_norm": gain((L, D_MODEL)),
        "ffn2_w1": w((L, D_MODEL, D_FF), D_MODEL),
        "ffn2_w3": w((L, D_MODEL, D_FF), D_MODEL),
        "ffn2_w2": w((L, D_FF, D_MODEL), D_FF),
    }


def reference(x, ffn1_norm, ffn1_w1, ffn1_w3, ffn1_w2, mix_norm, w_in,
              na_q_norm, na_k_norm, na_rpb,
              gla_gf_up, gla_gf_bias, gla_gb_up, gla_gb_bias, gla_out_norm,
              mla_cq_norm, mla_ckv_norm, mla_w_uq, mla_w_ukv, mla_q_norm, mla_k_norm,
              w_br_na, w_br_gla, w_br_mla, w_out,
              ffn2_norm, ffn2_w1, ffn2_w3, ffn2_w2):
    B, S, D = x.shape
    cos, sin = rope_tables(S)
    for l in range(DEPTH):
        x = x + 0.5 * swiglu(rms_norm(x, ffn1_norm[l]), ffn1_w1[l], ffn1_w3[l], ffn1_w2[l])

        h = rms_norm(x, mix_norm[l])
        z = h @ w_in[l]
        (na_q, na_k, na_v, gq, gk, gv, gr, gfl, gbl, c_q, c_kv, k_rope, gates) = split_cols(z, IN_SPLITS)

        qa = rms_norm(na_q.reshape(B, S, NA_HEADS, NA_HEAD_DIM), na_q_norm[l])
        ka = rms_norm(na_k.reshape(B, S, NA_HEADS, NA_HEAD_DIM), na_k_norm[l])
        va = na_v.reshape(B, S, NA_HEADS, NA_HEAD_DIM)
        y_na = neighborhood_attention(qa, ka, va, na_rpb[l])

        g_f = jax.nn.log_sigmoid((gfl @ gla_gf_up[l] + gla_gf_bias[l]).astype(jnp.float32)) / GLA_GATE_TAU
        g_b = jax.nn.log_sigmoid((gbl @ gla_gb_up[l] + gla_gb_bias[l]).astype(jnp.float32)) / GLA_GATE_TAU
        o_gla = gla_bidirectional(gq.reshape(B, S, GLA_HEADS, GLA_DK), gk.reshape(B, S, GLA_HEADS, GLA_DK),
                                  gv.reshape(B, S, GLA_HEADS, GLA_DV),
                                  g_f.reshape(B, S, GLA_HEADS, GLA_DK), g_b.reshape(B, S, GLA_HEADS, GLA_DK))
        o_gla = rms_norm(o_gla, gla_out_norm[l]).astype(x.dtype).reshape(B, S, GLA_V_W)
        y_gla = o_gla * jax.nn.silu(gr)

        y_mla = mla_attention(c_q, c_kv, k_rope, mla_cq_norm[l], mla_ckv_norm[l], mla_w_uq[l], mla_w_ukv[l],
                              mla_q_norm[l], mla_k_norm[l], cos, sin)

        gt = jax.nn.sigmoid(gates.reshape(B, S, N_BRANCH, D))
        mixed = (gt[:, :, 0] * (y_na @ w_br_na[l])
                 + gt[:, :, 1] * (y_gla @ w_br_gla[l])
                 + gt[:, :, 2] * (y_mla @ w_br_mla[l]))
        x = x + mixed @ w_out[l]

        x = x + 0.5 * swiglu(rms_norm(x, ffn2_norm[l]), ffn2_w1[l], ffn2_w3[l], ffn2_w2[l])
    return x
```

```cpp
#include <hip/hip_runtime.h>
#include <hip/hip_cooperative_groups.h>
#include <cstdio>
#include <cstdint>
namespace cg = cooperative_groups;

namespace pg8 {
#define PG8_LAS __attribute__((address_space(3)))
typedef unsigned short bf16_t;
typedef short bf16x8 __attribute__((ext_vector_type(8)));
typedef float f32x4 __attribute__((ext_vector_type(4)));
typedef unsigned u32x4 __attribute__((ext_vector_type(4)));
typedef unsigned u32x2 __attribute__((ext_vector_type(2)));
constexpr int BM = 256, BK = 64, HALF = 128, HTB = HALF * BK * 2  , STAGE_BYTES = 8 * HTB, NXCD = 8, WGM = 8;

__host__ __device__ __forceinline__ int lds_byte(int r, int c) { const int st = (r >> 4) * 2 + (c >> 5), rr = r & 15, cc = c & 31, ob = rr * 64 + cc * 2; return st * 1024 + (ob ^ (((ob >> 9) & 1) << 5)); }
__host__ __device__ __forceinline__ void stage_rc(int b, int& R, int& C) { const int st = b / 1024, sb = b % 1024, swz = sb ^ (((sb >> 9) & 1) << 5); R = (st >> 1) * 16 + swz / 64; C = (st & 1) * 32 + (swz % 64) / 2; }
__host__ __device__ __forceinline__ int perm32(int rho) { const int n = rho >> 4, i = rho & 15; return 8 * (i >> 2) + 4 * n + (i & 3); }

struct Unit { int pm, pn; };
struct Gemm { const bf16_t* A; const bf16_t* Bt; int M, N, K, lda, ldb; };

struct StaticOrder {
    int nM, nN, nwg, G, c;
    __host__ __device__ void init(int M, int N, int G_, int c_) { nM = M / BM; nN = N / BM; nwg = nM * nN; G = G_; c = c_; }
    __host__ __device__ __forceinline__ bool next(int i, Unit& u) const {
        const long L = (long)i * G + c; if (L >= nwg) return false;
        int wgid = (int)L; { const int q = nwg / NXCD, r = nwg % NXCD, xcd = wgid % NXCD, off = wgid / NXCD; wgid = (xcd < r ? xcd * (q + 1) : r * (q + 1) + (xcd - r) * q) + off; }
        const int nig = WGM * nN, gid = wgid / nig, fm = gid * WGM, gsz = (nM - fm) < WGM ? (nM - fm) : WGM;
        u.pm = fm + ((wgid % nig) % gsz); u.pn = (wgid % nig) / gsz; return true;
    }
    __device__ __forceinline__ size_t aoff(const Unit& u, const Gemm& g) const { return (size_t)u.pm * BM * g.lda * 2; }
    __device__ __forceinline__ size_t boff(const Unit& u, const Gemm& g) const { return (size_t)u.pn * BM * g.ldb * 2; }
    __device__ __forceinline__ void a_ready(const Unit&) const {}
    __device__ __forceinline__ void done(const Unit&) const {}
};
struct MergeOrder {
    int G, c; int acol0, acol1, acol2;
    __device__ __forceinline__ bool next(int k, Unit& u) const { const int t = c + (k / 3) * G; if (t >= 256) return false; const int i = k % 3; u.pm = i * 64 + (t >> 2); u.pn = i * 4 + (t & 3); return true; }
    __device__ __forceinline__ size_t aoff(const Unit& u, const Gemm& g) const { const int i = u.pm >> 6; const int ac = acol0 + i * (acol1 - acol0) + (i >> 1) * (acol2 - 2 * acol1 + acol0); return ((size_t)(u.pm & 63) * BM * g.lda + ac) * 2; }
    __device__ __forceinline__ size_t boff(const Unit& u, const Gemm& g) const { return (size_t)u.pn * BM * g.ldb * 2; }
    __device__ __forceinline__ void a_ready(const Unit&) const {}
    __device__ __forceinline__ void done(const Unit&) const {}
};

__device__ __forceinline__ unsigned cvt_pk_bf16(float lo, float hi) { unsigned r; asm volatile("v_cvt_pk_bf16_f32 %0, %1, %2" : "=v"(r) : "v"(lo), "v"(hi)); return r; }
__device__ __forceinline__ float bflo(unsigned w) { return __builtin_bit_cast(float, w << 16); }
__device__ __forceinline__ float bfhi(unsigned w) { return __builtin_bit_cast(float, w & 0xffff0000u); }
__device__ __forceinline__ float fsigmoid(float x) { return __builtin_amdgcn_rcpf(1.0f + __builtin_amdgcn_exp2f(-1.4426950408889634f * x)); }

struct EpiBf16 {
    static constexpr bool PERM = true, AFTER_DRAIN = false;
    bf16_t* O; int ldc;
    __device__ __forceinline__ void operator()(const f32x4 (&acc)[2][2][4][2], const Unit& u, int wr, int wc, int fr, int fq) const {
        const int row0 = u.pm * BM + wr * 64 + fr; const int col0 = u.pn * BM + wc * 32 + 8 * fq;
#pragma unroll
        for (int ai = 0; ai < 2; ++ai)
#pragma unroll
            for (int m = 0; m < 4; ++m) { bf16_t* rowp = O + (size_t)(row0 + ai * HALF + m * 16) * ldc + col0;
#pragma unroll
                for (int bj = 0; bj < 2; ++bj) { const f32x4 v0 = acc[ai][bj][m][0], v1 = acc[ai][bj][m][1];
                    u32x4 w; w.x = cvt_pk_bf16(v0[0], v0[1]); w.y = cvt_pk_bf16(v0[2], v0[3]); w.z = cvt_pk_bf16(v1[0], v1[1]); w.w = cvt_pk_bf16(v1[2], v1[3]);
                    *(u32x4*)(rowp + bj * HALF) = w; } }
    }
};
struct EpiSwiGLU {
    static constexpr bool PERM = true, AFTER_DRAIN = false;
    bf16_t* O; int ldc;
    __device__ __forceinline__ void operator()(const f32x4 (&acc)[2][2][4][2], const Unit& u, int wr, int wc, int fr, int fq) const {
        const int row0 = u.pm * BM + wr * 64 + fr; const int col0 = u.pn * HALF + wc * 32 + 8 * fq;
#pragma unroll
        for (int ai = 0; ai < 2; ++ai)
#pragma unroll
            for (int m = 0; m < 4; ++m) { bf16_t* rowp = O + (size_t)(row0 + ai * HALF + m * 16) * ldc + col0;
                float h[8];
#pragma unroll
                for (int n = 0; n < 2; ++n)
#pragma unroll
                    for (int j = 0; j < 4; ++j) { const float gt = acc[ai][0][m][n][j], up = acc[ai][1][m][n][j]; h[4 * n + j] = gt * fsigmoid(gt) * up; }
                u32x4 w; w.x = cvt_pk_bf16(h[0], h[1]); w.y = cvt_pk_bf16(h[2], h[3]); w.z = cvt_pk_bf16(h[4], h[5]); w.w = cvt_pk_bf16(h[6], h[7]);
                *(u32x4*)rowp = w; }
    }
};
struct EpiResid {
    static constexpr bool PERM = false, AFTER_DRAIN = false;
    const float* base; float* out; int ldc; float alpha;
    __device__ __forceinline__ void operator()(const f32x4 (&acc)[2][2][4][2], const Unit& u, int wr, int wc, int fr, int fq) const {
        const int row0 = u.pm * BM + wr * 64 + fr, col0 = u.pn * BM + wc * 32 + 4 * fq;
#pragma unroll
        for (int ai = 0; ai < 2; ++ai)
#pragma unroll
            for (int m = 0; m < 4; ++m) { const size_t off = (size_t)(row0 + ai * HALF + m * 16) * ldc + col0;
#pragma unroll
                for (int bj = 0; bj < 2; ++bj)
#pragma unroll
                    for (int n = 0; n < 2; ++n) { const f32x4 b = *(const f32x4*)(base + off + bj * HALF + n * 16); *(f32x4*)(out + off + bj * HALF + n * 16) = b + acc[ai][bj][m][n] * alpha; } }
    }
};
struct EpiMerge {
    static constexpr bool PERM = false, AFTER_DRAIN = false;
    const bf16_t* Z; int ldz, gcol; float* MIXF; bf16_t* MIXB;
    __device__ __forceinline__ void operator()(const f32x4 (&acc)[2][2][4][2], const Unit& u, int wr, int wc, int fr, int fq) const {
        const int i = u.pm >> 6, pm = u.pm & 63, pn = u.pn & 3;
        const int row0 = pm * BM + wr * 64 + fr, col0 = pn * BM + wc * 32 + 4 * fq;
#pragma unroll
        for (int ai = 0; ai < 2; ++ai)
#pragma unroll
            for (int m = 0; m < 4; ++m) { const int row = row0 + ai * HALF + m * 16;
#pragma unroll
                for (int bj = 0; bj < 2; ++bj)
#pragma unroll
                    for (int n = 0; n < 2; ++n) { const int col = col0 + bj * HALF + n * 16;
                        const u32x2 gw = *(const u32x2*)(Z + (size_t)row * ldz + gcol + i * 1024 + col);
                        f32x4 v = acc[ai][bj][m][n];
                        v[0] *= fsigmoid(bflo(gw.x)); v[1] *= fsigmoid(bfhi(gw.x)); v[2] *= fsigmoid(bflo(gw.y)); v[3] *= fsigmoid(bfhi(gw.y));
                        float* mp = MIXF + (size_t)row * 1024 + col;
                        if (i == 0) { *(f32x4*)mp = v; }
                        else if (i == 1) { *(f32x4*)mp = *(const f32x4*)mp + v; }
                        else { v = *(const f32x4*)mp + v; u32x2 w; w.x = cvt_pk_bf16(v[0], v[1]); w.y = cvt_pk_bf16(v[2], v[3]); *(u32x2*)(MIXB + (size_t)row * 1024 + col) = w; } } }
    }
};

template <class Epi, class Sched, bool ALIGN_EPI = false, bool SP2 = false>
__device__ __forceinline__ void gemm_phase(PG8_LAS unsigned char* lds, const Gemm g, const Sched& S, const Epi& E) {
    int tid_o = threadIdx.x; asm volatile("" : "+v"(tid_o)); const int tid = tid_o, wid = __builtin_amdgcn_readfirstlane(tid >> 6), lane = tid & 63, wr = wid >> 2, wc = wid & 3, fr = lane & 15, fq = lane >> 4;
    const int K = g.K, nt = K / BK;
    unsigned voffA[2], voffB[2];
#pragma unroll
    for (int i = 0; i < 2; ++i) { int R, C; stage_rc(tid * 16 + i * 8192, R, C); const int Rb = Epi::PERM ? ((R & ~31) + perm32(R & 31)) : R;
        voffA[i] = (unsigned)(R * g.lda + C) * 2u; voffB[i] = (unsigned)(Rb * g.ldb + C) * 2u; }
    const size_t kstep = (size_t)(BK * 2);
    const size_t hstepA = (size_t)HALF * g.lda * 2, hstepB = (size_t)HALF * g.ldb * 2;
    const unsigned ldsw = (unsigned)wid * 1024u;
    const int aoff = lds_byte(wr * 64 + fr, fq * 8), boff = lds_byte(wc * 32 + fr, fq * 8);
#define PG8_SA(b, h) (((b) * 2 + (h)) * HTB)
#define PG8_SB(b, h) ((4 + (b) * 2 + (h)) * HTB)
#define PG8_STAGE(bufoff, gbase, voff) do { _Pragma("unroll") for (int _i = 0; _i < 2; ++_i) \
        __builtin_amdgcn_global_load_lds((const unsigned*)((const char*)(gbase) + (voff)[_i]), (PG8_LAS unsigned*)(lds + (bufoff) + ldsw + _i * 8192), 16, 0, 0); } while (0)
#define PG8_LDA(dst, b, h) do { _Pragma("unroll") for (int m = 0; m < 4; ++m) _Pragma("unroll") for (int k = 0; k < 2; ++k) dst[m][k] = *(const PG8_LAS bf16x8*)(lds + PG8_SA(b, h) + aoff + m * 2048 + k * 1024); } while (0)
#define PG8_LDB(dst, b, h) do { _Pragma("unroll") for (int n = 0; n < 2; ++n) _Pragma("unroll") for (int k = 0; k < 2; ++k) dst[n][k] = *(const PG8_LAS bf16x8*)(lds + PG8_SB(b, h) + boff + n * 2048 + k * 1024); } while (0)
#define PG8_MMA(ai, bj, At, Bt) do { __builtin_amdgcn_s_setprio(1); _Pragma("unroll") for (int m = 0; m < 4; ++m) _Pragma("unroll") for (int n = 0; n < 2; ++n) _Pragma("unroll") for (int k = 0; k < 2; ++k) \
        acc[ai][bj][m][n] = __builtin_amdgcn_mfma_f32_16x16x32_bf16(Bt[n][k], At[m][k], acc[ai][bj][m][n], 0, 0, 0); __builtin_amdgcn_s_setprio(0); } while (0)
#define PG8_WAIT_V(n) asm volatile("s_waitcnt vmcnt(" #n ")" ::: "memory")
#define PG8_WAIT_L(n) asm volatile("s_waitcnt lgkmcnt(" #n ")" ::: "memory")
#define PG8_BAR __builtin_amdgcn_s_barrier()
#define PG8_SCHED __builtin_amdgcn_sched_barrier(0)
    Unit cur, nxt; int ui = 0;
    if (!S.next(0, cur)) return;
    f32x4 acc[2][2][4][2];
#pragma unroll
    for (int a = 0; a < 2; ++a)
#pragma unroll
        for (int b = 0; b < 2; ++b)
#pragma unroll
            for (int m = 0; m < 4; ++m)
#pragma unroll
                for (int n = 0; n < 2; ++n) acc[a][b][m][n] = (f32x4){0.f, 0.f, 0.f, 0.f};
    bf16x8 At[4][2], B0[2][2], B1[2][2];
    const char* cA = (const char*)g.A + S.aoff(cur, g); const char* cB = (const char*)g.Bt + S.boff(cur, g);
    S.a_ready(cur);
    if constexpr (SP2) {
        PG8_STAGE(PG8_SB(0, 0), cB, voffB); PG8_STAGE(PG8_SB(0, 1), cB + hstepB, voffB); PG8_STAGE(PG8_SA(0, 0), cA, voffA); PG8_STAGE(PG8_SA(0, 1), cA + hstepA, voffA);
        if (wr == 1) PG8_BAR;
        PG8_WAIT_V(2); PG8_BAR;
        PG8_STAGE(PG8_SB(1, 0), cB + kstep, voffB); PG8_STAGE(PG8_SA(1, 0), cA + kstep, voffA); PG8_STAGE(PG8_SB(1, 1), cB + hstepB + kstep, voffB);
        PG8_WAIT_V(6); PG8_BAR;
    } else {
        PG8_STAGE(PG8_SB(0, 0), cB, voffB); PG8_STAGE(PG8_SA(0, 0), cA, voffA); PG8_STAGE(PG8_SB(0, 1), cB + hstepB, voffB); PG8_STAGE(PG8_SA(0, 1), cA + hstepA, voffA);
        if (wr == 1) PG8_BAR;
        PG8_WAIT_V(4); PG8_BAR;
        PG8_STAGE(PG8_SB(1, 0), cB + kstep, voffB); PG8_STAGE(PG8_SA(1, 0), cA + kstep, voffA); PG8_STAGE(PG8_SB(1, 1), cB + hstepB + kstep, voffB);
        PG8_WAIT_V(6); PG8_BAR;
    }
    for (;;) {
        const bool has_next = S.next(ui + 1, nxt);
        const char* nA = has_next ? (const char*)g.A + S.aoff(nxt, g) : cA; const char* nB = has_next ? (const char*)g.Bt + S.boff(nxt, g) : cB;
        for (int t = 0; t < nt; t += 2) {
            const bool last = (t == nt - 2);
            const char* a1 = cA + (size_t)(t + 1) * kstep;
            const char* a2 = last ? nA : cA + (size_t)(t + 2) * kstep; const char* b2 = last ? nB : cB + (size_t)(t + 2) * kstep;
            const char* a3 = a2 + kstep; const char* b3 = b2 + kstep;
            if (last && has_next) S.a_ready(nxt);
            if constexpr (SP2) {
            PG8_LDB(B0, 0, 0); PG8_LDB(B1, 0, 1); PG8_SCHED; PG8_LDA(At, 0, 0); PG8_STAGE(PG8_SA(1, 1), a1 + hstepA, voffA);
            PG8_WAIT_V(8); PG8_WAIT_L(0); PG8_BAR; PG8_MMA(0, 0, At, B0); PG8_MMA(0, 1, At, B1); PG8_BAR; PG8_SCHED;
            PG8_LDA(At, 0, 1); PG8_STAGE(PG8_SB(0, 0), b2, voffB); PG8_STAGE(PG8_SB(0, 1), b2 + hstepB, voffB); PG8_STAGE(PG8_SA(0, 0), a2, voffA);
            PG8_WAIT_V(8); PG8_WAIT_L(0); PG8_BAR; PG8_MMA(1, 0, At, B0); PG8_MMA(1, 1, At, B1); PG8_BAR; PG8_SCHED;
            PG8_LDB(B0, 1, 0); PG8_LDB(B1, 1, 1); PG8_SCHED; PG8_LDA(At, 1, 0); PG8_STAGE(PG8_SA(0, 1), a2 + hstepA, voffA);
            PG8_WAIT_V(8); PG8_WAIT_L(0); PG8_BAR; PG8_MMA(0, 0, At, B0); PG8_MMA(0, 1, At, B1); PG8_BAR; PG8_SCHED;
            PG8_LDA(At, 1, 1); PG8_STAGE(PG8_SB(1, 0), b3, voffB); PG8_STAGE(PG8_SB(1, 1), b3 + hstepB, voffB); PG8_STAGE(PG8_SA(1, 0), a3, voffA);
            PG8_WAIT_V(8); PG8_WAIT_L(0); PG8_BAR; PG8_MMA(1, 0, At, B0); PG8_MMA(1, 1, At, B1); PG8_BAR; PG8_SCHED;
            } else {
            PG8_LDB(B0, 0, 0); PG8_SCHED; PG8_LDA(At, 0, 0); PG8_STAGE(PG8_SA(1, 1), a1 + hstepA, voffA);
            PG8_WAIT_L(8); PG8_BAR; PG8_WAIT_L(0); PG8_MMA(0, 0, At, B0); PG8_BAR; PG8_SCHED;
            PG8_LDB(B1, 0, 1); PG8_STAGE(PG8_SB(0, 0), b2, voffB);
            PG8_BAR; PG8_WAIT_L(0); PG8_MMA(0, 1, At, B1); PG8_BAR;
            PG8_LDA(At, 0, 1); PG8_STAGE(PG8_SA(0, 0), a2, voffA);
            PG8_BAR; PG8_WAIT_L(0); PG8_MMA(1, 0, At, B0); PG8_BAR; PG8_SCHED;
            PG8_STAGE(PG8_SB(0, 1), b2 + hstepB, voffB);
            PG8_WAIT_V(6); PG8_BAR; PG8_MMA(1, 1, At, B1); PG8_BAR;
            PG8_LDB(B0, 1, 0); PG8_SCHED; PG8_LDA(At, 1, 0); PG8_STAGE(PG8_SA(0, 1), a2 + hstepA, voffA);
            PG8_WAIT_L(8); PG8_BAR; PG8_WAIT_L(0); PG8_MMA(0, 0, At, B0); PG8_BAR; PG8_SCHED;
            PG8_LDB(B1, 1, 1); PG8_STAGE(PG8_SB(1, 0), b3, voffB);
            PG8_BAR; PG8_WAIT_L(0); PG8_MMA(0, 1, At, B1); PG8_BAR;
            PG8_LDA(At, 1, 1); PG8_STAGE(PG8_SA(1, 0), a3, voffA);
            PG8_BAR; PG8_WAIT_L(0); PG8_MMA(1, 0, At, B0); PG8_BAR; PG8_SCHED;
            PG8_STAGE(PG8_SB(1, 1), b3 + hstepB, voffB);
            PG8_WAIT_V(6); PG8_BAR; PG8_MMA(1, 1, At, B1); PG8_BAR;
            }
        }
        if constexpr (ALIGN_EPI) { if (wr == 0) PG8_BAR; }
        if constexpr (!Epi::AFTER_DRAIN) { E(acc, cur, wr, wc, fr, fq); S.done(cur); }
        if (!has_next) break;
#pragma unroll
        for (int a = 0; a < 2; ++a)
#pragma unroll
            for (int b = 0; b < 2; ++b)
#pragma unroll
                for (int m = 0; m < 4; ++m)
#pragma unroll
                    for (int n = 0; n < 2; ++n) acc[a][b][m][n] = (f32x4){0.f, 0.f, 0.f, 0.f};
        cur = nxt; cA = nA; cB = nB; ++ui;
        if constexpr (ALIGN_EPI) { if (wr == 1) PG8_BAR; }
    }
    PG8_WAIT_V(0);
    if constexpr (!ALIGN_EPI) { if (wr == 0) PG8_BAR; }
    PG8_BAR;
    if constexpr (Epi::AFTER_DRAIN) { E.fused(acc, cur, wr, wc, fr, fq, lds, wid, lane); S.done(cur); }
#undef PG8_SA
#undef PG8_SB
#undef PG8_STAGE
#undef PG8_LDA
#undef PG8_LDB
#undef PG8_MMA
#undef PG8_WAIT_V
#undef PG8_WAIT_L
#undef PG8_BAR
#undef PG8_SCHED
}
}

#define LAS __attribute__((address_space(3)))
typedef unsigned short bf16;
typedef unsigned v4u __attribute__((ext_vector_type(4)));
typedef unsigned v2u __attribute__((ext_vector_type(2)));
typedef float f32x4 __attribute__((ext_vector_type(4)));
typedef float f32x16 __attribute__((ext_vector_type(16)));
typedef short bf16x8 __attribute__((ext_vector_type(8)));
typedef short s16x4 __attribute__((ext_vector_type(4)));
typedef short v4i16_t __attribute__((ext_vector_type(4)));

constexpr int NWAVES = 8, NTHR = 512;
constexpr int M = 16384, DM = 1024, FF = 2816, DIN = 6752, ZP = 6912, SEQ = 4096, DEPTH = 4;
constexpr float EPS = 1e-6f, LOG2E = 1.4426950408889634f;
constexpr int ZQ_NA = 0, ZK_NA = 512, ZV_NA = 1024, ZGQ = 1536, ZGK = 1792, ZGV = 2048, ZGR = 2560, ZGFL = 3072, ZGBL = 3088, ZCQ = 3104, ZCKV = 3360, ZKR = 3616, ZGATE = 3680;
constexpr size_t MiB = 1u << 20;
constexpr size_t WS_WT = 1 * MiB, WS_XN = 57 * MiB, WS_Z = 89 * MiB, WS_QR = 305 * MiB, WS_KVR = 329 * MiB, WS_KF = 361 * MiB, WS_U = 385 * MiB, WS_DD = 449 * MiB, WS_END = 450 * MiB;
constexpr size_t WT_13A = 0, WT_2A = 11534336, WT_IN = 17301504, WT_UQ = 31457280, WT_UKV = 31850496, WT_BR = 32374784, WT_OUT = 35520512, WT_13B = 37617664, WT_2B = 49152000;
constexpr int LDS_BYTES = 135168;

struct Args { const float* in[29]; float* out; unsigned char* ws; };

#define LDS_WAIT() asm volatile("s_waitcnt lgkmcnt(0)" ::: "memory")
__device__ __forceinline__ unsigned pk2(float lo, float hi) { return pg8::cvt_pk_bf16(lo, hi); }
__device__ __forceinline__ float bf2f(bf16 h) { return __builtin_bit_cast(float, (unsigned)h << 16); }
__device__ __forceinline__ bf16 f2bf(float f) { return (bf16)(pk2(f, 0.f) & 0xffffu); }
__device__ __forceinline__ float wave_sum(float v) {
#pragma unroll
    for (int o = 1; o < 64; o <<= 1) v += __shfl_xor(v, o);
    return v;
}
__device__ __forceinline__ int opaque_tid() { int t = threadIdx.x; asm volatile("" : "+v"(t)); return t; }
__device__ __forceinline__ int crow(int r, int hi) { return (r & 3) + 8 * (r >> 2) + 4 * hi; }
__device__ __forceinline__ s16x4 vtr(const LAS char* p) { return __builtin_bit_cast(s16x4, __builtin_amdgcn_ds_read_tr16_b64_v4i16((LAS v4i16_t*)p)); }
__device__ __forceinline__ bf16x8 tr_frag(const LAS char* p0, const LAS char* p1) { const s16x4 a = vtr(p0), b = vtr(p1); return (bf16x8){a[0], a[1], a[2], a[3], b[0], b[1], b[2], b[3]}; }
__device__ __forceinline__ bf16x8 pack8(float a0, float a1, float a2, float a3, float a4, float a5, float a6, float a7) {
    v4u w; w.x = pk2(a0, a1); w.y = pk2(a2, a3); w.z = pk2(a4, a5); w.w = pk2(a6, a7); return __builtin_bit_cast(bf16x8, w);
}
#define MFMA32(a, b, c) __builtin_amdgcn_mfma_f32_32x32x16_bf16((a), (b), (c), 0, 0, 0)
#define MFMA16(a, b, c) __builtin_amdgcn_mfma_f32_16x16x32_bf16((a), (b), (c), 0, 0, 0)

__device__ __forceinline__ void tr_item(const float* __restrict__ W, int K, int N, bf16* WT, int k0, int n0, int drow0, LAS float* scr, int lane) {
#pragma unroll 8
    for (int i = 0; i < 32; ++i) { const int kk = 2 * i + (lane >> 5); scr[kk * 33 + (lane & 31)] = W[(size_t)(k0 + kk) * N + n0 + (lane & 31)]; }
    LDS_WAIT();
    const int c = lane & 7;
#pragma unroll
    for (int j = 0; j < 4; ++j) { const int n = (lane >> 3) + 8 * j; const LAS float* s = scr + (8 * c) * 33 + n;
        v4u o; o.x = pk2(s[0 * 33], s[1 * 33]); o.y = pk2(s[2 * 33], s[3 * 33]); o.z = pk2(s[4 * 33], s[5 * 33]); o.w = pk2(s[6 * 33], s[7 * 33]);
        *(v4u*)(WT + (size_t)(drow0 + n) * K + k0 + 8 * c) = o; }
    LDS_WAIT();
}
struct MatDesc { const float* W; bf16* WT; int K, N, mode, roff; };
__device__ __forceinline__ MatDesc mat_desc(int idx, int l, const Args& a, unsigned char* wt) {
    MatDesc d; d.mode = 0; d.roff = 0;
    switch (idx) {
    case 0:  d.W = a.in[2] + (size_t)l * DM * FF;  d.WT = (bf16*)(wt + WT_13A); d.K = DM; d.N = FF; d.mode = 1; d.roff = 0; break;
    case 1:  d.W = a.in[3] + (size_t)l * DM * FF;  d.WT = (bf16*)(wt + WT_13A); d.K = DM; d.N = FF; d.mode = 1; d.roff = 1; break;
    case 2:  d.W = a.in[4] + (size_t)l * FF * DM;  d.WT = (bf16*)(wt + WT_2A);  d.K = FF; d.N = DM; break;
    case 3:  d.W = a.in[6] + (size_t)l * DM * DIN; d.WT = (bf16*)(wt + WT_IN);  d.K = DM; d.N = DIN; break;
    case 4:  d.W = a.in[17] + (size_t)l * 256 * 768;  d.WT = (bf16*)(wt + WT_UQ);  d.K = 256; d.N = 768; break;
    case 5:  d.W = a.in[18] + (size_t)l * 256 * 1024; d.WT = (bf16*)(wt + WT_UKV); d.K = 256; d.N = 1024; break;
    case 6:  d.W = a.in[21] + (size_t)l * 512 * 1024; d.WT = (bf16*)(wt + WT_BR);  d.K = 512; d.N = 1024; d.roff = 0; break;
    case 7:  d.W = a.in[22] + (size_t)l * 512 * 1024; d.WT = (bf16*)(wt + WT_BR);  d.K = 512; d.N = 1024; d.roff = 1024; break;
    case 8:  d.W = a.in[23] + (size_t)l * 512 * 1024; d.WT = (bf16*)(wt + WT_BR);  d.K = 512; d.N = 1024; d.roff = 2048; break;
    case 9:  d.W = a.in[24] + (size_t)l * DM * DM;  d.WT = (bf16*)(wt + WT_OUT); d.K = DM; d.N = DM; break;
    case 10: d.W = a.in[26] + (size_t)l * DM * FF;  d.WT = (bf16*)(wt + WT_13B); d.K = DM; d.N = FF; d.mode = 1; d.roff = 0; break;
    case 11: d.W = a.in[27] + (size_t)l * DM * FF;  d.WT = (bf16*)(wt + WT_13B); d.K = DM; d.N = FF; d.mode = 1; d.roff = 1; break;
    default: d.W = a.in[28] + (size_t)l * FF * DM;  d.WT = (bf16*)(wt + WT_2B);  d.K = FF; d.N = DM; break;
    }
    return d;
}
__device__ __forceinline__ void convert_phase(const Args& a, int l, LAS unsigned char* lds) {
    const int tid = opaque_tid(), lane = tid & 63, wave = __builtin_amdgcn_readfirstlane(tid >> 6), gw = blockIdx.x * NWAVES + wave, NGW = gridDim.x * NWAVES, gtid = blockIdx.x * NTHR + tid, gthreads = gridDim.x * NTHR;
    unsigned char* wt = a.ws + WS_WT;
    LAS float* scr = (LAS float*)(lds + wave * 8704);
    int it = gw;
    for (int mi = 0; mi < 13; ++mi) {
        const MatDesc d = mat_desc(mi, l, a, wt);
        const int nblk = d.N / 32, cnt = (d.K / 64) * nblk;
        for (; it < cnt; it += NGW) {
            const int kb = it / nblk, nb = it - kb * nblk, n0 = 32 * nb;
            const int drow0 = d.mode ? (256 * (n0 >> 7) + 128 * d.roff + (n0 & 127)) : (d.roff + n0);
            tr_item(d.W, d.K, d.N, d.WT, 64 * kb, n0, drow0, scr, lane);
        }
        it -= cnt;
    }
    v4u* pad = (v4u*)(wt + WT_IN + (size_t)DIN * DM * 2);
    const int npad = (ZP - DIN) * DM * 2 / 16;
    for (int i = gtid; i < npad; i += gthreads) pad[i] = (v4u){0u, 0u, 0u, 0u};
}
__device__ __forceinline__ void norm_phase(const float* x, const float* g, bf16* XN) {
    const int tid = opaque_tid(), lane = tid & 63, wave = __builtin_amdgcn_readfirstlane(tid >> 6), gw = blockIdx.x * NWAVES + wave, NGW = gridDim.x * NWAVES;
    f32x4 gg[4];
#pragma unroll
    for (int j = 0; j < 4; ++j) gg[j] = ((const f32x4*)g)[lane + 64 * j];
    for (int m = gw; m < M; m += NGW) {
        const f32x4* xr = (const f32x4*)(x + (size_t)m * DM) + lane;
        f32x4 v[4]; float s = 0.f;
#pragma unroll
        for (int j = 0; j < 4; ++j) { v[j] = xr[64 * j]; s += (v[j].x * v[j].x + v[j].y * v[j].y) + (v[j].z * v[j].z + v[j].w * v[j].w); }
        const float r = 1.0f / sqrtf(wave_sum(s) * (1.0f / DM) + EPS);
        v2u* o = (v2u*)(XN + (size_t)m * DM) + lane;
#pragma unroll
        for (int j = 0; j < 4; ++j) { v2u w; w.x = pk2(v[j].x * r * gg[j].x, v[j].y * r * gg[j].y); w.y = pk2(v[j].z * r * gg[j].z, v[j].w * r * gg[j].w); o[64 * j] = w; }
    }
}
__device__ __forceinline__ void token_prep_phase(const Args& a, int l, bf16* Z) {
    const int tid = opaque_tid(), lane = tid & 63, wave = __builtin_amdgcn_readfirstlane(tid >> 6), gw = blockIdx.x * NWAVES + wave, NGW = gridDim.x * NWAVES;
    const float* gna = (lane < 32 ? a.in[7] : a.in[8]) + l * 64 + ((16 * lane) & 63);
    const float* gc = (lane < 32 ? a.in[15] : a.in[16]) + l * 256 + ((8 * lane) & 255);
    float g1[16], g2[8];
#pragma unroll
    for (int j = 0; j < 16; ++j) g1[j] = gna[j] * (lane < 32 ? 0.125f * LOG2E : 1.0f);
#pragma unroll
    for (int j = 0; j < 8; ++j) g2[j] = gc[j];
    for (int m = gw; m < M; m += NGW) {
        bf16* zr = Z + (size_t)m * ZP;
        { v4u w0 = *(const v4u*)(zr + 16 * lane), w1 = *(const v4u*)(zr + 16 * lane + 8);
          float v[16]; const unsigned ww[8] = {w0.x, w0.y, w0.z, w0.w, w1.x, w1.y, w1.z, w1.w};
          float ss = 0.f;
#pragma unroll
          for (int j = 0; j < 8; ++j) { v[2 * j] = pg8::bflo(ww[j]); v[2 * j + 1] = pg8::bfhi(ww[j]); ss += v[2 * j] * v[2 * j] + v[2 * j + 1] * v[2 * j + 1]; }
          ss += __shfl_xor(ss, 1); ss += __shfl_xor(ss, 2);
          const float r = 1.0f / sqrtf(ss * (1.0f / 64.0f) + EPS);
          v4u o0, o1;
          o0.x = pk2(v[0] * r * g1[0], v[1] * r * g1[1]); o0.y = pk2(v[2] * r * g1[2], v[3] * r * g1[3]); o0.z = pk2(v[4] * r * g1[4], v[5] * r * g1[5]); o0.w = pk2(v[6] * r * g1[6], v[7] * r * g1[7]);
          o1.x = pk2(v[8] * r * g1[8], v[9] * r * g1[9]); o1.y = pk2(v[10] * r * g1[10], v[11] * r * g1[11]); o1.z = pk2(v[12] * r * g1[12], v[13] * r * g1[13]); o1.w = pk2(v[14] * r * g1[14], v[15] * r * g1[15]);
          *(v4u*)(zr + 16 * lane) = o0; *(v4u*)(zr + 16 * lane + 8) = o1; }
        { const v4u w = *(const v4u*)(zr + ZCQ + 8 * lane);
          float v[8]; const unsigned ww[4] = {w.x, w.y, w.z, w.w}; float ss = 0.f;
#pragma unroll
          for (int j = 0; j < 4; ++j) { v[2 * j] = pg8::bflo(ww[j]); v[2 * j + 1] = pg8::bfhi(ww[j]); ss += v[2 * j] * v[2 * j] + v[2 * j + 1] * v[2 * j + 1]; }
#pragma unroll
          for (int o = 1; o < 32; o <<= 1) ss += __shfl_xor(ss, o);
          const float r = 1.0f / sqrtf(ss * (1.0f / 256.0f) + EPS);
          v4u o; o.x = pk2(v[0] * r * g2[0], v[1] * r * g2[1]); o.y = pk2(v[2] * r * g2[2], v[3] * r * g2[3]); o.z = pk2(v[4] * r * g2[4], v[5] * r * g2[5]); o.w = pk2(v[6] * r * g2[6], v[7] * r * g2[7]);
          *(v4u*)(zr + ZCQ + 8 * lane) = o; }
    }
}

constexpr int GP = 144;
constexpr int GL_QF = 0, GL_QB = 9216, GL_KF = 18432, GL_KB = 27648, GL_A = 36864  , GL_V = 55296  , GL_G = 73728;
constexpr int GL_BF = GL_G, GL_BB = GL_G + 16384, GL_GLF = GL_G + 32768, GL_GLB = GL_G + 36864;
constexpr int GL_S = GL_G;
constexpr int GL_O = 0;
__device__ __forceinline__ float log_sigmoid(float x) { return fminf(x, 0.f) - log1pf(__expf(-fabsf(x))); }

__device__ __forceinline__ void gla_item(const Args& a, int l, int mode, int b, int h, int c, bf16* Z, float* U, float* Dd, LAS unsigned char* lds_u) {
    LAS char* lds = (LAS char*)lds_u;
    const int tid = opaque_tid(), lane = tid & 63, wave = __builtin_amdgcn_readfirstlane(tid >> 6), r32 = lane & 31, hi = lane >> 5, i16 = lane & 15, blk = (lane >> 4) & 1;
    const int bh = b * 4 + h; const size_t tok0 = (size_t)b * SEQ + 64 * c;
    LAS float* sBf = (LAS float*)(lds + GL_BF); LAS float* sBb = (LAS float*)(lds + GL_BB); LAS float* sGlf = (LAS float*)(lds + GL_GLF); LAS float* sGlb = (LAS float*)(lds + GL_GLB);
    for (int idx = tid; idx < 2048; idx += NTHR) { const int dx = idx >> 10, t = (idx >> 4) & 63, r = idx & 15;
        const float v = bf2f(Z[(tok0 + t) * ZP + (dx ? ZGBL : ZGFL) + r]); (dx ? sGlb : sGlf)[t * 16 + r] = v; }
#pragma unroll
    for (int i = 0; i < 2; ++i) { const int idx = tid + NTHR * i, t = idx >> 4, ch = idx & 15;
        *(LAS v4u*)(lds + GL_V + t * 288 + ch * 16) = *(const v4u*)(Z + (tok0 + t) * ZP + ZGV + 128 * h + 8 * ch); }
    const int j = tid & 63, tg = tid >> 6;
    float upf[16], upb[16];
    { const float* pf = a.in[10] + (size_t)l * 16 * 256 + 64 * h + j; const float* pb = a.in[12] + (size_t)l * 16 * 256 + 64 * h + j;
#pragma unroll
      for (int r = 0; r < 16; ++r) { upf[r] = pf[r * 256]; upb[r] = pb[r * 256]; } }
    const float biasf = a.in[11][l * 256 + 64 * h + j], biasb = a.in[13][l * 256 + 64 * h + j];
    __syncthreads();
#pragma unroll
    for (int i = 0; i < 8; ++i) { const int t = tg + 8 * i; float lf = biasf, lb = biasb;
#pragma unroll
        for (int r = 0; r < 16; ++r) { lf += sGlf[t * 16 + r] * upf[r]; lb += sGlb[t * 16 + r] * upb[r]; }
        sBf[t * 64 + j] = log_sigmoid(lf) * (1.0f / 16.0f); sBb[t * 64 + j] = log_sigmoid(lb) * (1.0f / 16.0f); }
    __syncthreads();
    if (tid < 64) { float acc = 0.f; for (int t = 0; t < 64; ++t) { acc += sBf[t * 64 + tid]; sBf[t * 64 + tid] = acc; } }
    else if (tid < 128) { const int jj = tid - 64; float acc = 0.f; for (int t = 63; t >= 0; --t) { acc += sBb[t * 64 + jj]; sBb[t * 64 + jj] = acc; } }
    __syncthreads();
    { const float bl = sBf[63 * 64 + j], bs0 = sBb[j];
#pragma unroll
      for (int i = 0; i < 8; ++i) { const int t = tg + 8 * i;
          const float q = bf2f(Z[(tok0 + t) * ZP + ZGQ + 64 * h + j]) * 0.125f, k = bf2f(Z[(tok0 + t) * ZP + ZGK + 64 * h + j]);
          const float bf = sBf[t * 64 + j], bs = sBb[t * 64 + j];
          if (mode == 1) {
              *(LAS bf16*)(lds + GL_QF + t * GP + j * 2) = f2bf(q * __expf(bf)); *(LAS bf16*)(lds + GL_KF + t * GP + j * 2) = f2bf(k * __expf(-bf));
              *(LAS bf16*)(lds + GL_QB + t * GP + j * 2) = f2bf(q * __expf(bs)); *(LAS bf16*)(lds + GL_KB + t * GP + j * 2) = f2bf(k * __expf(-bs));
          } else {
              *(LAS bf16*)(lds + GL_A + j * GP + t * 2) = f2bf(k * __expf(bl - bf)); *(LAS bf16*)(lds + GL_A + 9216 + j * GP + t * 2) = f2bf(k * __expf(bs0 - bs));
          } }
      if (mode == 0 && tg == 0) { Dd[((size_t)(0 * 16 + bh) * 64 + c) * 64 + j] = __expf(bl); Dd[((size_t)(1 * 16 + bh) * 64 + c) * 64 + j] = __expf(bs0); } }
    __syncthreads();
    if (mode == 0) {
        const int dir = wave >> 2, dvt = wave & 3;
        float* Ub = U + ((size_t)(dir * 16 + bh) * 64 + c) * 8192;
#pragma unroll
        for (int dkt = 0; dkt < 2; ++dkt) { f32x16 acc = {};
#pragma unroll
            for (int s = 0; s < 4; ++s) {
                const bf16x8 A = *(const LAS bf16x8*)(lds + GL_A + dir * 9216 + (32 * dkt + r32) * GP + (16 * s + 8 * hi) * 2);
                const LAS char* vp = lds + GL_V + (16 * s + 8 * hi + (i16 >> 2)) * 288 + (32 * dvt + 16 * blk + 4 * (i16 & 3)) * 2;
                const bf16x8 B = tr_frag(vp, vp + 4 * 288);
                acc = MFMA32(A, B, acc); }
#pragma unroll
            for (int r = 0; r < 16; ++r) Ub[(32 * dkt + crow(r, hi)) * 128 + 32 * dvt + r32] = acc[r]; }
        __syncthreads();
        return;
    }
    { const int dir = wave >> 2, ti = (wave >> 1) & 1, tj = wave & 1; f32x16 acc = {};
      const int qo = dir ? GL_QB : GL_QF, ko = dir ? GL_KB : GL_KF;
#pragma unroll
      for (int s = 0; s < 4; ++s) {
          const bf16x8 A = *(const LAS bf16x8*)(lds + qo + (32 * ti + r32) * GP + (16 * s + 8 * hi) * 2);
          const bf16x8 B = *(const LAS bf16x8*)(lds + ko + (32 * tj + r32) * GP + (16 * s + 8 * hi) * 2);
          acc = MFMA32(A, B, acc); }
      const int jj = 32 * tj + r32;
#pragma unroll
      for (int r = 0; r < 16; ++r) { const int ii = 32 * ti + crow(r, hi); const bool keep = dir ? (jj > ii) : (jj <= ii);
          *(LAS bf16*)(lds + GL_A + dir * 9216 + ii * GP + jj * 2) = f2bf(keep ? acc[r] : 0.f); } }
#pragma unroll
    for (int i = 0; i < 8; ++i) { const int idx = tid + NTHR * i, dir = idx >> 11, e4 = idx & 2047, dk = e4 >> 5, c4 = e4 & 31;
        const f32x4 v = *(const f32x4*)(U + ((size_t)(dir * 16 + bh) * 64 + c) * 8192 + dk * 128 + 4 * c4);
        v2u w; w.x = pk2(v.x, v.y); w.y = pk2(v.z, v.w); *(LAS v2u*)(lds + GL_S + dir * 18432 + dk * 288 + c4 * 8) = w; }
    __syncthreads();
    f32x16 oacc = {};
    const int ti = wave >> 2, dvt = wave & 3;
#pragma unroll
    for (int dir = 0; dir < 2; ++dir) {
        const int qo = dir ? GL_QB : GL_QF;
#pragma unroll
        for (int s = 0; s < 4; ++s) {
            const bf16x8 A1 = *(const LAS bf16x8*)(lds + GL_A + dir * 9216 + (32 * ti + r32) * GP + (16 * s + 8 * hi) * 2);
            const LAS char* vp = lds + GL_V + (16 * s + 8 * hi + (i16 >> 2)) * 288 + (32 * dvt + 16 * blk + 4 * (i16 & 3)) * 2;
            oacc = MFMA32(A1, tr_frag(vp, vp + 4 * 288), oacc);
            const bf16x8 A2 = *(const LAS bf16x8*)(lds + qo + (32 * ti + r32) * GP + (16 * s + 8 * hi) * 2);
            const LAS char* sp = lds + GL_S + dir * 18432 + (16 * s + 8 * hi + (i16 >> 2)) * 288 + (32 * dvt + 16 * blk + 4 * (i16 & 3)) * 2;
            oacc = MFMA32(A2, tr_frag(sp, sp + 4 * 288), oacc); } }
    __syncthreads();
#pragma unroll
    for (int r = 0; r < 16; ++r) *(LAS float*)(lds + GL_O + ((32 * ti + crow(r, hi)) * 132 + 32 * dvt + r32) * 4) = oacc[r];
    __syncthreads();
    { const int row = tid >> 3, seg = tid & 7; float v[16]; float ss = 0.f;
#pragma unroll
      for (int q4 = 0; q4 < 4; ++q4) { const f32x4 t = *(const LAS f32x4*)(lds + GL_O + (row * 132 + 16 * seg + 4 * q4) * 4); v[4 * q4] = t.x; v[4 * q4 + 1] = t.y; v[4 * q4 + 2] = t.z; v[4 * q4 + 3] = t.w; }
#pragma unroll
      for (int q = 0; q < 16; ++q) ss += v[q] * v[q];
      ss += __shfl_xor(ss, 1); ss += __shfl_xor(ss, 2); ss += __shfl_xor(ss, 4);
      const float rr = 1.0f / sqrtf(ss * (1.0f / 128.0f) + EPS);
      bf16* zr = Z + (tok0 + row) * ZP;
      const v4u g0 = *(const v4u*)(zr + ZGR + 128 * h + 16 * seg), g1 = *(const v4u*)(zr + ZGR + 128 * h + 16 * seg + 8);
      const unsigned gw_[8] = {g0.x, g0.y, g0.z, g0.w, g1.x, g1.y, g1.z, g1.w};
      const float* gn = a.in[14] + l * 128 + 16 * seg;
      unsigned ow[8];
#pragma unroll
      for (int q = 0; q < 8; ++q) { const float ga = pg8::bflo(gw_[q]), gb = pg8::bfhi(gw_[q]);
          const float ya = (v[2 * q] * rr * gn[2 * q]) * (ga * pg8::fsigmoid(ga)), yb = (v[2 * q + 1] * rr * gn[2 * q + 1]) * (gb * pg8::fsigmoid(gb));
          ow[q] = pk2(ya, yb); }
      *(v4u*)(zr + ZGV + 128 * h + 16 * seg) = (v4u){ow[0], ow[1], ow[2], ow[3]}; *(v4u*)(zr + ZGV + 128 * h + 16 * seg + 8) = (v4u){ow[4], ow[5], ow[6], ow[7]}; }
    __syncthreads();
}
__device__ __forceinline__ void gla_scan_phase(float* U, const float* Dd) {
    const int gtid = blockIdx.x * NTHR + opaque_tid(), gthreads = gridDim.x * NTHR;
    for (int ch = gtid; ch < 2 * 16 * 8192; ch += gthreads) {
        const int e = ch & 8191, dirbh = ch >> 13, dir = dirbh >> 4, dk = e >> 7;
        float* Ub = U + (size_t)dirbh * 64 * 8192 + e; const float* Db = Dd + (size_t)dirbh * 64 * 64 + dk;
        float st = 0.f;
        for (int cc = 0; cc < 64; cc += 8) { float u[8], d[8];
#pragma unroll
            for (int k = 0; k < 8; ++k) { const int c = dir ? 63 - (cc + k) : cc + k; u[k] = Ub[(size_t)c * 8192]; d[k] = Db[c * 64]; }
#pragma unroll
            for (int k = 0; k < 8; ++k) { const int c = dir ? 63 - (cc + k) : cc + k; Ub[(size_t)c * 8192] = st; st = d[k] * st + u[k]; } }
    }
}

__device__ __forceinline__ void na_phase(const Args& a, int l, bf16* Z, LAS unsigned char* lds_u) {
    const int tid = opaque_tid(), lane = tid & 63, wave = __builtin_amdgcn_readfirstlane(tid >> 6), gw = blockIdx.x * NWAVES + wave, NGW = gridDim.x * NWAVES;
    LAS char* wv = (LAS char*)lds_u + wave * 16384;
    const int l15 = lane & 15, quad = lane >> 4;
    for (int it = gw; it < 8192; it += NGW) {
        const int j = it & 3, r = (it >> 2) & 63, h = (it >> 8) & 7, b = it >> 11;
        const int r0 = min(max(r - 4, 0), 56), k0 = min(max(16 * j - 8, 0), 32);
        const size_t tq = (size_t)b * SEQ + r * 64 + 16 * j + l15;
        const bf16* qp = Z + tq * ZP + ZQ_NA + 64 * h + 8 * quad;
        const bf16x8 qf0 = *(const bf16x8*)qp, qf1 = *(const bf16x8*)(qp + 32);
        f32x4 s[16];
#pragma unroll
        for (int kt = 0; kt < 16; ++kt) { const size_t tk = (size_t)b * SEQ + (r0 + (kt >> 1)) * 64 + k0 + 16 * (kt & 1) + l15;
            const bf16* kp = Z + tk * ZP + ZK_NA + 64 * h + 8 * quad;
            const bf16x8 kf0 = *(const bf16x8*)kp, kf1 = *(const bf16x8*)(kp + 32);
            f32x4 acc = {0.f, 0.f, 0.f, 0.f}; acc = MFMA16(kf0, qf0, acc); acc = MFMA16(kf1, qf1, acc); s[kt] = acc; if ((kt & 3) == 3) asm volatile("" ::: "memory"); }
        const int qc = 16 * j + l15, c0 = min(max(qc - 8, 0), 48);
        const float* rp = a.in[9] + (size_t)((l * 8 + h) * 15) * 31;
        float mx = -1e30f;
#pragma unroll
        for (int kt = 0; kt < 16; ++kt)
#pragma unroll
            for (int i = 0; i < 4; ++i) { const int kc = k0 + 16 * (kt & 1) + 4 * quad + i, kr = r0 + (kt >> 1), dr = kr - r + 7, dc = min(max(kc - qc + 15, 0), 30);
                const bool ok = (kc >= c0) && (kc < c0 + 16);
                const float v = ok ? s[kt][i] + rp[dr * 31 + dc] * LOG2E : -1e30f; s[kt][i] = v; mx = fmaxf(mx, v); }
        mx = fmaxf(mx, __shfl_xor(mx, 16)); mx = fmaxf(mx, __shfl_xor(mx, 32));
        float lsum = 0.f;
#pragma unroll
        for (int kt = 0; kt < 16; ++kt)
#pragma unroll
            for (int i = 0; i < 4; ++i) { const float p = __builtin_amdgcn_exp2f(s[kt][i] - mx); s[kt][i] = p; lsum += p; }
        lsum += __shfl_xor(lsum, 16); lsum += __shfl_xor(lsum, 32);
        const float inv = 1.0f / lsum;
        f32x4 o[4];
#pragma unroll
        for (int c = 0; c < 4; ++c) o[c] = (f32x4){0.f, 0.f, 0.f, 0.f};
#pragma unroll
        for (int half = 0; half < 2; ++half) {
            LDS_WAIT();
#pragma unroll
            for (int i = 0; i < 16; ++i) { const int id = lane + 64 * i, tl = id >> 3, ch = id & 7;
                const size_t tk = (size_t)b * SEQ + (r0 + 4 * half + (tl >> 5)) * 64 + k0 + (tl & 31);
                *(LAS v4u*)(wv + tl * 128 + ch * 16) = *(const v4u*)(Z + tk * ZP + ZV_NA + 64 * h + 8 * ch); }
            LDS_WAIT();
#pragma unroll
            for (int s4 = 0; s4 < 4; ++s4) { const int sw = 4 * half + s4;
                const bf16x8 pf = pack8(s[2 * sw][0], s[2 * sw][1], s[2 * sw][2], s[2 * sw][3], s[2 * sw + 1][0], s[2 * sw + 1][1], s[2 * sw + 1][2], s[2 * sw + 1][3]);
#pragma unroll
                for (int c = 0; c < 4; ++c) { const LAS char* vp = wv + (32 * s4 + 4 * quad + (l15 >> 2)) * 128 + (16 * c + 4 * (l15 & 3)) * 2;
                    o[c] = MFMA16(tr_frag(vp, vp + 16 * 128), pf, o[c]); } }
        }
        bf16* op = Z + tq * ZP + ZQ_NA + 64 * h + 4 * quad;
#pragma unroll
        for (int c = 0; c < 4; ++c) { v2u w; w.x = pk2(o[c][0] * inv, o[c][1] * inv); w.y = pk2(o[c][2] * inv, o[c][3] * inv); *(v2u*)(op + 16 * c) = w; }
    }
    LDS_WAIT();
}

__device__ __forceinline__ void mla_prep_phase(const Args& a, int l, const bf16* Z, bf16* QR, const bf16* KVR, bf16* KF) {
    const int tid = opaque_tid(), lane = tid & 63, wave = __builtin_amdgcn_readfirstlane(tid >> 6), gw = blockIdx.x * NWAVES + wave, NGW = gridDim.x * NWAVES;
    const float* qn = a.in[19] + l * 192; const float* kn = a.in[20] + l * 192;
    const float gq0 = qn[2 * lane], gq1 = qn[2 * lane + 1], gq2 = qn[128 + lane];
    const float gk0 = kn[2 * lane], gk1 = kn[2 * lane + 1], gk2 = kn[128 + lane];
    const float inv_freq = exp2f(-(float)(lane & 31) * (13.287712379549449f / 32.0f));
    const float qs = 0.07216878364870322f * LOG2E;
    for (int m = gw; m < M; m += NGW) {
        const int pos = m & (SEQ - 1);
        float sn, cs; sincosf((float)pos * inv_freq, &sn, &cs);
        const float krp = bf2f(Z[(size_t)m * ZP + ZKR + lane]);
#pragma unroll
        for (int h = 0; h < 4; ++h) {
            { bf16* qp = QR + (size_t)m * 768 + 192 * h;
              const unsigned w = *(const unsigned*)(qp + 2 * lane); const float n0 = pg8::bflo(w), n1 = pg8::bfhi(w), rp = bf2f(qp[128 + lane]);
              const float r = 1.0f / sqrtf(wave_sum(n0 * n0 + n1 * n1 + rp * rp) * (1.0f / 192.0f) + EPS);
              const float x = rp * r * gq2, y = __shfl_xor(x, 32);
              const float ro = (lane < 32) ? (x * cs - y * sn) : (y * sn + x * cs);
              *(unsigned*)(qp + 2 * lane) = pk2(n0 * r * gq0 * qs, n1 * r * gq1 * qs); qp[128 + lane] = f2bf(ro * qs); }
            { const bf16* kp = KVR + (size_t)m * 1024 + 256 * h; bf16* ko = KF + (size_t)m * 768 + 192 * h;
              const unsigned w = *(const unsigned*)(kp + 2 * lane); const float n0 = pg8::bflo(w), n1 = pg8::bfhi(w), rp = krp;
              const float r = 1.0f / sqrtf(wave_sum(n0 * n0 + n1 * n1 + rp * rp) * (1.0f / 192.0f) + EPS);
              const float x = rp * r * gk2, y = __shfl_xor(x, 32);
              const float ro = (lane < 32) ? (x * cs - y * sn) : (y * sn + x * cs);
              *(unsigned*)(ko + 2 * lane) = pk2(n0 * r * gk0, n1 * r * gk1); ko[128 + lane] = f2bf(ro); }
        }
    }
}

constexpr int MK_P = 400, MV_P = 288, MK_BYTES = 64 * MK_P, MSTG = MK_BYTES + 64 * MV_P;
__device__ __forceinline__ void mla_attn_unit(LAS unsigned char* lds_u, const bf16* QF, const bf16* KF, const bf16* KVR, bf16* Z, int b, int h, int qb) {
    LAS char* lds = (LAS char*)lds_u;
    const int tid = opaque_tid(), lane = tid & 63, wave = __builtin_amdgcn_readfirstlane(tid >> 6), r32 = lane & 31, hi = lane >> 5, i16 = lane & 15, blk = (lane >> 4) & 1;
    const size_t tokb = (size_t)b * SEQ;
    const size_t qtok = tokb + 256 * qb + 32 * wave + r32;
    bf16x8 qf[12];
    { const bf16* qp = QF + qtok * 768 + 192 * h + 8 * hi;
#pragma unroll
      for (int s = 0; s < 12; ++s) qf[s] = *(const bf16x8*)(qp + 16 * s); }
    f32x16 o[4];
#pragma unroll
    for (int c = 0; c < 4; ++c) o[c] = f32x16{};
    float mrun = -1e30f, lrun = 0.f;
    int krow[3], kch[3];
#pragma unroll
    for (int i = 0; i < 3; ++i) { const int id = tid + NTHR * i; krow[i] = id / 24; kch[i] = id - krow[i] * 24; }
    const bf16* kbase = KF + tokb * 768 + 192 * h; const bf16* vbase = KVR + tokb * 1024 + 256 * h + 128;
    v4u kreg[3], vreg[2];
#define MLA_LOAD(t) do { _Pragma("unroll") for (int i = 0; i < 3; ++i) kreg[i] = *(const v4u*)(kbase + (size_t)(64 * (t) + krow[i]) * 768 + 8 * kch[i]); \
        _Pragma("unroll") for (int i = 0; i < 2; ++i) { const int id = tid + NTHR * i; vreg[i] = *(const v4u*)(vbase + (size_t)(64 * (t) + (id >> 4)) * 1024 + 8 * (id & 15)); } } while (0)
#define MLA_STORE(buf) do { _Pragma("unroll") for (int i = 0; i < 3; ++i) *(LAS v4u*)(lds + (buf) * MSTG + krow[i] * MK_P + kch[i] * 16) = kreg[i]; \
        _Pragma("unroll") for (int i = 0; i < 2; ++i) { const int id = tid + NTHR * i; *(LAS v4u*)(lds + (buf) * MSTG + MK_BYTES + (id >> 4) * MV_P + (id & 15) * 16) = vreg[i]; } } while (0)
    MLA_LOAD(0); MLA_STORE(0);
    __syncthreads();
    for (int t = 0; t < 64; ++t) {
        const int cur = t & 1;
        if (t + 1 < 64) MLA_LOAD(t + 1);
        const LAS char* kb = lds + cur * MSTG; const LAS char* vb = kb + MK_BYTES;
        f32x16 p0 = f32x16{}, p1 = f32x16{};
#pragma unroll
        for (int s = 0; s < 12; ++s) {
            const bf16x8 k0 = *(const LAS bf16x8*)(kb + r32 * MK_P + (16 * s + 8 * hi) * 2);
            const bf16x8 k1 = *(const LAS bf16x8*)(kb + (32 + r32) * MK_P + (16 * s + 8 * hi) * 2);
            p0 = MFMA32(k0, qf[s], p0); p1 = MFMA32(k1, qf[s], p1); }
        float mx = fmaxf(p0[0], p1[0]);
#pragma unroll
        for (int r = 1; r < 16; ++r) mx = fmaxf(mx, fmaxf(p0[r], p1[r]));
        mx = fmaxf(mx, __shfl_xor(mx, 32));
        const float mn = fmaxf(mrun, mx), f = __builtin_amdgcn_exp2f(mrun - mn); mrun = mn; lrun *= f;
#pragma unroll
        for (int c = 0; c < 4; ++c)
#pragma unroll
            for (int r = 0; r < 16; ++r) o[c][r] *= f;
        float ls = 0.f;
#pragma unroll
        for (int r = 0; r < 16; ++r) { p0[r] = __builtin_amdgcn_exp2f(p0[r] - mn); p1[r] = __builtin_amdgcn_exp2f(p1[r] - mn); ls += p0[r] + p1[r]; }
        lrun += ls;
        bf16x8 pf[4];
        pf[0] = pack8(p0[0], p0[1], p0[2], p0[3], p0[4], p0[5], p0[6], p0[7]); pf[1] = pack8(p0[8], p0[9], p0[10], p0[11], p0[12], p0[13], p0[14], p0[15]);
        pf[2] = pack8(p1[0], p1[1], p1[2], p1[3], p1[4], p1[5], p1[6], p1[7]); pf[3] = pack8(p1[8], p1[9], p1[10], p1[11], p1[12], p1[13], p1[14], p1[15]);
#pragma unroll
        for (int c = 0; c < 4; ++c)
#pragma unroll
            for (int s = 0; s < 4; ++s) { const LAS char* vp = vb + (16 * s + 4 * hi + (i16 >> 2)) * MV_P + (32 * c + 16 * blk + 4 * (i16 & 3)) * 2;
                o[c] = MFMA32(tr_frag(vp, vp + 8 * MV_P), pf[s], o[c]); }
        if (t + 1 < 64) MLA_STORE(cur ^ 1);
        __syncthreads();
    }
#undef MLA_LOAD
#undef MLA_STORE
    lrun += __shfl_xor(lrun, 32);
    const float inv = 1.0f / lrun;
    bf16* op = Z + qtok * ZP + ZCQ + 128 * h + 4 * hi;
#pragma unroll
    for (int c = 0; c < 4; ++c)
#pragma unroll
        for (int g4 = 0; g4 < 4; ++g4) { v2u w; w.x = pk2(o[c][4 * g4] * inv, o[c][4 * g4 + 1] * inv); w.y = pk2(o[c][4 * g4 + 2] * inv, o[c][4 * g4 + 3] * inv);
            *(v2u*)(op + 32 * c + 8 * g4) = w; }
}

#ifndef PH_MASK
#define PH_MASK 0xFFFF
#endif
__global__ void __launch_bounds__(NTHR, 2) mega_fwd(Args a) {
    extern __shared__ __attribute__((aligned(16))) unsigned char lds_raw[];
    LAS unsigned char* lds = (LAS unsigned char*)lds_raw;
    cg::grid_group grid = cg::this_grid();
    const int G = gridDim.x, bx = blockIdx.x;
    const int vcu = (G % 8 == 0) ? (bx % 8) * (G / 8) + bx / 8 : bx;
    unsigned char* ws = a.ws;
    bf16* XN = (bf16*)(ws + WS_XN); bf16* Z = (bf16*)(ws + WS_Z); bf16* Hb = (bf16*)(ws + WS_Z);
    bf16* QR = (bf16*)(ws + WS_QR); bf16* KVR = (bf16*)(ws + WS_KVR); bf16* KF = (bf16*)(ws + WS_KF);
    float* U = (float*)(ws + WS_U); float* MIXF = (float*)(ws + WS_U); float* Dd = (float*)(ws + WS_DD);
    unsigned char* wt = ws + WS_WT;
    float* out = a.out;
    for (int l = 0; l < DEPTH; ++l) {
        const float* xin = (l == 0) ? a.in[0] : out;
#if (PH_MASK >> 0) & 1
        convert_phase(a, l, lds);
        norm_phase(xin, a.in[1] + l * DM, XN);
#endif
        grid.sync();
#if (PH_MASK >> 1) & 1
        { pg8::Gemm g{XN, (const bf16*)(wt + WT_13A), M, 2 * FF, DM, DM, DM}; pg8::StaticOrder S; S.init(M, 2 * FF, G, bx);
          pg8::EpiSwiGLU E{Hb, FF}; pg8::gemm_phase<pg8::EpiSwiGLU, pg8::StaticOrder, true, true>(lds, g, S, E); }
#endif
        grid.sync();
#if (PH_MASK >> 2) & 1
        { pg8::Gemm g{Hb, (const bf16*)(wt + WT_2A), M, DM, FF, FF, FF}; pg8::StaticOrder S; S.init(M, DM, G, bx);
          pg8::EpiResid E{xin, out, DM, 0.5f}; pg8::gemm_phase<pg8::EpiResid, pg8::StaticOrder, true, true>(lds, g, S, E); }
#endif
        grid.sync();
#if (PH_MASK >> 3) & 1
        norm_phase(out, a.in[5] + l * DM, XN);
#endif
        grid.sync();
#if (PH_MASK >> 4) & 1
        { pg8::Gemm g{XN, (const bf16*)(wt + WT_IN), M, ZP, DM, DM, DM}; pg8::StaticOrder S; S.init(M, ZP, G, bx);
          pg8::EpiBf16 E{Z, ZP}; pg8::gemm_phase<pg8::EpiBf16, pg8::StaticOrder, true, true>(lds, g, S, E); }
#endif
        grid.sync();
#if (PH_MASK >> 5) & 1
        token_prep_phase(a, l, Z);
        for (int it = bx; it < 1024; it += G) gla_item(a, l, 0, it >> 8, (it >> 6) & 3, it & 63, Z, U, Dd, lds);
#endif
        grid.sync();
#if (PH_MASK >> 6) & 1
        { pg8::Gemm g{Z + ZCQ, (const bf16*)(wt + WT_UQ), M, 768, 256, ZP, 256}; pg8::StaticOrder S; S.init(M, 768, G, bx);
          pg8::EpiBf16 E{QR, 768}; pg8::gemm_phase<pg8::EpiBf16, pg8::StaticOrder, true, true>(lds, g, S, E); }
        __syncthreads();
        { pg8::Gemm g{Z + ZCKV, (const bf16*)(wt + WT_UKV), M, 1024, 256, ZP, 256}; pg8::StaticOrder S; S.init(M, 1024, G, bx);
          pg8::EpiBf16 E{KVR, 1024}; pg8::gemm_phase<pg8::EpiBf16, pg8::StaticOrder, true, true>(lds, g, S, E); }
        __syncthreads();
        gla_scan_phase(U, Dd);
        na_phase(a, l, Z, lds);
#endif
        grid.sync();
#if (PH_MASK >> 7) & 1
        mla_prep_phase(a, l, Z, QR, KVR, KF);
        __syncthreads();
        for (int it = bx; it < 1024; it += G) gla_item(a, l, 1, it >> 8, (it >> 6) & 3, it & 63, Z, U, Dd, lds);
#endif
        grid.sync();
#if (PH_MASK >> 8) & 1
        for (int u = vcu; u < 256; u += G) { mla_attn_unit(lds, QR, KF, KVR, Z, (u >> 4) >> 2, (u >> 4) & 3, u & 15); __syncthreads(); }
#endif
        grid.sync();
#if (PH_MASK >> 9) & 1
        { pg8::Gemm g{Z, (const bf16*)(wt + WT_BR), M, 1024, 512, ZP, 512}; pg8::MergeOrder S{G, bx, ZQ_NA, ZGV, ZCQ};
          pg8::EpiMerge E{Z, ZP, ZGATE, MIXF, XN}; pg8::gemm_phase<pg8::EpiMerge, pg8::MergeOrder, true, true>(lds, g, S, E); }
#endif
        grid.sync();
#if (PH_MASK >> 10) & 1
        { pg8::Gemm g{XN, (const bf16*)(wt + WT_OUT), M, DM, DM, DM, DM}; pg8::StaticOrder S; S.init(M, DM, G, bx);
          pg8::EpiResid E{out, out, DM, 1.0f}; pg8::gemm_phase<pg8::EpiResid, pg8::StaticOrder, true, true>(lds, g, S, E); }
#endif
        grid.sync();
#if (PH_MASK >> 11) & 1
        norm_phase(out, a.in[25] + l * DM, XN);
#endif
        grid.sync();
#if (PH_MASK >> 12) & 1
        { pg8::Gemm g{XN, (const bf16*)(wt + WT_13B), M, 2 * FF, DM, DM, DM}; pg8::StaticOrder S; S.init(M, 2 * FF, G, bx);
          pg8::EpiSwiGLU E{Hb, FF}; pg8::gemm_phase<pg8::EpiSwiGLU, pg8::StaticOrder, true, true>(lds, g, S, E); }
#endif
        grid.sync();
#if (PH_MASK >> 13) & 1
        { pg8::Gemm g{Hb, (const bf16*)(wt + WT_2B), M, DM, FF, FF, FF}; pg8::StaticOrder S; S.init(M, DM, G, bx);
          pg8::EpiResid E{out, out, DM, 0.5f}; pg8::gemm_phase<pg8::EpiResid, pg8::StaticOrder, true, true>(lds, g, S, E); }
#endif
        grid.sync();
    }
}

extern "C" void kernel_launch(void* const* d_in, const int* in_sizes, int n_in, void* d_out, int out_size, void* d_ws, size_t ws_size, hipStream_t stream) {
    static int grid = 0;
    if (grid == 0) {
        if (n_in != 29 || out_size != M * DM || ws_size < WS_END) { fprintf(stderr, "kernel_launch: unexpected shapes / workspace (%d inputs, out %d, ws %zu)\n", n_in, out_size, ws_size); grid = -1; return; }
        int dev = 0, cus = 0, per_cu = 0;
        (void)hipGetDevice(&dev); (void)hipDeviceGetAttribute(&cus, hipDeviceAttributeMultiprocessorCount, dev);
        (void)hipFuncSetAttribute((const void*)mega_fwd, hipFuncAttributeMaxDynamicSharedMemorySize, LDS_BYTES);
        if (hipOccupancyMaxActiveBlocksPerMultiprocessor(&per_cu, (const void*)mega_fwd, NTHR, LDS_BYTES) != hipSuccess || per_cu < 1) per_cu = 1;
        (void)hipGetLastError();
        grid = cus * per_cu; if (grid > 256) grid = 256;
        if (grid <= 0) grid = 256;
    }
    if (grid < 0) return;
    Args a{};
    for (int i = 0; i < 29; ++i) a.in[i] = (const float*)d_in[i];
    a.out = (float*)d_out; a.ws = (unsigned char*)d_ws;
    void* args[] = {&a};
    hipError_t e = hipLaunchCooperativeKernel((const void*)mega_fwd, dim3(grid), dim3(NTHR), args, LDS_BYTES, stream);
    if (e != hipSuccess) fprintf(stderr, "cooperative launch failed: %s (grid %d)\n", hipGetErrorString(e), grid);
}
```

```cpp
#include <hip/hip_runtime.h>
#include <hip/hip_cooperative_groups.h>
#include <cstdio>
#include <cstdint>
namespace cg = cooperative_groups;

namespace pg8 {
#define PG8_LAS __attribute__((address_space(3)))
typedef unsigned short bf16_t;
typedef short bf16x8 __attribute__((ext_vector_type(8)));
typedef float f32x4 __attribute__((ext_vector_type(4)));
typedef unsigned u32x4 __attribute__((ext_vector_type(4)));
typedef unsigned u32x2 __attribute__((ext_vector_type(2)));
constexpr int BM = 256, BK = 64, HALF = 128, HTB = HALF * BK * 2  , STAGE_BYTES = 8 * HTB, NXCD = 8, WGM = 8;

__host__ __device__ __forceinline__ int lds_byte(int r, int c) { const int st = (r >> 4) * 2 + (c >> 5), rr = r & 15, cc = c & 31, ob = rr * 64 + cc * 2; return st * 1024 + (ob ^ (((ob >> 9) & 1) << 5)); }
__host__ __device__ __forceinline__ void stage_rc(int b, int& R, int& C) { const int st = b / 1024, sb = b % 1024, swz = sb ^ (((sb >> 9) & 1) << 5); R = (st >> 1) * 16 + swz / 64; C = (st & 1) * 32 + (swz % 64) / 2; }
__host__ __device__ __forceinline__ int perm32(int rho) { const int n = rho >> 4, i = rho & 15; return 8 * (i >> 2) + 4 * n + (i & 3); }

struct Unit { int pm, pn; };
struct Gemm { const bf16_t* A; const bf16_t* Bt; int M, N, K, lda, ldb; };

struct StaticOrder {
    int nM, nN, nwg, G, c;
    __host__ __device__ void init(int M, int N, int G_, int c_) { nM = M / BM; nN = N / BM; nwg = nM * nN; G = G_; c = c_; }
    __host__ __device__ __forceinline__ bool next(int i, Unit& u) const {
        const long L = (long)i * G + c; if (L >= nwg) return false;
        int wgid = (int)L; { const int q = nwg / NXCD, r = nwg % NXCD, xcd = wgid % NXCD, off = wgid / NXCD; wgid = (xcd < r ? xcd * (q + 1) : r * (q + 1) + (xcd - r) * q) + off; }
        const int nig = WGM * nN, gid = wgid / nig, fm = gid * WGM, gsz = (nM - fm) < WGM ? (nM - fm) : WGM;
        u.pm = fm + ((wgid % nig) % gsz); u.pn = (wgid % nig) / gsz; return true;
    }
    __device__ __forceinline__ size_t aoff(const Unit& u, const Gemm& g) const { return (size_t)u.pm * BM * g.lda * 2; }
    __device__ __forceinline__ size_t boff(const Unit& u, const Gemm& g) const { return (size_t)u.pn * BM * g.ldb * 2; }
    __device__ __forceinline__ void a_ready(const Unit&) const {}
    __device__ __forceinline__ void done(const Unit&) const {}
};
struct MergeOrder {
    int G, c; int acol0, acol1, acol2;
    __device__ __forceinline__ bool next(int k, Unit& u) const { const int t = c + (k / 3) * G; if (t >= 256) return false; const int i = k % 3; u.pm = i * 64 + (t >> 2); u.pn = i * 4 + (t & 3); return true; }
    __device__ __forceinline__ size_t aoff(const Unit& u, const Gemm& g) const { const int i = u.pm >> 6; const int ac = acol0 + i * (acol1 - acol0) + (i >> 1) * (acol2 - 2 * acol1 + acol0); return ((size_t)(u.pm & 63) * BM * g.lda + ac) * 2; }
    __device__ __forceinline__ size_t boff(const Unit& u, const Gemm& g) const { return (size_t)u.pn * BM * g.ldb * 2; }
    __device__ __forceinline__ void a_ready(const Unit&) const {}
    __device__ __forceinline__ void done(const Unit&) const {}
};

__device__ __forceinline__ unsigned cvt_pk_bf16(float lo, float hi) { unsigned r; asm volatile("v_cvt_pk_bf16_f32 %0, %1, %2" : "=v"(r) : "v"(lo), "v"(hi)); return r; }
__device__ __forceinline__ float bflo(unsigned w) { return __builtin_bit_cast(float, w << 16); }
__device__ __forceinline__ float bfhi(unsigned w) { return __builtin_bit_cast(float, w & 0xffff0000u); }
__device__ __forceinline__ float fsigmoid(float x) { return __builtin_amdgcn_rcpf(1.0f + __builtin_amdgcn_exp2f(-1.4426950408889634f * x)); }

struct EpiBf16 {
    static constexpr bool PERM = true, AFTER_DRAIN = false;
    bf16_t* O; int ldc;
    __device__ __forceinline__ void operator()(const f32x4 (&acc)[2][2][4][2], const Unit& u, int wr, int wc, int fr, int fq) const {
        const int row0 = u.pm * BM + wr * 64 + fr; const int col0 = u.pn * BM + wc * 32 + 8 * fq;
#pragma unroll
        for (int ai = 0; ai < 2; ++ai)
#pragma unroll
            for (int m = 0; m < 4; ++m) { bf16_t* rowp = O + (size_t)(row0 + ai * HALF + m * 16) * ldc + col0;
#pragma unroll
                for (int bj = 0; bj < 2; ++bj) { const f32x4 v0 = acc[ai][bj][m][0], v1 = acc[ai][bj][m][1];
                    u32x4 w; w.x = cvt_pk_bf16(v0[0], v0[1]); w.y = cvt_pk_bf16(v0[2], v0[3]); w.z = cvt_pk_bf16(v1[0], v1[1]); w.w = cvt_pk_bf16(v1[2], v1[3]);
                    *(u32x4*)(rowp + bj * HALF) = w; } }
    }
};
struct EpiSwiGLU {
    static constexpr bool PERM = true, AFTER_DRAIN = false;
    bf16_t* O; int ldc;
    __device__ __forceinline__ void operator()(const f32x4 (&acc)[2][2][4][2], const Unit& u, int wr, int wc, int fr, int fq) const {
        const int row0 = u.pm * BM + wr * 64 + fr; const int col0 = u.pn * HALF + wc * 32 + 8 * fq;
#pragma unroll
        for (int ai = 0; ai < 2; ++ai)
#pragma unroll
            for (int m = 0; m < 4; ++m) { bf16_t* rowp = O + (size_t)(row0 + ai * HALF + m * 16) * ldc + col0;
                float h[8];
#pragma unroll
                for (int n = 0; n < 2; ++n)
#pragma unroll
                    for (int j = 0; j < 4; ++j) { const float gt = acc[ai][0][m][n][j], up = acc[ai][1][m][n][j]; h[4 * n + j] = gt * fsigmoid(gt) * up; }
                u32x4 w; w.x = cvt_pk_bf16(h[0], h[1]); w.y = cvt_pk_bf16(h[2], h[3]); w.z = cvt_pk_bf16(h[4], h[5]); w.w = cvt_pk_bf16(h[6], h[7]);
                *(u32x4*)rowp = w; }
    }
};
struct EpiResid {
    static constexpr bool PERM = false, AFTER_DRAIN = false;
    const float* base; float* out; int ldc; float alpha;
    __device__ __forceinline__ void operator()(const f32x4 (&acc)[2][2][4][2], const Unit& u, int wr, int wc, int fr, int fq) const {
        const int row0 = u.pm * BM + wr * 64 + fr, col0 = u.pn * BM + wc * 32 + 4 * fq;
#pragma unroll
        for (int ai = 0; ai < 2; ++ai)
#pragma unroll
            for (int m = 0; m < 4; ++m) { const size_t off = (size_t)(row0 + ai * HALF + m * 16) * ldc + col0;
#pragma unroll
                for (int bj = 0; bj < 2; ++bj)
#pragma unroll
                    for (int n = 0; n < 2; ++n) { const f32x4 b = *(const f32x4*)(base + off + bj * HALF + n * 16); *(f32x4*)(out + off + bj * HALF + n * 16) = b + acc[ai][bj][m][n] * alpha; } }
    }
};
struct EpiMerge {
    static constexpr bool PERM = false, AFTER_DRAIN = false;
    const bf16_t* Z; int ldz, gcol; float* MIXF; bf16_t* MIXB;
    __device__ __forceinline__ void operator()(const f32x4 (&acc)[2][2][4][2], const Unit& u, int wr, int wc, int fr, int fq) const {
        const int i = u.pm >> 6, pm = u.pm & 63, pn = u.pn & 3;
        const int row0 = pm * BM + wr * 64 + fr, col0 = pn * BM + wc * 32 + 4 * fq;
#pragma unroll
        for (int ai = 0; ai < 2; ++ai)
#pragma unroll
            for (int m = 0; m < 4; ++m) { const int row = row0 + ai * HALF + m * 16;
#pragma unroll
                for (int bj = 0; bj < 2; ++bj)
#pragma unroll
                    for (int n = 0; n < 2; ++n) { const int col = col0 + bj * HALF + n * 16;
                        const u32x2 gw = *(const u32x2*)(Z + (size_t)row * ldz + gcol + i * 1024 + col);
                        f32x4 v = acc[ai][bj][m][n];
                        v[0] *= fsigmoid(bflo(gw.x)); v[1] *= fsigmoid(bfhi(gw.x)); v[2] *= fsigmoid(bflo(gw.y)); v[3] *= fsigmoid(bfhi(gw.y));
                        float* mp = MIXF + (size_t)row * 1024 + col;
                        if (i == 0) { *(f32x4*)mp = v; }
                        else if (i == 1) { *(f32x4*)mp = *(const f32x4*)mp + v; }
                        else { v = *(const f32x4*)mp + v; u32x2 w; w.x = cvt_pk_bf16(v[0], v[1]); w.y = cvt_pk_bf16(v[2], v[3]); *(u32x2*)(MIXB + (size_t)row * 1024 + col) = w; } } }
    }
};

template <class Epi, class Sched, bool ALIGN_EPI = false, bool SP2 = false>
__device__ __forceinline__ void gemm_phase(PG8_LAS unsigned char* lds, const Gemm g, const Sched& S, const Epi& E) {
    int tid_o = threadIdx.x; asm volatile("" : "+v"(tid_o)); const int tid = tid_o, wid = __builtin_amdgcn_readfirstlane(tid >> 6), lane = tid & 63, wr = wid >> 2, wc = wid & 3, fr = lane & 15, fq = lane >> 4;
    const int K = g.K, nt = K / BK;
    unsigned voffA[2], voffB[2];
#pragma unroll
    for (int i = 0; i < 2; ++i) { int R, C; stage_rc(tid * 16 + i * 8192, R, C); const int Rb = Epi::PERM ? ((R & ~31) + perm32(R & 31)) : R;
        voffA[i] = (unsigned)(R * g.lda + C) * 2u; voffB[i] = (unsigned)(Rb * g.ldb + C) * 2u; }
    const size_t kstep = (size_t)(BK * 2);
    const size_t hstepA = (size_t)HALF * g.lda * 2, hstepB = (size_t)HALF * g.ldb * 2;
    const unsigned ldsw = (unsigned)wid * 1024u;
    const int aoff = lds_byte(wr * 64 + fr, fq * 8), boff = lds_byte(wc * 32 + fr, fq * 8);
#define PG8_SA(b, h) (((b) * 2 + (h)) * HTB)
#define PG8_SB(b, h) ((4 + (b) * 2 + (h)) * HTB)
#define PG8_STAGE(bufoff, gbase, voff) do { _Pragma("unroll") for (int _i = 0; _i < 2; ++_i) \
        __builtin_amdgcn_global_load_lds((const unsigned*)((const char*)(gbase) + (voff)[_i]), (PG8_LAS unsigned*)(lds + (bufoff) + ldsw + _i * 8192), 16, 0, 0); } while (0)
#define PG8_LDA(dst, b, h) do { _Pragma("unroll") for (int m = 0; m < 4; ++m) _Pragma("unroll") for (int k = 0; k < 2; ++k) dst[m][k] = *(const PG8_LAS bf16x8*)(lds + PG8_SA(b, h) + aoff + m * 2048 + k * 1024); } while (0)
#define PG8_LDB(dst, b, h) do { _Pragma("unroll") for (int n = 0; n < 2; ++n) _Pragma("unroll") for (int k = 0; k < 2; ++k) dst[n][k] = *(const PG8_LAS bf16x8*)(lds + PG8_SB(b, h) + boff + n * 2048 + k * 1024); } while (0)
#define PG8_MMA(ai, bj, At, Bt) do { __builtin_amdgcn_s_setprio(1); _Pragma("unroll") for (int m = 0; m < 4; ++m) _Pragma("unroll") for (int n = 0; n < 2; ++n) _Pragma("unroll") for (int k = 0; k < 2; ++k) \
        acc[ai][bj][m][n] = __builtin_amdgcn_mfma_f32_16x16x32_bf16(Bt[n][k], At[m][k], acc[ai][bj][m][n], 0, 0, 0); __builtin_amdgcn_s_setprio(0); } while (0)
#define PG8_WAIT_V(n) asm volatile("s_waitcnt vmcnt(" #n ")" ::: "memory")
#define PG8_WAIT_L(n) asm volatile("s_waitcnt lgkmcnt(" #n ")" ::: "memory")
#define PG8_BAR __builtin_amdgcn_s_barrier()
#define PG8_SCHED __builtin_amdgcn_sched_barrier(0)
    Unit cur, nxt; int ui = 0;
    if (!S.next(0, cur)) return;
    f32x4 acc[2][2][4][2];
#pragma unroll
    for (int a = 0; a < 2; ++a)
#pragma unroll
        for (int b = 0; b < 2; ++b)
#pragma unroll
            for (int m = 0; m < 4; ++m)
#pragma unroll
                for (int n = 0; n < 2; ++n) acc[a][b][m][n] = (f32x4){0.f, 0.f, 0.f, 0.f};
    bf16x8 At[4][2], B0[2][2], B1[2][2];
    const char* cA = (const char*)g.A + S.aoff(cur, g); const char* cB = (const char*)g.Bt + S.boff(cur, g);
    S.a_ready(cur);
    if constexpr (SP2) {
        PG8_STAGE(PG8_SB(0, 0), cB, voffB); PG8_STAGE(PG8_SB(0, 1), cB + hstepB, voffB); PG8_STAGE(PG8_SA(0, 0), cA, voffA); PG8_STAGE(PG8_SA(0, 1), cA + hstepA, voffA);
        if (wr == 1) PG8_BAR;
        PG8_WAIT_V(2); PG8_BAR;
        PG8_STAGE(PG8_SB(1, 0), cB + kstep, voffB); PG8_STAGE(PG8_SA(1, 0), cA + kstep, voffA); PG8_STAGE(PG8_SB(1, 1), cB + hstepB + kstep, voffB);
        PG8_WAIT_V(6); PG8_BAR;
    } else {
        PG8_STAGE(PG8_SB(0, 0), cB, voffB); PG8_STAGE(PG8_SA(0, 0), cA, voffA); PG8_STAGE(PG8_SB(0, 1), cB + hstepB, voffB); PG8_STAGE(PG8_SA(0, 1), cA + hstepA, voffA);
        if (wr == 1) PG8_BAR;
        PG8_WAIT_V(4); PG8_BAR;
        PG8_STAGE(PG8_SB(1, 0), cB + kstep, voffB); PG8_STAGE(PG8_SA(1, 0), cA + kstep, voffA); PG8_STAGE(PG8_SB(1, 1), cB + hstepB + kstep, voffB);
        PG8_WAIT_V(6); PG8_BAR;
    }
    for (;;) {
        const bool has_next = S.next(ui + 1, nxt);
        const char* nA = has_next ? (const char*)g.A + S.aoff(nxt, g) : cA; const char* nB = has_next ? (const char*)g.Bt + S.boff(nxt, g) : cB;
        for (int t = 0; t < nt; t += 2) {
            const bool last = (t == nt - 2);
            const char* a1 = cA + (size_t)(t + 1) * kstep;
            const char* a2 = last ? nA : cA + (size_t)(t + 2) * kstep; const char* b2 = last ? nB : cB + (size_t)(t + 2) * kstep;
            const char* a3 = a2 + kstep; const char* b3 = b2 + kstep;
            if (last && has_next) S.a_ready(nxt);
            if constexpr (SP2) {
            PG8_LDB(B0, 0, 0); PG8_LDB(B1, 0, 1); PG8_SCHED; PG8_LDA(At, 0, 0); PG8_STAGE(PG8_SA(1, 1), a1 + hstepA, voffA);
            PG8_WAIT_V(8); PG8_WAIT_L(0); PG8_BAR; PG8_MMA(0, 0, At, B0); PG8_MMA(0, 1, At, B1); PG8_BAR; PG8_SCHED;
            PG8_LDA(At, 0, 1); PG8_STAGE(PG8_SB(0, 0), b2, voffB); PG8_STAGE(PG8_SB(0, 1), b2 + hstepB, voffB); PG8_STAGE(PG8_SA(0, 0), a2, voffA);
            PG8_WAIT_V(8); PG8_WAIT_L(0); PG8_BAR; PG8_MMA(1, 0, At, B0); PG8_MMA(1, 1, At, B1); PG8_BAR; PG8_SCHED;
            PG8_LDB(B0, 1, 0); PG8_LDB(B1, 1, 1); PG8_SCHED; PG8_LDA(At, 1, 0); PG8_STAGE(PG8_SA(0, 1), a2 + hstepA, voffA);
            PG8_WAIT_V(8); PG8_WAIT_L(0); PG8_BAR; PG8_MMA(0, 0, At, B0); PG8_MMA(0, 1, At, B1); PG8_BAR; PG8_SCHED;
            PG8_LDA(At, 1, 1); PG8_STAGE(PG8_SB(1, 0), b3, voffB); PG8_STAGE(PG8_SB(1, 1), b3 + hstepB, voffB); PG8_STAGE(PG8_SA(1, 0), a3, voffA);
            PG8_WAIT_V(8); PG8_WAIT_L(0); PG8_BAR; PG8_MMA(1, 0, At, B0); PG8_MMA(1, 1, At, B1); PG8_BAR; PG8_SCHED;
            } else {
            PG8_LDB(B0, 0, 0); PG8_SCHED; PG8_LDA(At, 0, 0); PG8_STAGE(PG8_SA(1, 1), a1 + hstepA, voffA);
            PG8_WAIT_L(8); PG8_BAR; PG8_WAIT_L(0); PG8_MMA(0, 0, At, B0); PG8_BAR; PG8_SCHED;
            PG8_LDB(B1, 0, 1); PG8_STAGE(PG8_SB(0, 0), b2, voffB);
            PG8_BAR; PG8_WAIT_L(0); PG8_MMA(0, 1, At, B1); PG8_BAR;
            PG8_LDA(At, 0, 1); PG8_STAGE(PG8_SA(0, 0), a2, voffA);
            PG8_BAR; PG8_WAIT_L(0); PG8_MMA(1, 0, At, B0); PG8_BAR; PG8_SCHED;
            PG8_STAGE(PG8_SB(0, 1), b2 + hstepB, voffB);
            PG8_WAIT_V(6); PG8_BAR; PG8_MMA(1, 1, At, B1); PG8_BAR;
            PG8_LDB(B0, 1, 0); PG8_SCHED; PG8_LDA(At, 1, 0); PG8_STAGE(PG8_SA(0, 1), a2 + hstepA, voffA);
            PG8_WAIT_L(8); PG8_BAR; PG8_WAIT_L(0); PG8_MMA(0, 0, At, B0); PG8_BAR; PG8_SCHED;
            PG8_LDB(B1, 1, 1); PG8_STAGE(PG8_SB(1, 0), b3, voffB);
            PG8_BAR; PG8_WAIT_L(0); PG8_MMA(0, 1, At, B1); PG8_BAR;
            PG8_LDA(At, 1, 1); PG8_STAGE(PG8_SA(1, 0), a3, voffA);
            PG8_BAR; PG8_WAIT_L(0); PG8_MMA(1, 0, At, B0); PG8_BAR; PG8_SCHED;
            PG8_STAGE(PG8_SB(1, 1), b3 + hstepB, voffB);
            PG8_WAIT_V(6); PG8_BAR; PG8_MMA(1, 1, At, B1); PG8_BAR;
            }
        }
        if constexpr (ALIGN_EPI) { if (wr == 0) PG8_BAR; }
        if constexpr (!Epi::AFTER_DRAIN) { E(acc, cur, wr, wc, fr, fq); S.done(cur); }
        if (!has_next) break;
#pragma unroll
        for (int a = 0; a < 2; ++a)
#pragma unroll
            for (int b = 0; b < 2; ++b)
#pragma unroll
                for (int m = 0; m < 4; ++m)
#pragma unroll
                    for (int n = 0; n < 2; ++n) acc[a][b][m][n] = (f32x4){0.f, 0.f, 0.f, 0.f};
        cur = nxt; cA = nA; cB = nB; ++ui;
        if constexpr (ALIGN_EPI) { if (wr == 1) PG8_BAR; }
    }
    PG8_WAIT_V(0);
    if constexpr (!ALIGN_EPI) { if (wr == 0) PG8_BAR; }
    PG8_BAR;
    if constexpr (Epi::AFTER_DRAIN) { E.fused(acc, cur, wr, wc, fr, fq, lds, wid, lane); S.done(cur); }
#undef PG8_SA
#undef PG8_SB
#undef PG8_STAGE
#undef PG8_LDA
#undef PG8_LDB
#undef PG8_MMA
#undef PG8_WAIT_V
#undef PG8_WAIT_L
#undef PG8_BAR
#undef PG8_SCHED
}
}

#define LAS __attribute__((address_space(3)))
typedef unsigned short bf16;
typedef unsigned v4u __attribute__((ext_vector_type(4)));
typedef unsigned v2u __attribute__((ext_vector_type(2)));
typedef float f32x4 __attribute__((ext_vector_type(4)));
typedef float f32x16 __attribute__((ext_vector_type(16)));
typedef short bf16x8 __attribute__((ext_vector_type(8)));
typedef short s16x4 __attribute__((ext_vector_type(4)));
typedef short v4i16_t __attribute__((ext_vector_type(4)));

constexpr int NWAVES = 8, NTHR = 512;
constexpr int M = 16384, DM = 1024, FF = 2816, DIN = 6752, ZP = 6912, SEQ = 4096, DEPTH = 4;
constexpr float EPS = 1e-6f, LOG2E = 1.4426950408889634f;
constexpr int ZQ_NA = 0, ZK_NA = 512, ZV_NA = 1024, ZGQ = 1536, ZGK = 1792, ZGV = 2048, ZGR = 2560, ZGFL = 3072, ZGBL = 3088, ZCQ = 3104, ZCKV = 3360, ZKR = 3616, ZGATE = 3680;
constexpr size_t MiB = 1u << 20;
constexpr size_t WS_WT = 1 * MiB, WS_XN = 57 * MiB, WS_Z = 89 * MiB, WS_QR = 305 * MiB, WS_KVR = 329 * MiB, WS_KF = 361 * MiB, WS_U = 385 * MiB, WS_DD = 449 * MiB, WS_END = 450 * MiB;
constexpr size_t WT_13A = 0, WT_2A = 11534336, WT_IN = 17301504, WT_UQ = 31457280, WT_UKV = 31850496, WT_BR = 32374784, WT_OUT = 35520512, WT_13B = 37617664, WT_2B = 49152000;
constexpr int LDS_BYTES = 135168;

struct Args { const float* in[29]; float* out; unsigned char* ws; };

#define LDS_WAIT() asm volatile("s_waitcnt lgkmcnt(0)" ::: "memory")
__device__ __forceinline__ unsigned pk2(float lo, float hi) { return pg8::cvt_pk_bf16(lo, hi); }
__device__ __forceinline__ float bf2f(bf16 h) { return __builtin_bit_cast(float, (unsigned)h << 16); }
__device__ __forceinline__ bf16 f2bf(float f) { return (bf16)(pk2(f, 0.f) & 0xffffu); }
__device__ __forceinline__ float wave_sum(float v) {
#pragma unroll
    for (int o = 1; o < 64; o <<= 1) v += __shfl_xor(v, o);
    return v;
}
__device__ __forceinline__ int opaque_tid() { int t = threadIdx.x; asm volatile("" : "+v"(t)); return t; }
__device__ __forceinline__ int crow(int r, int hi) { return (r & 3) + 8 * (r >> 2) + 4 * hi; }
__device__ __forceinline__ s16x4 vtr(const LAS char* p) { return __builtin_bit_cast(s16x4, __builtin_amdgcn_ds_read_tr16_b64_v4i16((LAS v4i16_t*)p)); }
__device__ __forceinline__ bf16x8 tr_frag(const LAS char* p0, const LAS char* p1) { const s16x4 a = vtr(p0), b = vtr(p1); return (bf16x8){a[0], a[1], a[2], a[3], b[0], b[1], b[2], b[3]}; }
__device__ __forceinline__ bf16x8 pack8(float a0, float a1, float a2, float a3, float a4, float a5, float a6, float a7) {
    v4u w; w.x = pk2(a0, a1); w.y = pk2(a2, a3); w.z = pk2(a4, a5); w.w = pk2(a6, a7); return __builtin_bit_cast(bf16x8, w);
}
#define MFMA32(a, b, c) __builtin_amdgcn_mfma_f32_32x32x16_bf16((a), (b), (c), 0, 0, 0)
#define MFMA16(a, b, c) __builtin_amdgcn_mfma_f32_16x16x32_bf16((a), (b), (c), 0, 0, 0)

#define XB_TMO      128
#define XB_XCNT(j)  (256  + 64 * (j))
#define XB_XSUB(j)  (1280 + 64 * (j))
#define XB_XGEN(j)  (2304 + 64 * (j))
#define XB_TOP      3328
#define XB_TOPGEN   3392
#define XCD_BAR_WORDS 3456
#define XB_SPIN_CAP (1u << 18)

__device__ __forceinline__ unsigned xb_ld(unsigned* p)              { return __hip_atomic_load(p, __ATOMIC_RELAXED, __HIP_MEMORY_SCOPE_AGENT); }
__device__ __forceinline__ unsigned xb_add(unsigned* p, unsigned v) { return __hip_atomic_fetch_add(p, v, __ATOMIC_RELAXED, __HIP_MEMORY_SCOPE_AGENT); }
__device__ __forceinline__ unsigned xb_xcc_id() { return (unsigned)__builtin_amdgcn_s_getreg((3 << 11) | 20) & 0xFu; }
#define XB_SPIN(cond, bar) do { unsigned _sp = 0; while (cond) { __builtin_amdgcn_s_sleep(1); \
    if ((++_sp & 255u) == 0u) { if (xb_ld(&(bar)[XB_TMO])) break; if (_sp > XB_SPIN_CAP) { atomicAdd(&(bar)[XB_TMO], 1u); break; } } } } while (0)

struct XcdBarrier {
    unsigned* bar; unsigned x;
    volatile LAS unsigned* st;
};

__device__ __forceinline__ XcdBarrier xcd_barrier_post(unsigned* bar, volatile LAS unsigned* st) {
    XcdBarrier b; b.bar = bar; b.x = xb_xcc_id(); b.st = st;
    if (threadIdx.x == 0) (void)xb_add(&bar[XB_XCNT(b.x)], 1u);
    return b;
}
__device__ __forceinline__ void xcd_barrier_complete(unsigned* bar, unsigned x, unsigned& nloc, unsigned& nx) {
    const unsigned G = gridDim.x * gridDim.y * gridDim.z;
    unsigned sum, cnt, mine, sp = 0u;
    for (;;) {
        sum = 0u; cnt = 0u; mine = 0u;
#pragma unroll
        for (unsigned j = 0; j < 16; ++j) { const unsigned c = xb_ld(&bar[XB_XCNT(j)]); sum += c; cnt += (c > 0u) ? 1u : 0u; mine = (j == x) ? c : mine; }
        if (sum == G) break;
        __builtin_amdgcn_s_sleep(1);
        if ((++sp & 255u) == 0u) { if (xb_ld(&bar[XB_TMO])) break; if (sp > XB_SPIN_CAP) { atomicAdd(&bar[XB_TMO], 1u); break; } }
    }
    nloc = mine > 0u ? mine : 1u; nx = cnt > 0u ? cnt : 1u;
}

__device__ __forceinline__ void xcd_barrier(const XcdBarrier& b) {
    asm volatile("s_waitcnt vmcnt(0)" ::: "memory");
    __syncthreads();
    if (threadIdx.x == 0) {
        unsigned* bar = b.bar;
        __builtin_amdgcn_s_waitcnt(0);
        unsigned nloc = b.st[0], nx = b.st[1];
        if (nloc == 0u) { xcd_barrier_complete(bar, b.x, nloc, nx); b.st[0] = nloc; b.st[1] = nx; }
        const unsigned old = xb_add(&bar[XB_XSUB(b.x)], 1u);
        const unsigned gen = old / nloc;
        if (old + 1u == (gen + 1u) * nloc) {
            __builtin_amdgcn_fence(__ATOMIC_RELEASE, "agent");
            asm volatile("s_waitcnt vmcnt(0)" ::: "memory");
            const unsigned og = xb_add(&bar[XB_TOP], 1u);
            const unsigned tg = og / nx;
            if (og + 1u == (tg + 1u) * nx) xb_add(&bar[XB_TOPGEN], 1u);
            else XB_SPIN(xb_ld(&bar[XB_TOPGEN]) == tg, bar);
            __builtin_amdgcn_fence(__ATOMIC_ACQUIRE, "agent");
            xb_add(&bar[XB_XGEN(b.x)], 1u);
            asm volatile("s_waitcnt vmcnt(0)" ::: "memory");
        } else {
            XB_SPIN(xb_ld(&bar[XB_XGEN(b.x)]) == gen, bar);
            __builtin_amdgcn_fence(__ATOMIC_ACQUIRE, "agent");
            asm volatile("s_waitcnt vmcnt(0)" ::: "memory");
        }
    }
    __syncthreads();
}

__device__ __forceinline__ void tr_item(const float* __restrict__ W, int K, int N, bf16* WT, int k0, int n0, int drow0, LAS float* scr, int lane) {
#pragma unroll 8
    for (int i = 0; i < 32; ++i) { const int kk = 2 * i + (lane >> 5); scr[kk * 33 + (lane & 31)] = W[(size_t)(k0 + kk) * N + n0 + (lane & 31)]; }
    LDS_WAIT();
    const int c = lane & 7;
#pragma unroll
    for (int j = 0; j < 4; ++j) { const int n = (lane >> 3) + 8 * j; const LAS float* s = scr + (8 * c) * 33 + n;
        v4u o; o.x = pk2(s[0 * 33], s[1 * 33]); o.y = pk2(s[2 * 33], s[3 * 33]); o.z = pk2(s[4 * 33], s[5 * 33]); o.w = pk2(s[6 * 33], s[7 * 33]);
        *(v4u*)(WT + (size_t)(drow0 + n) * K + k0 + 8 * c) = o; }
    LDS_WAIT();
}
struct MatDesc { const float* W; bf16* WT; int K, N, mode, roff; };
__device__ __forceinline__ MatDesc mat_desc(int idx, int l, const Args& a, unsigned char* wt) {
    MatDesc d; d.mode = 0; d.roff = 0;
    switch (idx) {
    case 0:  d.W = a.in[2] + (size_t)l * DM * FF;  d.WT = (bf16*)(wt + WT_13A); d.K = DM; d.N = FF; d.mode = 1; d.roff = 0; break;
    case 1:  d.W = a.in[3] + (size_t)l * DM * FF;  d.WT = (bf16*)(wt + WT_13A); d.K = DM; d.N = FF; d.mode = 1; d.roff = 1; break;
    case 2:  d.W = a.in[4] + (size_t)l * FF * DM;  d.WT = (bf16*)(wt + WT_2A);  d.K = FF; d.N = DM; break;
    case 3:  d.W = a.in[6] + (size_t)l * DM * DIN; d.WT = (bf16*)(wt + WT_IN);  d.K = DM; d.N = DIN; break;
    case 4:  d.W = a.in[17] + (size_t)l * 256 * 768;  d.WT = (bf16*)(wt + WT_UQ);  d.K = 256; d.N = 768; break;
    case 5:  d.W = a.in[18] + (size_t)l * 256 * 1024; d.WT = (bf16*)(wt + WT_UKV); d.K = 256; d.N = 1024; break;
    case 6:  d.W = a.in[21] + (size_t)l * 512 * 1024; d.WT = (bf16*)(wt + WT_BR);  d.K = 512; d.N = 1024; d.roff = 0; break;
    case 7:  d.W = a.in[22] + (size_t)l * 512 * 1024; d.WT = (bf16*)(wt + WT_BR);  d.K = 512; d.N = 1024; d.roff = 1024; break;
    case 8:  d.W = a.in[23] + (size_t)l * 512 * 1024; d.WT = (bf16*)(wt + WT_BR);  d.K = 512; d.N = 1024; d.roff = 2048; break;
    case 9:  d.W = a.in[24] + (size_t)l * DM * DM;  d.WT = (bf16*)(wt + WT_OUT); d.K = DM; d.N = DM; break;
    case 10: d.W = a.in[26] + (size_t)l * DM * FF;  d.WT = (bf16*)(wt + WT_13B); d.K = DM; d.N = FF; d.mode = 1; d.roff = 0; break;
    case 11: d.W = a.in[27] + (size_t)l * DM * FF;  d.WT = (bf16*)(wt + WT_13B); d.K = DM; d.N = FF; d.mode = 1; d.roff = 1; break;
    default: d.W = a.in[28] + (size_t)l * FF * DM;  d.WT = (bf16*)(wt + WT_2B);  d.K = FF; d.N = DM; break;
    }
    return d;
}
__device__ __forceinline__ void convert_phase(const Args& a, int l, LAS unsigned char* lds) {
    const int tid = opaque_tid(), lane = tid & 63, wave = __builtin_amdgcn_readfirstlane(tid >> 6), gw = blockIdx.x * NWAVES + wave, NGW = gridDim.x * NWAVES, gtid = blockIdx.x * NTHR + tid, gthreads = gridDim.x * NTHR;
    unsigned char* wt = a.ws + WS_WT;
    LAS float* scr = (LAS float*)(lds + wave * 8704);
    int it = gw;
    for (int mi = 0; mi < 13; ++mi) {
        const MatDesc d = mat_desc(mi, l, a, wt);
        const int nblk = d.N / 32, cnt = (d.K / 64) * nblk;
        for (; it < cnt; it += NGW) {
            const int kb = it / nblk, nb = it - kb * nblk, n0 = 32 * nb;
            const int drow0 = d.mode ? (256 * (n0 >> 7) + 128 * d.roff + (n0 & 127)) : (d.roff + n0);
            tr_item(d.W, d.K, d.N, d.WT, 64 * kb, n0, drow0, scr, lane);
        }
        it -= cnt;
    }
    v4u* pad = (v4u*)(wt + WT_IN + (size_t)DIN * DM * 2);
    const int npad = (ZP - DIN) * DM * 2 / 16;
    for (int i = gtid; i < npad; i += gthreads) pad[i] = (v4u){0u, 0u, 0u, 0u};
}
__device__ __forceinline__ void norm_phase(const float* x, const float* g, bf16* XN) {
    const int tid = opaque_tid(), lane = tid & 63, wave = __builtin_amdgcn_readfirstlane(tid >> 6), gw = blockIdx.x * NWAVES + wave, NGW = gridDim.x * NWAVES;
    f32x4 gg[4];
#pragma unroll
    for (int j = 0; j < 4; ++j) gg[j] = ((const f32x4*)g)[lane + 64 * j];
    for (int m = gw; m < M; m += NGW) {
        const f32x4* xr = (const f32x4*)(x + (size_t)m * DM) + lane;
        f32x4 v[4]; float s = 0.f;
#pragma unroll
        for (int j = 0; j < 4; ++j) { v[j] = xr[64 * j]; s += (v[j].x * v[j].x + v[j].y * v[j].y) + (v[j].z * v[j].z + v[j].w * v[j].w); }
        const float r = 1.0f / sqrtf(wave_sum(s) * (1.0f / DM) + EPS);
        v2u* o = (v2u*)(XN + (size_t)m * DM) + lane;
#pragma unroll
        for (int j = 0; j < 4; ++j) { v2u w; w.x = pk2(v[j].x * r * gg[j].x, v[j].y * r * gg[j].y); w.y = pk2(v[j].z * r * gg[j].z, v[j].w * r * gg[j].w); o[64 * j] = w; }
    }
}
__device__ __forceinline__ void token_prep_phase(const Args& a, int l, bf16* Z) {
    const int tid = opaque_tid(), lane = tid & 63, wave = __builtin_amdgcn_readfirstlane(tid >> 6), gw = blockIdx.x * NWAVES + wave, NGW = gridDim.x * NWAVES;
    const float* gna = (lane < 32 ? a.in[7] : a.in[8]) + l * 64 + ((16 * lane) & 63);
    const float* gc = (lane < 32 ? a.in[15] : a.in[16]) + l * 256 + ((8 * lane) & 255);
    float g1[16], g2[8];
#pragma unroll
    for (int j = 0; j < 16; ++j) g1[j] = gna[j] * (lane < 32 ? 0.125f * LOG2E : 1.0f);
#pragma unroll
    for (int j = 0; j < 8; ++j) g2[j] = gc[j];
    for (int m = gw; m < M; m += NGW) {
        bf16* zr = Z + (size_t)m * ZP;
        { v4u w0 = *(const v4u*)(zr + 16 * lane), w1 = *(const v4u*)(zr + 16 * lane + 8);
          float v[16]; const unsigned ww[8] = {w0.x, w0.y, w0.z, w0.w, w1.x, w1.y, w1.z, w1.w};
          float ss = 0.f;
#pragma unroll
          for (int j = 0; j < 8; ++j) { v[2 * j] = pg8::bflo(ww[j]); v[2 * j + 1] = pg8::bfhi(ww[j]); ss += v[2 * j] * v[2 * j] + v[2 * j + 1] * v[2 * j + 1]; }
          ss += __shfl_xor(ss, 1); ss += __shfl_xor(ss, 2);
          const float r = 1.0f / sqrtf(ss * (1.0f / 64.0f) + EPS);
          v4u o0, o1;
          o0.x = pk2(v[0] * r * g1[0], v[1] * r * g1[1]); o0.y = pk2(v[2] * r * g1[2], v[3] * r * g1[3]); o0.z = pk2(v[4] * r * g1[4], v[5] * r * g1[5]); o0.w = pk2(v[6] * r * g1[6], v[7] * r * g1[7]);
          o1.x = pk2(v[8] * r * g1[8], v[9] * r * g1[9]); o1.y = pk2(v[10] * r * g1[10], v[11] * r * g1[11]); o1.z = pk2(v[12] * r * g1[12], v[13] * r * g1[13]); o1.w = pk2(v[14] * r * g1[14], v[15] * r * g1[15]);
          *(v4u*)(zr + 16 * lane) = o0; *(v4u*)(zr + 16 * lane + 8) = o1; }
        { const v4u w = *(const v4u*)(zr + ZCQ + 8 * lane);
          float v[8]; const unsigned ww[4] = {w.x, w.y, w.z, w.w}; float ss = 0.f;
#pragma unroll
          for (int j = 0; j < 4; ++j) { v[2 * j] = pg8::bflo(ww[j]); v[2 * j + 1] = pg8::bfhi(ww[j]); ss += v[2 * j] * v[2 * j] + v[2 * j + 1] * v[2 * j + 1]; }
#pragma unroll
          for (int o = 1; o < 32; o <<= 1) ss += __shfl_xor(ss, o);
          const float r = 1.0f / sqrtf(ss * (1.0f / 256.0f) + EPS);
          v4u o; o.x = pk2(v[0] * r * g2[0], v[1] * r * g2[1]); o.y = pk2(v[2] * r * g2[2], v[3] * r * g2[3]); o.z = pk2(v[4] * r * g2[4], v[5] * r * g2[5]); o.w = pk2(v[6] * r * g2[6], v[7] * r * g2[7]);
          *(v4u*)(zr + ZCQ + 8 * lane) = o; }
    }
}

constexpr int GP = 144;
constexpr int GL_QF = 0, GL_QB = 9216, GL_KF = 18432, GL_KB = 27648, GL_A = 36864  , GL_V = 55296  , GL_G = 73728;
constexpr int GL_BF = GL_G, GL_BB = GL_G + 16384, GL_GLF = GL_G + 32768, GL_GLB = GL_G + 36864;
constexpr int GL_S = GL_G;
constexpr int GL_O = 0;
__device__ __forceinline__ float log_sigmoid(float x) { return fminf(x, 0.f) - log1pf(__expf(-fabsf(x))); }

__device__ __forceinline__ void gla_item(const Args& a, int l, int mode, int b, int h, int c, bf16* Z, float* U, float* Dd, LAS unsigned char* lds_u) {
    LAS char* lds = (LAS char*)lds_u;
    const int tid = opaque_tid(), lane = tid & 63, wave = __builtin_amdgcn_readfirstlane(tid >> 6), r32 = lane & 31, hi = lane >> 5, i16 = lane & 15, blk = (lane >> 4) & 1;
    const int bh = b * 4 + h; const size_t tok0 = (size_t)b * SEQ + 64 * c;
    LAS float* sBf = (LAS float*)(lds + GL_BF); LAS float* sBb = (LAS float*)(lds + GL_BB); LAS float* sGlf = (LAS float*)(lds + GL_GLF); LAS float* sGlb = (LAS float*)(lds + GL_GLB);
    for (int idx = tid; idx < 2048; idx += NTHR) { const int dx = idx >> 10, t = (idx >> 4) & 63, r = idx & 15;
        const float v = bf2f(Z[(tok0 + t) * ZP + (dx ? ZGBL : ZGFL) + r]); (dx ? sGlb : sGlf)[t * 16 + r] = v; }
#pragma unroll
    for (int i = 0; i < 2; ++i) { const int idx = tid + NTHR * i, t = idx >> 4, ch = idx & 15;
        *(LAS v4u*)(lds + GL_V + t * 288 + ch * 16) = *(const v4u*)(Z + (tok0 + t) * ZP + ZGV + 128 * h + 8 * ch); }
    const int j = tid & 63, tg = tid >> 6;
    float upf[16], upb[16];
    { const float* pf = a.in[10] + (size_t)l * 16 * 256 + 64 * h + j; const float* pb = a.in[12] + (size_t)l * 16 * 256 + 64 * h + j;
#pragma unroll
      for (int r = 0; r < 16; ++r) { upf[r] = pf[r * 256]; upb[r] = pb[r * 256]; } }
    const float biasf = a.in[11][l * 256 + 64 * h + j], biasb = a.in[13][l * 256 + 64 * h + j];
    __syncthreads();
#pragma unroll
    for (int i = 0; i < 8; ++i) { const int t = tg + 8 * i; float lf = biasf, lb = biasb;
#pragma unroll
        for (int r = 0; r < 16; ++r) { lf += sGlf[t * 16 + r] * upf[r]; lb += sGlb[t * 16 + r] * upb[r]; }
        sBf[t * 64 + j] = log_sigmoid(lf) * (1.0f / 16.0f); sBb[t * 64 + j] = log_sigmoid(lb) * (1.0f / 16.0f); }
    __syncthreads();
    if (tid < 64) { float acc = 0.f; for (int t = 0; t < 64; ++t) { acc += sBf[t * 64 + tid]; sBf[t * 64 + tid] = acc; } }
    else if (tid < 128) { const int jj = tid - 64; float acc = 0.f; for (int t = 63; t >= 0; --t) { acc += sBb[t * 64 + jj]; sBb[t * 64 + jj] = acc; } }
    __syncthreads();
    { const float bl = sBf[63 * 64 + j], bs0 = sBb[j];
#pragma unroll
      for (int i = 0; i < 8; ++i) { const int t = tg + 8 * i;
          const float q = bf2f(Z[(tok0 + t) * ZP + ZGQ + 64 * h + j]) * 0.125f, k = bf2f(Z[(tok0 + t) * ZP + ZGK + 64 * h + j]);
          const float bf = sBf[t * 64 + j], bs = sBb[t * 64 + j];
          if (mode == 1) {
              *(LAS bf16*)(lds + GL_QF + t * GP + j * 2) = f2bf(q * __expf(bf)); *(LAS bf16*)(lds + GL_KF + t * GP + j * 2) = f2bf(k * __expf(-bf));
              *(LAS bf16*)(lds + GL_QB + t * GP + j * 2) = f2bf(q * __expf(bs)); *(LAS bf16*)(lds + GL_KB + t * GP + j * 2) = f2bf(k * __expf(-bs));
          } else {
              *(LAS bf16*)(lds + GL_A + j * GP + t * 2) = f2bf(k * __expf(bl - bf)); *(LAS bf16*)(lds + GL_A + 9216 + j * GP + t * 2) = f2bf(k * __expf(bs0 - bs));
          } }
      if (mode == 0 && tg == 0) { Dd[((size_t)(0 * 16 + bh) * 64 + c) * 64 + j] = __expf(bl); Dd[((size_t)(1 * 16 + bh) * 64 + c) * 64 + j] = __expf(bs0); } }
    __syncthreads();
    if (mode == 0) {
        const int dir = wave >> 2, dvt = wave & 3;
        float* Ub = U + ((size_t)(dir * 16 + bh) * 64 + c) * 8192;
#pragma unroll
        for (int dkt = 0; dkt < 2; ++dkt) { f32x16 acc = {};
#pragma unroll
            for (int s = 0; s < 4; ++s) {
                const bf16x8 A = *(const LAS bf16x8*)(lds + GL_A + dir * 9216 + (32 * dkt + r32) * GP + (16 * s + 8 * hi) * 2);
                const LAS char* vp = lds + GL_V + (16 * s + 8 * hi + (i16 >> 2)) * 288 + (32 * dvt + 16 * blk + 4 * (i16 & 3)) * 2;
                const bf16x8 B = tr_frag(vp, vp + 4 * 288);
                acc = MFMA32(A, B, acc); }
#pragma unroll
            for (int r = 0; r < 16; ++r) Ub[(32 * dkt + crow(r, hi)) * 128 + 32 * dvt + r32] = acc[r]; }
        __syncthreads();
        return;
    }
    { const int dir = wave >> 2, ti = (wave >> 1) & 1, tj = wave & 1; f32x16 acc = {};
      const int qo = dir ? GL_QB : GL_QF, ko = dir ? GL_KB : GL_KF;
#pragma unroll
      for (int s = 0; s < 4; ++s) {
          const bf16x8 A = *(const LAS bf16x8*)(lds + qo + (32 * ti + r32) * GP + (16 * s + 8 * hi) * 2);
          const bf16x8 B = *(const LAS bf16x8*)(lds + ko + (32 * tj + r32) * GP + (16 * s + 8 * hi) * 2);
          acc = MFMA32(A, B, acc); }
      const int jj = 32 * tj + r32;
#pragma unroll
      for (int r = 0; r < 16; ++r) { const int ii = 32 * ti + crow(r, hi); const bool keep = dir ? (jj > ii) : (jj <= ii);
          *(LAS bf16*)(lds + GL_A + dir * 9216 + ii * GP + jj * 2) = f2bf(keep ? acc[r] : 0.f); } }
#pragma unroll
    for (int i = 0; i < 8; ++i) { const int idx = tid + NTHR * i, dir = idx >> 11, e4 = idx & 2047, dk = e4 >> 5, c4 = e4 & 31;
        const f32x4 v = *(const f32x4*)(U + ((size_t)(dir * 16 + bh) * 64 + c) * 8192 + dk * 128 + 4 * c4);
        v2u w; w.x = pk2(v.x, v.y); w.y = pk2(v.z, v.w); *(LAS v2u*)(lds + GL_S + dir * 18432 + dk * 288 + c4 * 8) = w; }
    __syncthreads();
    f32x16 oacc = {};
    const int ti = wave >> 2, dvt = wave & 3;
#pragma unroll
    for (int dir = 0; dir < 2; ++dir) {
        const int qo = dir ? GL_QB : GL_QF;
#pragma unroll
        for (int s = 0; s < 4; ++s) {
            const bf16x8 A1 = *(const LAS bf16x8*)(lds + GL_A + dir * 9216 + (32 * ti + r32) * GP + (16 * s + 8 * hi) * 2);
            const LAS char* vp = lds + GL_V + (16 * s + 8 * hi + (i16 >> 2)) * 288 + (32 * dvt + 16 * blk + 4 * (i16 & 3)) * 2;
            oacc = MFMA32(A1, tr_frag(vp, vp + 4 * 288), oacc);
            const bf16x8 A2 = *(const LAS bf16x8*)(lds + qo + (32 * ti + r32) * GP + (16 * s + 8 * hi) * 2);
            const LAS char* sp = lds + GL_S + dir * 18432 + (16 * s + 8 * hi + (i16 >> 2)) * 288 + (32 * dvt + 16 * blk + 4 * (i16 & 3)) * 2;
            oacc = MFMA32(A2, tr_frag(sp, sp + 4 * 288), oacc); } }
    __syncthreads();
#pragma unroll
    for (int r = 0; r < 16; ++r) *(LAS float*)(lds + GL_O + ((32 * ti + crow(r, hi)) * 132 + 32 * dvt + r32) * 4) = oacc[r];
    __syncthreads();
    { const int row = tid >> 3, seg = tid & 7; float v[16]; float ss = 0.f;
#pragma unroll
      for (int q4 = 0; q4 < 4; ++q4) { const f32x4 t = *(const LAS f32x4*)(lds + GL_O + (row * 132 + 16 * seg + 4 * q4) * 4); v[4 * q4] = t.x; v[4 * q4 + 1] = t.y; v[4 * q4 + 2] = t.z; v[4 * q4 + 3] = t.w; }
#pragma unroll
      for (int q = 0; q < 16; ++q) ss += v[q] * v[q];
      ss += __shfl_xor(ss, 1); ss += __shfl_xor(ss, 2); ss += __shfl_xor(ss, 4);
      const float rr = 1.0f / sqrtf(ss * (1.0f / 128.0f) + EPS);
      bf16* zr = Z + (tok0 + row) * ZP;
      const v4u g0 = *(const v4u*)(zr + ZGR + 128 * h + 16 * seg), g1 = *(const v4u*)(zr + ZGR + 128 * h + 16 * seg + 8);
      const unsigned gw_[8] = {g0.x, g0.y, g0.z, g0.w, g1.x, g1.y, g1.z, g1.w};
      const float* gn = a.in[14] + l * 128 + 16 * seg;
      unsigned ow[8];
#pragma unroll
      for (int q = 0; q < 8; ++q) { const float ga = pg8::bflo(gw_[q]), gb = pg8::bfhi(gw_[q]);
          const float ya = (v[2 * q] * rr * gn[2 * q]) * (ga * pg8::fsigmoid(ga)), yb = (v[2 * q + 1] * rr * gn[2 * q + 1]) * (gb * pg8::fsigmoid(gb));
          ow[q] = pk2(ya, yb); }
      *(v4u*)(zr + ZGV + 128 * h + 16 * seg) = (v4u){ow[0], ow[1], ow[2], ow[3]}; *(v4u*)(zr + ZGV + 128 * h + 16 * seg + 8) = (v4u){ow[4], ow[5], ow[6], ow[7]}; }
    __syncthreads();
}
__device__ __forceinline__ void gla_scan_phase(float* U, const float* Dd) {
    const int gtid = blockIdx.x * NTHR + opaque_tid(), gthreads = gridDim.x * NTHR;
    for (int ch = gtid; ch < 2 * 16 * 8192; ch += gthreads) {
        const int e = ch & 8191, dirbh = ch >> 13, dir = dirbh >> 4, dk = e >> 7;
        float* Ub = U + (size_t)dirbh * 64 * 8192 + e; const float* Db = Dd + (size_t)dirbh * 64 * 64 + dk;
        float st = 0.f;
        for (int cc = 0; cc < 64; cc += 8) { float u[8], d[8];
#pragma unroll
            for (int k = 0; k < 8; ++k) { const int c = dir ? 63 - (cc + k) : cc + k; u[k] = Ub[(size_t)c * 8192]; d[k] = Db[c * 64]; }
#pragma unroll
            for (int k = 0; k < 8; ++k) { const int c = dir ? 63 - (cc + k) : cc + k; Ub[(size_t)c * 8192] = st; st = d[k] * st + u[k]; } }
    }
}

__device__ __forceinline__ void na_phase(const Args& a, int l, bf16* Z, LAS unsigned char* lds_u, bf16* O, int OP) {
    const int tid = opaque_tid(), lane = tid & 63, wave = __builtin_amdgcn_readfirstlane(tid >> 6), gw = blockIdx.x * NWAVES + wave, NGW = gridDim.x * NWAVES;
    LAS char* wv = (LAS char*)lds_u + wave * 16384;
    const int l15 = lane & 15, quad = lane >> 4;
    for (int it = gw; it < 8192; it += NGW) {
        const int j = it & 3, r = (it >> 2) & 63, h = (it >> 8) & 7, b = it >> 11;
        const int r0 = min(max(r - 4, 0), 56), k0 = min(max(16 * j - 8, 0), 32);
        const size_t tq = (size_t)b * SEQ + r * 64 + 16 * j + l15;
        const bf16* qp = Z + tq * ZP + ZQ_NA + 64 * h + 8 * quad;
        const bf16x8 qf0 = *(const bf16x8*)qp, qf1 = *(const bf16x8*)(qp + 32);
        f32x4 s[16];
#pragma unroll
        for (int kt = 0; kt < 16; ++kt) { const size_t tk = (size_t)b * SEQ + (r0 + (kt >> 1)) * 64 + k0 + 16 * (kt & 1) + l15;
            const bf16* kp = Z + tk * ZP + ZK_NA + 64 * h + 8 * quad;
            const bf16x8 kf0 = *(const bf16x8*)kp, kf1 = *(const bf16x8*)(kp + 32);
            f32x4 acc = {0.f, 0.f, 0.f, 0.f}; acc = MFMA16(kf0, qf0, acc); acc = MFMA16(kf1, qf1, acc); s[kt] = acc; if ((kt & 3) == 3) asm volatile("" ::: "memory"); }
        const int qc = 16 * j + l15, c0 = min(max(qc - 8, 0), 48);
        const float* rp = a.in[9] + (size_t)((l * 8 + h) * 15) * 31;
        float mx = -1e30f;
#pragma unroll
        for (int kt = 0; kt < 16; ++kt)
#pragma unroll
            for (int i = 0; i < 4; ++i) { const int kc = k0 + 16 * (kt & 1) + 4 * quad + i, kr = r0 + (kt >> 1), dr = kr - r + 7, dc = min(max(kc - qc + 15, 0), 30);
                const bool ok = (kc >= c0) && (kc < c0 + 16);
                const float v = ok ? s[kt][i] + rp[dr * 31 + dc] * LOG2E : -1e30f; s[kt][i] = v; mx = fmaxf(mx, v); }
        mx = fmaxf(mx, __shfl_xor(mx, 16)); mx = fmaxf(mx, __shfl_xor(mx, 32));
        float lsum = 0.f;
#pragma unroll
        for (int kt = 0; kt < 16; ++kt)
#pragma unroll
            for (int i = 0; i < 4; ++i) { const float p = __builtin_amdgcn_exp2f(s[kt][i] - mx); s[kt][i] = p; lsum += p; }
        lsum += __shfl_xor(lsum, 16); lsum += __shfl_xor(lsum, 32);
        const float inv = 1.0f / lsum;
        f32x4 o[4];
#pragma unroll
        for (int c = 0; c < 4; ++c) o[c] = (f32x4){0.f, 0.f, 0.f, 0.f};
#pragma unroll
        for (int half = 0; half < 2; ++half) {
            LDS_WAIT();
#pragma unroll
            for (int i = 0; i < 16; ++i) { const int id = lane + 64 * i, tl = id >> 3, ch = id & 7;
                const size_t tk = (size_t)b * SEQ + (r0 + 4 * half + (tl >> 5)) * 64 + k0 + (tl & 31);
                *(LAS v4u*)(wv + tl * 128 + ch * 16) = *(const v4u*)(Z + tk * ZP + ZV_NA + 64 * h + 8 * ch); }
            LDS_WAIT();
#pragma unroll
            for (int s4 = 0; s4 < 4; ++s4) { const int sw = 4 * half + s4;
                const bf16x8 pf = pack8(s[2 * sw][0], s[2 * sw][1], s[2 * sw][2], s[2 * sw][3], s[2 * sw + 1][0], s[2 * sw + 1][1], s[2 * sw + 1][2], s[2 * sw + 1][3]);
#pragma unroll
                for (int c = 0; c < 4; ++c) { const LAS char* vp = wv + (32 * s4 + 4 * quad + (l15 >> 2)) * 128 + (16 * c + 4 * (l15 & 3)) * 2;
                    o[c] = MFMA16(tr_frag(vp, vp + 16 * 128), pf, o[c]); } }
        }
        bf16* op = O + tq * OP + 64 * h + 4 * quad;
#pragma unroll
        for (int c = 0; c < 4; ++c) { v2u w; w.x = pk2(o[c][0] * inv, o[c][1] * inv); w.y = pk2(o[c][2] * inv, o[c][3] * inv); *(v2u*)(op + 16 * c) = w; }
    }
    LDS_WAIT();
}

__device__ __forceinline__ void mla_prep_phase(const Args& a, int l, const bf16* Z, bf16* QR, const bf16* KVR, bf16* KF) {
    const int tid = opaque_tid(), lane = tid & 63, wave = __builtin_amdgcn_readfirstlane(tid >> 6), gw = blockIdx.x * NWAVES + wave, NGW = gridDim.x * NWAVES;
    const float* qn = a.in[19] + l * 192; const float* kn = a.in[20] + l * 192;
    const float gq0 = qn[2 * lane], gq1 = qn[2 * lane + 1], gq2 = qn[128 + lane];
    const float gk0 = kn[2 * lane], gk1 = kn[2 * lane + 1], gk2 = kn[128 + lane];
    const float inv_freq = exp2f(-(float)(lane & 31) * (13.287712379549449f / 32.0f));
    const float qs = 0.07216878364870322f * LOG2E;
    for (int m = gw; m < M; m += NGW) {
        const int pos = m & (SEQ - 1);
        float sn, cs; sincosf((float)pos * inv_freq, &sn, &cs);
        const float krp = bf2f(Z[(size_t)m * ZP + ZKR + lane]);
#pragma unroll
        for (int h = 0; h < 4; ++h) {
            { bf16* qp = QR + (size_t)m * 768 + 192 * h;
              const unsigned w = *(const unsigned*)(qp + 2 * lane); const float n0 = pg8::bflo(w), n1 = pg8::bfhi(w), rp = bf2f(qp[128 + lane]);
              const float r = 1.0f / sqrtf(wave_sum(n0 * n0 + n1 * n1 + rp * rp) * (1.0f / 192.0f) + EPS);
              const float x = rp * r * gq2, y = __shfl_xor(x, 32);
              const float ro = (lane < 32) ? (x * cs - y * sn) : (y * sn + x * cs);
              *(unsigned*)(qp + 2 * lane) = pk2(n0 * r * gq0 * qs, n1 * r * gq1 * qs); qp[128 + lane] = f2bf(ro * qs); }
            { const bf16* kp = KVR + (size_t)m * 1024 + 256 * h; bf16* ko = KF + (size_t)m * 768 + 192 * h;
              const unsigned w = *(const unsigned*)(kp + 2 * lane); const float n0 = pg8::bflo(w), n1 = pg8::bfhi(w), rp = krp;
              const float r = 1.0f / sqrtf(wave_sum(n0 * n0 + n1 * n1 + rp * rp) * (1.0f / 192.0f) + EPS);
              const float x = rp * r * gk2, y = __shfl_xor(x, 32);
              const float ro = (lane < 32) ? (x * cs - y * sn) : (y * sn + x * cs);
              *(unsigned*)(ko + 2 * lane) = pk2(n0 * r * gk0, n1 * r * gk1); ko[128 + lane] = f2bf(ro); }
        }
    }
}

constexpr int MK_P = 400, MV_P = 288, MK_BYTES = 64 * MK_P, MSTG = MK_BYTES + 64 * MV_P;
__device__ __forceinline__ void mla_attn_unit(LAS unsigned char* lds_u, const bf16* QF, const bf16* KF, const bf16* KVR, bf16* Z, int b, int h, int qb) {
    LAS char* lds = (LAS char*)lds_u;
    const int tid = opaque_tid(), lane = tid & 63, wave = __builtin_amdgcn_readfirstlane(tid >> 6), r32 = lane & 31, hi = lane >> 5, i16 = lane & 15, blk = (lane >> 4) & 1;
    const size_t tokb = (size_t)b * SEQ;
    const size_t qtok = tokb + 256 * qb + 32 * wave + r32;
    bf16x8 qf[12];
    { const bf16* qp = QF + qtok * 768 + 192 * h + 8 * hi;
#pragma unroll
      for (int s = 0; s < 12; ++s) qf[s] = *(const bf16x8*)(qp + 16 * s); }
    f32x16 o[4];
#pragma unroll
    for (int c = 0; c < 4; ++c) o[c] = f32x16{};
    float mrun = -1e30f, lrun = 0.f;
    int krow[3], kch[3];
#pragma unroll
    for (int i = 0; i < 3; ++i) { const int id = tid + NTHR * i; krow[i] = id / 24; kch[i] = id - krow[i] * 24; }
    const bf16* kbase = KF + tokb * 768 + 192 * h; const bf16* vbase = KVR + tokb * 1024 + 256 * h + 128;
    v4u kreg[3], vreg[2];
#define MLA_LOAD(t) do { _Pragma("unroll") for (int i = 0; i < 3; ++i) kreg[i] = *(const v4u*)(kbase + (size_t)(64 * (t) + krow[i]) * 768 + 8 * kch[i]); \
        _Pragma("unroll") for (int i = 0; i < 2; ++i) { const int id = tid + NTHR * i; vreg[i] = *(const v4u*)(vbase + (size_t)(64 * (t) + (id >> 4)) * 1024 + 8 * (id & 15)); } } while (0)
#define MLA_STORE(buf) do { _Pragma("unroll") for (int i = 0; i < 3; ++i) *(LAS v4u*)(lds + (buf) * MSTG + krow[i] * MK_P + kch[i] * 16) = kreg[i]; \
        _Pragma("unroll") for (int i = 0; i < 2; ++i) { const int id = tid + NTHR * i; *(LAS v4u*)(lds + (buf) * MSTG + MK_BYTES + (id >> 4) * MV_P + (id & 15) * 16) = vreg[i]; } } while (0)
    MLA_LOAD(0); MLA_STORE(0);
    __syncthreads();
    for (int t = 0; t < 64; ++t) {
        const int cur = t & 1;
        if (t + 1 < 64) MLA_LOAD(t + 1);
        const LAS char* kb = lds + cur * MSTG; const LAS char* vb = kb + MK_BYTES;
        f32x16 p0 = f32x16{}, p1 = f32x16{};
#pragma unroll
        for (int s = 0; s < 12; ++s) {
            const bf16x8 k0 = *(const LAS bf16x8*)(kb + r32 * MK_P + (16 * s + 8 * hi) * 2);
            const bf16x8 k1 = *(const LAS bf16x8*)(kb + (32 + r32) * MK_P + (16 * s + 8 * hi) * 2);
            p0 = MFMA32(k0, qf[s], p0); p1 = MFMA32(k1, qf[s], p1); }
        float mx = fmaxf(p0[0], p1[0]);
#pragma unroll
        for (int r = 1; r < 16; ++r) mx = fmaxf(mx, fmaxf(p0[r], p1[r]));
        mx = fmaxf(mx, __shfl_xor(mx, 32));
        const float mn = fmaxf(mrun, mx), f = __builtin_amdgcn_exp2f(mrun - mn); mrun = mn; lrun *= f;
#pragma unroll
        for (int c = 0; c < 4; ++c)
#pragma unroll
            for (int r = 0; r < 16; ++r) o[c][r] *= f;
        float ls = 0.f;
#pragma unroll
        for (int r = 0; r < 16; ++r) { p0[r] = __builtin_amdgcn_exp2f(p0[r] - mn); p1[r] = __builtin_amdgcn_exp2f(p1[r] - mn); ls += p0[r] + p1[r]; }
        lrun += ls;
        bf16x8 pf[4];
        pf[0] = pack8(p0[0], p0[1], p0[2], p0[3], p0[4], p0[5], p0[6], p0[7]); pf[1] = pack8(p0[8], p0[9], p0[10], p0[11], p0[12], p0[13], p0[14], p0[15]);
        pf[2] = pack8(p1[0], p1[1], p1[2], p1[3], p1[4], p1[5], p1[6], p1[7]); pf[3] = pack8(p1[8], p1[9], p1[10], p1[11], p1[12], p1[13], p1[14], p1[15]);
#pragma unroll
        for (int c = 0; c < 4; ++c)
#pragma unroll
            for (int s = 0; s < 4; ++s) { const LAS char* vp = vb + (16 * s + 4 * hi + (i16 >> 2)) * MV_P + (32 * c + 16 * blk + 4 * (i16 & 3)) * 2;
                o[c] = MFMA32(tr_frag(vp, vp + 8 * MV_P), pf[s], o[c]); }
        if (t + 1 < 64) MLA_STORE(cur ^ 1);
        __syncthreads();
    }
#undef MLA_LOAD
#undef MLA_STORE
    lrun += __shfl_xor(lrun, 32);
    const float inv = 1.0f / lrun;
    bf16* op = Z + qtok * ZP + ZCQ + 128 * h + 4 * hi;
#pragma unroll
    for (int c = 0; c < 4; ++c)
#pragma unroll
        for (int g4 = 0; g4 < 4; ++g4) { v2u w; w.x = pk2(o[c][4 * g4] * inv, o[c][4 * g4 + 1] * inv); w.y = pk2(o[c][4 * g4 + 2] * inv, o[c][4 * g4 + 3] * inv);
            *(v2u*)(op + 32 * c + 8 * g4) = w; }
}

#ifndef DUP_MASK
#define DUP_MASK 0
#endif
#ifndef PH_MASK
#define PH_MASK 0xFFFF
#endif
#if DUP_MASK & 8
#define GSYNC() do { xcd_barrier(xbar); xcd_barrier(xbar); } while (0)
#else
#define GSYNC() xcd_barrier(xbar)
#endif
__global__ void __launch_bounds__(NTHR, 2) mega_fwd(Args a) {
    extern __shared__ __attribute__((aligned(16))) unsigned char lds_raw[];
    LAS unsigned char* lds = (LAS unsigned char*)lds_raw;
    cg::grid_group grid = cg::this_grid();
    if (threadIdx.x < 2) ((volatile LAS unsigned*)(lds + 131072))[threadIdx.x] = 0u;
    __syncthreads();
    const XcdBarrier xbar = xcd_barrier_post((unsigned*)a.ws, (volatile LAS unsigned*)(lds + 131072));
    grid.sync();
    const int G = gridDim.x, bx = blockIdx.x;
    const int vcu = (G % 8 == 0) ? (bx % 8) * (G / 8) + bx / 8 : bx;
    unsigned char* ws = a.ws;
    bf16* XN = (bf16*)(ws + WS_XN); bf16* Z = (bf16*)(ws + WS_Z); bf16* Hb = (bf16*)(ws + WS_Z);
    bf16* QR = (bf16*)(ws + WS_QR); bf16* KVR = (bf16*)(ws + WS_KVR); bf16* KF = (bf16*)(ws + WS_KF);
    float* U = (float*)(ws + WS_U); float* MIXF = (float*)(ws + WS_U); float* Dd = (float*)(ws + WS_DD);
    unsigned char* wt = ws + WS_WT;
    float* out = a.out;
    for (int l = 0; l < DEPTH; ++l) {
        const float* xin = (l == 0) ? a.in[0] : out;
#if (PH_MASK >> 0) & 1
        convert_phase(a, l, lds);
        norm_phase(xin, a.in[1] + l * DM, XN);
#endif
        GSYNC();
#if (PH_MASK >> 1) & 1
        { pg8::Gemm g{XN, (const bf16*)(wt + WT_13A), M, 2 * FF, DM, DM, DM}; pg8::StaticOrder S; S.init(M, 2 * FF, G, bx);
          pg8::EpiSwiGLU E{Hb, FF}; pg8::gemm_phase<pg8::EpiSwiGLU, pg8::StaticOrder, true, true>(lds, g, S, E);
#if DUP_MASK & 1
          __syncthreads(); pg8::gemm_phase<pg8::EpiSwiGLU, pg8::StaticOrder, true, true>(lds, g, S, E);
#endif
        }
#endif
        GSYNC();
#if (PH_MASK >> 2) & 1
        { pg8::Gemm g{Hb, (const bf16*)(wt + WT_2A), M, DM, FF, FF, FF}; pg8::StaticOrder S; S.init(M, DM, G, bx);
          pg8::EpiResid E{xin, out, DM, 0.5f}; pg8::gemm_phase<pg8::EpiResid, pg8::StaticOrder, true, true>(lds, g, S, E); }
#endif
        GSYNC();
#if (PH_MASK >> 3) & 1
        norm_phase(out, a.in[5] + l * DM, XN);
#endif
        GSYNC();
#if (PH_MASK >> 4) & 1
        { pg8::Gemm g{XN, (const bf16*)(wt + WT_IN), M, ZP, DM, DM, DM}; pg8::StaticOrder S; S.init(M, ZP, G, bx);
          pg8::EpiBf16 E{Z, ZP}; pg8::gemm_phase<pg8::EpiBf16, pg8::StaticOrder, true, true>(lds, g, S, E); }
#endif
        GSYNC();
#if (PH_MASK >> 5) & 1
        token_prep_phase(a, l, Z);
        for (int it = bx; it < 1024; it += G) gla_item(a, l, 0, it >> 8, (it >> 6) & 3, it & 63, Z, U, Dd, lds);
#endif
        GSYNC();
#if (PH_MASK >> 6) & 1
        { pg8::Gemm g{Z + ZCQ, (const bf16*)(wt + WT_UQ), M, 768, 256, ZP, 256}; pg8::StaticOrder S; S.init(M, 768, G, bx);
          pg8::EpiBf16 E{QR, 768}; pg8::gemm_phase<pg8::EpiBf16, pg8::StaticOrder, true, true>(lds, g, S, E); }
        __syncthreads();
        { pg8::Gemm g{Z + ZCKV, (const bf16*)(wt + WT_UKV), M, 1024, 256, ZP, 256}; pg8::StaticOrder S; S.init(M, 1024, G, bx);
          pg8::EpiBf16 E{KVR, 1024}; pg8::gemm_phase<pg8::EpiBf16, pg8::StaticOrder, true, true>(lds, g, S, E); }
        __syncthreads();
        gla_scan_phase(U, Dd);
#if DUP_MASK & 4
        na_phase(a, l, Z, lds, (bf16*)(ws + 450 * MiB), 512);
#endif
        na_phase(a, l, Z, lds, Z + ZQ_NA, ZP);
#endif
        GSYNC();
#if (PH_MASK >> 7) & 1
        mla_prep_phase(a, l, Z, QR, KVR, KF);
        __syncthreads();
        for (int it = bx; it < 1024; it += G) gla_item(a, l, 1, it >> 8, (it >> 6) & 3, it & 63, Z, U, Dd, lds);
#endif
        GSYNC();
#if (PH_MASK >> 8) & 1
        for (int u = vcu; u < 256; u += G) { mla_attn_unit(lds, QR, KF, KVR, Z, (u >> 4) >> 2, (u >> 4) & 3, u & 15); __syncthreads(); }
#if DUP_MASK & 2
        for (int u = vcu; u < 256; u += G) { mla_attn_unit(lds, QR, KF, KVR, Z, (u >> 4) >> 2, (u >> 4) & 3, u & 15); __syncthreads(); }
#endif
#endif
        GSYNC();
#if (PH_MASK >> 9) & 1
        { pg8::Gemm g{Z, (const bf16*)(wt + WT_BR), M, 1024, 512, ZP, 512}; pg8::MergeOrder S{G, bx, ZQ_NA, ZGV, ZCQ};
          pg8::EpiMerge E{Z, ZP, ZGATE, MIXF, XN}; pg8::gemm_phase<pg8::EpiMerge, pg8::MergeOrder, true, true>(lds, g, S, E); }
#endif
        GSYNC();
#if (PH_MASK >> 10) & 1
        { pg8::Gemm g{XN, (const bf16*)(wt + WT_OUT), M, DM, DM, DM, DM}; pg8::StaticOrder S; S.init(M, DM, G, bx);
          pg8::EpiResid E{out, out, DM, 1.0f}; pg8::gemm_phase<pg8::EpiResid, pg8::StaticOrder, true, true>(lds, g, S, E); }
#endif
        GSYNC();
#if (PH_MASK >> 11) & 1
        norm_phase(out, a.in[25] + l * DM, XN);
#endif
        GSYNC();
#if (PH_MASK >> 12) & 1
        { pg8::Gemm g{XN, (const bf16*)(wt + WT_13B), M, 2 * FF, DM, DM, DM}; pg8::StaticOrder S; S.init(M, 2 * FF, G, bx);
          pg8::EpiSwiGLU E{Hb, FF}; pg8::gemm_phase<pg8::EpiSwiGLU, pg8::StaticOrder, true, true>(lds, g, S, E);
#if DUP_MASK & 1
          __syncthreads(); pg8::gemm_phase<pg8::EpiSwiGLU, pg8::StaticOrder, true, true>(lds, g, S, E);
#endif
        }
#endif
        GSYNC();
#if (PH_MASK >> 13) & 1
        { pg8::Gemm g{Hb, (const bf16*)(wt + WT_2B), M, DM, FF, FF, FF}; pg8::StaticOrder S; S.init(M, DM, G, bx);
          pg8::EpiResid E{out, out, DM, 0.5f}; pg8::gemm_phase<pg8::EpiResid, pg8::StaticOrder, true, true>(lds, g, S, E); }
#endif
        GSYNC();
    }
}

extern "C" void kernel_launch(void* const* d_in, const int* in_sizes, int n_in, void* d_out, int out_size, void* d_ws, size_t ws_size, hipStream_t stream) {
    static int grid = 0;
    if (grid == 0) {
        if (n_in != 29 || out_size != M * DM || ws_size < WS_END) { fprintf(stderr, "kernel_launch: unexpected shapes / workspace (%d inputs, out %d, ws %zu)\n", n_in, out_size, ws_size); grid = -1; return; }
        int dev = 0, cus = 0, per_cu = 0;
        (void)hipGetDevice(&dev); (void)hipDeviceGetAttribute(&cus, hipDeviceAttributeMultiprocessorCount, dev);
        (void)hipFuncSetAttribute((const void*)mega_fwd, hipFuncAttributeMaxDynamicSharedMemorySize, LDS_BYTES);
        if (hipOccupancyMaxActiveBlocksPerMultiprocessor(&per_cu, (const void*)mega_fwd, NTHR, LDS_BYTES) != hipSuccess || per_cu < 1) per_cu = 1;
        (void)hipGetLastError();
        grid = cus * per_cu; if (grid > 256) grid = 256;
        if (grid <= 0) grid = 256;
    }
    if (grid < 0) return;
    if (hipMemsetAsync(d_ws, 0, 16384, stream) != hipSuccess) { fprintf(stderr, "kernel_launch: memset failed\n"); return; }
    Args a{};
    for (int i = 0; i < 29; ++i) a.in[i] = (const float*)d_in[i];
    a.out = (float*)d_out; a.ws = (unsigned char*)d_ws;
    void* args[] = {&a};
    hipError_t e = hipLaunchCooperativeKernel((const void*)mega_fwd, dim3(grid), dim3(NTHR), args, LDS_BYTES, stream);
    if (e != hipSuccess) fprintf(stderr, "cooperative launch failed: %s (grid %d)\n", hipGetErrorString(e), grid);
}
```

```cpp
#include <hip/hip_runtime.h>
#include <hip/hip_cooperative_groups.h>
#include <cstdio>
#include <cstdint>
namespace cg = cooperative_groups;

namespace pg8 {
#define PG8_LAS __attribute__((address_space(3)))
typedef unsigned short bf16_t;
typedef short bf16x8 __attribute__((ext_vector_type(8)));
typedef float f32x4 __attribute__((ext_vector_type(4)));
typedef unsigned u32x4 __attribute__((ext_vector_type(4)));
typedef unsigned u32x2 __attribute__((ext_vector_type(2)));
constexpr int BM = 256, BK = 64, HALF = 128, HTB = HALF * BK * 2  , STAGE_BYTES = 8 * HTB, NXCD = 8, WGM = 8;

__host__ __device__ __forceinline__ int lds_byte(int r, int c) { const int st = (r >> 4) * 2 + (c >> 5), rr = r & 15, cc = c & 31, ob = rr * 64 + cc * 2; return st * 1024 + (ob ^ (((ob >> 9) & 1) << 5)); }
__host__ __device__ __forceinline__ void stage_rc(int b, int& R, int& C) { const int st = b / 1024, sb = b % 1024, swz = sb ^ (((sb >> 9) & 1) << 5); R = (st >> 1) * 16 + swz / 64; C = (st & 1) * 32 + (swz % 64) / 2; }
__host__ __device__ __forceinline__ int perm32(int rho) { const int n = rho >> 4, i = rho & 15; return 8 * (i >> 2) + 4 * n + (i & 3); }

struct Unit { int pm, pn; };
struct Gemm { const bf16_t* A; const bf16_t* Bt; int M, N, K, lda, ldb; };

struct StaticOrder {
    int nM, nN, nwg, G, c;
    __host__ __device__ void init(int M, int N, int G_, int c_) { nM = M / BM; nN = N / BM; nwg = nM * nN; G = G_; c = c_; }
    __host__ __device__ __forceinline__ bool next(int i, Unit& u) const {
        const long L = (long)i * G + c; if (L >= nwg) return false;
        int wgid = (int)L; { const int q = nwg / NXCD, r = nwg % NXCD, xcd = wgid % NXCD, off = wgid / NXCD; wgid = (xcd < r ? xcd * (q + 1) : r * (q + 1) + (xcd - r) * q) + off; }
        const int nig = WGM * nN, gid = wgid / nig, fm = gid * WGM, gsz = (nM - fm) < WGM ? (nM - fm) : WGM;
        u.pm = fm + ((wgid % nig) % gsz); u.pn = (wgid % nig) / gsz; return true;
    }
    __device__ __forceinline__ size_t aoff(const Unit& u, const Gemm& g) const { return (size_t)u.pm * BM * g.lda * 2; }
    __device__ __forceinline__ size_t boff(const Unit& u, const Gemm& g) const { return (size_t)u.pn * BM * g.ldb * 2; }
    __device__ __forceinline__ void a_ready(const Unit&) const {}
    __device__ __forceinline__ void done(const Unit&) const {}
};
struct MergeOrder {
    int G, c; int acol0, acol1, acol2;
    __device__ __forceinline__ bool next(int k, Unit& u) const { const int t = c + (k / 3) * G; if (t >= 256) return false; const int i = k % 3; u.pm = i * 64 + (t >> 2); u.pn = i * 4 + (t & 3); return true; }
    __device__ __forceinline__ size_t aoff(const Unit& u, const Gemm& g) const { const int i = u.pm >> 6; const int ac = acol0 + i * (acol1 - acol0) + (i >> 1) * (acol2 - 2 * acol1 + acol0); return ((size_t)(u.pm & 63) * BM * g.lda + ac) * 2; }
    __device__ __forceinline__ size_t boff(const Unit& u, const Gemm& g) const { return (size_t)u.pn * BM * g.ldb * 2; }
    __device__ __forceinline__ void a_ready(const Unit&) const {}
    __device__ __forceinline__ void done(const Unit&) const {}
};

__device__ __forceinline__ unsigned cvt_pk_bf16(float lo, float hi) { unsigned r; asm volatile("v_cvt_pk_bf16_f32 %0, %1, %2" : "=v"(r) : "v"(lo), "v"(hi)); return r; }
__device__ __forceinline__ float sx(float v, int mask, int lane) { return __builtin_bit_cast(float, __builtin_amdgcn_ds_bpermute((lane ^ mask) << 2, __builtin_bit_cast(int, v))); }
__device__ __forceinline__ float bflo(unsigned w) { return __builtin_bit_cast(float, w << 16); }
__device__ __forceinline__ float bfhi(unsigned w) { return __builtin_bit_cast(float, w & 0xffff0000u); }
__device__ __forceinline__ float fsigmoid(float x) { return __builtin_amdgcn_rcpf(1.0f + __builtin_amdgcn_exp2f(-1.4426950408889634f * x)); }

struct RowSS { unsigned raw[8]; };
struct NoState {};
__device__ __forceinline__ void load_rowss(RowSS& st, const unsigned* SS, const Unit& u, int wr) {
    int ln; asm volatile("v_mbcnt_lo_u32_b32 %0, -1, 0\n\tv_mbcnt_hi_u32_b32 %0, -1, %0" : "=&v"(ln)); const int row0 = u.pm * BM + wr * 64 + (ln & 15);
#pragma unroll
    for (int ai = 0; ai < 2; ++ai)
#pragma unroll
        for (int m = 0; m < 4; ++m) st.raw[ai * 4 + m] = __hip_atomic_load(SS + row0 + ai * HALF + m * 16, __ATOMIC_RELAXED, __HIP_MEMORY_SCOPE_AGENT);
}
__device__ __forceinline__ float rs_of(unsigned raw) { return 1.0f / sqrtf((float)raw * (1.0f / (4096.0f * 1024.0f)) + 1e-6f); }
template <bool SCALE> struct EpiBf16 {
    static constexpr bool PERM = true, AFTER_DRAIN = false, KEEP = false;
    bf16_t* O; int ldc; const unsigned* SS;
    typedef RowSS State;
    __device__ __forceinline__ void pre(State& st, const Unit& u, int wr) const { if (SCALE) load_rowss(st, SS, u, wr); }
    __device__ __forceinline__ void operator()(const f32x4 (&acc)[2][2][4][2], const Unit& u, int wr, int wc, int fr_, int fq_, const State& st) const {
        int ln; asm volatile("v_mbcnt_lo_u32_b32 %0, -1, 0\n\tv_mbcnt_hi_u32_b32 %0, -1, %0" : "=&v"(ln)); const int fr = ln & 15, fq = ln >> 4;
        const int row0 = u.pm * BM + wr * 64 + fr; const int col0 = u.pn * BM + wc * 32 + 8 * fq;
#pragma unroll
        for (int ai = 0; ai < 2; ++ai)
#pragma unroll
            for (int m = 0; m < 4; ++m) { bf16_t* rowp = O + (size_t)(row0 + ai * HALF + m * 16) * ldc + col0;
                float rs = 1.0f; if (SCALE) rs = rs_of(st.raw[ai * 4 + m]);
#pragma unroll
                for (int bj = 0; bj < 2; ++bj) { const f32x4 v0 = acc[ai][bj][m][0] * rs, v1 = acc[ai][bj][m][1] * rs;
                    u32x4 w; w.x = cvt_pk_bf16(v0[0], v0[1]); w.y = cvt_pk_bf16(v0[2], v0[3]); w.z = cvt_pk_bf16(v1[0], v1[1]); w.w = cvt_pk_bf16(v1[2], v1[3]);
                    *(u32x4*)(rowp + bj * HALF) = w; } }
    }
};
struct EpiSwiGLU {
    static constexpr bool PERM = true, AFTER_DRAIN = false, KEEP = false;
    bf16_t* O; int ldc; const unsigned* SS;
    typedef RowSS State;
    __device__ __forceinline__ void pre(State& st, const Unit& u, int wr) const { load_rowss(st, SS, u, wr); }
    __device__ __forceinline__ void operator()(const f32x4 (&acc)[2][2][4][2], const Unit& u, int wr, int wc, int fr_, int fq_, const State& st) const {
        int ln; asm volatile("v_mbcnt_lo_u32_b32 %0, -1, 0\n\tv_mbcnt_hi_u32_b32 %0, -1, %0" : "=&v"(ln)); const int fr = ln & 15, fq = ln >> 4;
        const int row0 = u.pm * BM + wr * 64 + fr; const int col0 = u.pn * HALF + wc * 32 + 8 * fq;
#pragma unroll
        for (int ai = 0; ai < 2; ++ai)
#pragma unroll
            for (int m = 0; m < 4; ++m) { bf16_t* rowp = O + (size_t)(row0 + ai * HALF + m * 16) * ldc + col0;
                const float rs = rs_of(st.raw[ai * 4 + m]);
                float h[8];
#pragma unroll
                for (int n = 0; n < 2; ++n)
#pragma unroll
                    for (int j = 0; j < 4; ++j) { const float gt = acc[ai][0][m][n][j] * rs, up = acc[ai][1][m][n][j] * rs; h[4 * n + j] = gt * fsigmoid(gt) * up; }
                u32x4 w; w.x = cvt_pk_bf16(h[0], h[1]); w.y = cvt_pk_bf16(h[2], h[3]); w.z = cvt_pk_bf16(h[4], h[5]); w.w = cvt_pk_bf16(h[6], h[7]);
                *(u32x4*)rowp = w; }
    }
};
struct EpiResid {
    static constexpr bool PERM = false, AFTER_DRAIN = false, KEEP = false;
    const float* base; float* out; int ldc; float alpha; bf16_t* XB; unsigned* SS;
    typedef NoState State;
    __device__ __forceinline__ void pre(State&, const Unit&, int) const {}
    __device__ __forceinline__ void operator()(const f32x4 (&acc)[2][2][4][2], const Unit& u, int wr, int wc, int fr_, int fq_, const State&) const {
        int ln; asm volatile("v_mbcnt_lo_u32_b32 %0, -1, 0\n\tv_mbcnt_hi_u32_b32 %0, -1, %0" : "=&v"(ln)); const int fr = ln & 15, fq = ln >> 4;
        const int row0 = u.pm * BM + wr * 64 + fr, col0 = u.pn * BM + wc * 32 + 4 * fq;
        float al = alpha; asm volatile("" : "+v"(al));
        bf16_t* xb = XB; unsigned* ssp = SS; asm volatile("" : "+s"(xb), "+s"(ssp));
#pragma unroll
        for (int ai = 0; ai < 2; ++ai)
#pragma unroll
            for (int m = 0; m < 4; ++m) { const size_t off = (size_t)(row0 + ai * HALF + m * 16) * ldc + col0; float ss = 0.f;
#pragma unroll
                for (int bj = 0; bj < 2; ++bj)
#pragma unroll
                    for (int n = 0; n < 2; ++n) { const f32x4 b = *(const f32x4*)(base + off + bj * HALF + n * 16); const f32x4 v = b + acc[ai][bj][m][n] * al;
                        *(f32x4*)(out + off + bj * HALF + n * 16) = v; ss += (v[0] * v[0] + v[1] * v[1]) + (v[2] * v[2] + v[3] * v[3]);
                        u32x2 w; w.x = cvt_pk_bf16(v[0], v[1]); w.y = cvt_pk_bf16(v[2], v[3]); *(u32x2*)(xb + off + bj * HALF + n * 16) = w; }
                { const int ln = fq * 16 + fr; ss += sx(ss, 16, ln); ss += sx(ss, 32, ln); }
                if (fq == 0) (void)__hip_atomic_fetch_add(ssp + row0 + ai * HALF + m * 16, (unsigned)(ss * 4096.0f + 0.5f), __ATOMIC_RELAXED, __HIP_MEMORY_SCOPE_AGENT); }
    }
};
struct EpiMerge {
    static constexpr bool PERM = false, AFTER_DRAIN = false, KEEP = true;
    const bf16_t* Z; int ldz, gcol; bf16_t* MIXB;
    typedef NoState State;
    __device__ __forceinline__ void pre(State&, const Unit&, int) const {}
    __device__ __forceinline__ bool zero_after(const Unit& u) const { return (u.pm >> 6) == 2; }
    __device__ __forceinline__ void operator()(f32x4 (&acc)[2][2][4][2], const Unit& u, int wr, int wc, int fr_, int fq_, const State&) const {
        int ln; asm volatile("v_mbcnt_lo_u32_b32 %0, -1, 0\n\tv_mbcnt_hi_u32_b32 %0, -1, %0" : "=&v"(ln)); const int fr = ln & 15, fq = ln >> 4;
        const int i = u.pm >> 6, pm = u.pm & 63, pn = u.pn & 3;
        const int row0 = pm * BM + wr * 64 + fr, col0 = pn * BM + wc * 32 + 4 * fq;
#pragma unroll
        for (int ai = 0; ai < 2; ++ai)
#pragma unroll
            for (int m = 0; m < 4; ++m) { const int row = row0 + ai * HALF + m * 16;
#pragma unroll
                for (int bj = 0; bj < 2; ++bj)
#pragma unroll
                    for (int n = 0; n < 2; ++n) { const int col = col0 + bj * HALF + n * 16;
                        const bf16_t* gp = Z + (size_t)row * ldz + gcol + i * 1024 + col;
                        const u32x2 ga = *(const u32x2*)gp;
                        f32x4 ea; ea[0] = __builtin_amdgcn_exp2f(-1.4426950408889634f * bflo(ga.x)); ea[1] = __builtin_amdgcn_exp2f(-1.4426950408889634f * bfhi(ga.x));
                        ea[2] = __builtin_amdgcn_exp2f(-1.4426950408889634f * bflo(ga.y)); ea[3] = __builtin_amdgcn_exp2f(-1.4426950408889634f * bfhi(ga.y));
                        f32x4 v = acc[ai][bj][m][n];
                        if (i < 2) { const u32x2 gb = *(const u32x2*)(gp + 1024);
                            f32x4 eb; eb[0] = __builtin_amdgcn_exp2f(-1.4426950408889634f * bflo(gb.x)); eb[1] = __builtin_amdgcn_exp2f(-1.4426950408889634f * bfhi(gb.x));
                            eb[2] = __builtin_amdgcn_exp2f(-1.4426950408889634f * bflo(gb.y)); eb[3] = __builtin_amdgcn_exp2f(-1.4426950408889634f * bfhi(gb.y));
#pragma unroll
                            for (int j = 0; j < 4; ++j) v[j] *= (1.0f + eb[j]) * __builtin_amdgcn_rcpf(1.0f + ea[j]);
                            acc[ai][bj][m][n] = v;
                        } else {
#pragma unroll
                            for (int j = 0; j < 4; ++j) v[j] *= __builtin_amdgcn_rcpf(1.0f + ea[j]);
                            u32x2 w; w.x = cvt_pk_bf16(v[0], v[1]); w.y = cvt_pk_bf16(v[2], v[3]); *(u32x2*)(MIXB + (size_t)row * 1024 + col) = w; } } }
    }
};

template <class Epi, class Sched, bool ALIGN_EPI = false, bool SP2 = false>
__device__ __forceinline__ void gemm_phase(PG8_LAS unsigned char* lds, const Gemm g, const Sched& S, const Epi& E, const int wv) {
    int tid_o; asm volatile("v_mbcnt_lo_u32_b32 %0, -1, 0\n\tv_mbcnt_hi_u32_b32 %0, -1, %0\n\tv_lshl_or_b32 %0, %1, 6, %0" : "=&v"(tid_o) : "s"(wv)); const int tid = tid_o, wid = __builtin_amdgcn_readfirstlane(tid >> 6), lane = tid & 63, wr = wid >> 2, wc = wid & 3, fr = lane & 15, fq = lane >> 4;
    const int K = g.K, nt = K / BK;
    unsigned voffA[2], voffB[2];
#pragma unroll
    for (int i = 0; i < 2; ++i) { int R, C; stage_rc(tid * 16 + i * 8192, R, C); const int Rb = Epi::PERM ? ((R & ~31) + perm32(R & 31)) : R;
        voffA[i] = (unsigned)(R * g.lda + C) * 2u; voffB[i] = (unsigned)(Rb * g.ldb + C) * 2u; }
    const size_t kstep = (size_t)(BK * 2);
    const size_t hstepA = (size_t)HALF * g.lda * 2, hstepB = (size_t)HALF * g.ldb * 2;
    const unsigned ldsw = (unsigned)wid * 1024u;
    const int aoff = lds_byte(wr * 64 + fr, fq * 8), boff = lds_byte(wc * 32 + fr, fq * 8);
#define PG8_SA(b, h) (((b) * 2 + (h)) * HTB)
#define PG8_SB(b, h) ((4 + (b) * 2 + (h)) * HTB)
#define PG8_STAGE(bufoff, gbase, voff) do { _Pragma("unroll") for (int _i = 0; _i < 2; ++_i) \
        __builtin_amdgcn_global_load_lds((const unsigned*)((const char*)(gbase) + (voff)[_i]), (PG8_LAS unsigned*)(lds + (bufoff) + ldsw + _i * 8192), 16, 0, 0); } while (0)
#define PG8_LDA(dst, b, h) do { _Pragma("unroll") for (int m = 0; m < 4; ++m) _Pragma("unroll") for (int k = 0; k < 2; ++k) dst[m][k] = *(const PG8_LAS bf16x8*)(lds + PG8_SA(b, h) + aoff + m * 2048 + k * 1024); } while (0)
#define PG8_LDB(dst, b, h) do { _Pragma("unroll") for (int n = 0; n < 2; ++n) _Pragma("unroll") for (int k = 0; k < 2; ++k) dst[n][k] = *(const PG8_LAS bf16x8*)(lds + PG8_SB(b, h) + boff + n * 2048 + k * 1024); } while (0)
#define PG8_MMA(ai, bj, At, Bt) do { __builtin_amdgcn_s_setprio(1); _Pragma("unroll") for (int m = 0; m < 4; ++m) _Pragma("unroll") for (int n = 0; n < 2; ++n) _Pragma("unroll") for (int k = 0; k < 2; ++k) \
        acc[ai][bj][m][n] = __builtin_amdgcn_mfma_f32_16x16x32_bf16(Bt[n][k], At[m][k], acc[ai][bj][m][n], 0, 0, 0); __builtin_amdgcn_s_setprio(0); } while (0)
#define PG8_WAIT_V(n) asm volatile("s_waitcnt vmcnt(" #n ")" ::: "memory")
#define PG8_WAIT_L(n) asm volatile("s_waitcnt lgkmcnt(" #n ")" ::: "memory")
#define PG8_BAR __builtin_amdgcn_s_barrier()
#define PG8_SCHED __builtin_amdgcn_sched_barrier(0)
    Unit cur, nxt; int ui = 0;
    if (!S.next(0, cur)) return;
    f32x4 acc[2][2][4][2];
#pragma unroll
    for (int a = 0; a < 2; ++a)
#pragma unroll
        for (int b = 0; b < 2; ++b)
#pragma unroll
            for (int m = 0; m < 4; ++m)
#pragma unroll
                for (int n = 0; n < 2; ++n) acc[a][b][m][n] = (f32x4){0.f, 0.f, 0.f, 0.f};
    bf16x8 At[4][2], B0[2][2], B1[2][2];
    const char* cA = (const char*)g.A + S.aoff(cur, g); const char* cB = (const char*)g.Bt + S.boff(cur, g);
    S.a_ready(cur);
    typename Epi::State est; E.pre(est, cur, wr);
    if constexpr (SP2) {
        PG8_STAGE(PG8_SB(0, 0), cB, voffB); PG8_STAGE(PG8_SB(0, 1), cB + hstepB, voffB); PG8_STAGE(PG8_SA(0, 0), cA, voffA); PG8_STAGE(PG8_SA(0, 1), cA + hstepA, voffA);
        if (wr == 1) PG8_BAR;
        PG8_WAIT_V(2); PG8_BAR;
        PG8_STAGE(PG8_SB(1, 0), cB + kstep, voffB); PG8_STAGE(PG8_SA(1, 0), cA + kstep, voffA); PG8_STAGE(PG8_SB(1, 1), cB + hstepB + kstep, voffB);
        PG8_WAIT_V(6); PG8_BAR;
    } else {
        PG8_STAGE(PG8_SB(0, 0), cB, voffB); PG8_STAGE(PG8_SA(0, 0), cA, voffA); PG8_STAGE(PG8_SB(0, 1), cB + hstepB, voffB); PG8_STAGE(PG8_SA(0, 1), cA + hstepA, voffA);
        if (wr == 1) PG8_BAR;
        PG8_WAIT_V(4); PG8_BAR;
        PG8_STAGE(PG8_SB(1, 0), cB + kstep, voffB); PG8_STAGE(PG8_SA(1, 0), cA + kstep, voffA); PG8_STAGE(PG8_SB(1, 1), cB + hstepB + kstep, voffB);
        PG8_WAIT_V(6); PG8_BAR;
    }
    for (;;) {
        const bool has_next = S.next(ui + 1, nxt);
        const char* nA = has_next ? (const char*)g.A + S.aoff(nxt, g) : cA; const char* nB = has_next ? (const char*)g.Bt + S.boff(nxt, g) : cB;
        for (int t = 0; t < nt; t += 2) {
            const bool last = (t == nt - 2);
            const char* a1 = cA + (size_t)(t + 1) * kstep;
            const char* a2 = last ? nA : cA + (size_t)(t + 2) * kstep; const char* b2 = last ? nB : cB + (size_t)(t + 2) * kstep;
            const char* a3 = a2 + kstep; const char* b3 = b2 + kstep;
            if (last && has_next) S.a_ready(nxt);
            if constexpr (SP2) {
            PG8_LDB(B0, 0, 0); PG8_LDB(B1, 0, 1); PG8_SCHED; PG8_LDA(At, 0, 0); PG8_STAGE(PG8_SA(1, 1), a1 + hstepA, voffA);
            PG8_WAIT_V(8); PG8_WAIT_L(0); PG8_BAR; PG8_MMA(0, 0, At, B0); PG8_MMA(0, 1, At, B1); PG8_BAR; PG8_SCHED;
            PG8_LDA(At, 0, 1); PG8_STAGE(PG8_SB(0, 0), b2, voffB); PG8_STAGE(PG8_SB(0, 1), b2 + hstepB, voffB); PG8_STAGE(PG8_SA(0, 0), a2, voffA);
            PG8_WAIT_V(8); PG8_WAIT_L(0); PG8_BAR; PG8_MMA(1, 0, At, B0); PG8_MMA(1, 1, At, B1); PG8_BAR; PG8_SCHED;
            PG8_LDB(B0, 1, 0); PG8_LDB(B1, 1, 1); PG8_SCHED; PG8_LDA(At, 1, 0); PG8_STAGE(PG8_SA(0, 1), a2 + hstepA, voffA);
            PG8_WAIT_V(8); PG8_WAIT_L(0); PG8_BAR; PG8_MMA(0, 0, At, B0); PG8_MMA(0, 1, At, B1); PG8_BAR; PG8_SCHED;
            PG8_LDA(At, 1, 1); PG8_STAGE(PG8_SB(1, 0), b3, voffB); PG8_STAGE(PG8_SB(1, 1), b3 + hstepB, voffB); PG8_STAGE(PG8_SA(1, 0), a3, voffA);
            PG8_WAIT_V(8); PG8_WAIT_L(0); PG8_BAR; PG8_MMA(1, 0, At, B0); PG8_MMA(1, 1, At, B1); PG8_BAR; PG8_SCHED;
            } else {
            PG8_LDB(B0, 0, 0); PG8_SCHED; PG8_LDA(At, 0, 0); PG8_STAGE(PG8_SA(1, 1), a1 + hstepA, voffA);
            PG8_WAIT_L(8); PG8_BAR; PG8_WAIT_L(0); PG8_MMA(0, 0, At, B0); PG8_BAR; PG8_SCHED;
            PG8_LDB(B1, 0, 1); PG8_STAGE(PG8_SB(0, 0), b2, voffB);
            PG8_BAR; PG8_WAIT_L(0); PG8_MMA(0, 1, At, B1); PG8_BAR;
            PG8_LDA(At, 0, 1); PG8_STAGE(PG8_SA(0, 0), a2, voffA);
            PG8_BAR; PG8_WAIT_L(0); PG8_MMA(1, 0, At, B0); PG8_BAR; PG8_SCHED;
            PG8_STAGE(PG8_SB(0, 1), b2 + hstepB, voffB);
            PG8_WAIT_V(6); PG8_BAR; PG8_MMA(1, 1, At, B1); PG8_BAR;
            PG8_LDB(B0, 1, 0); PG8_SCHED; PG8_LDA(At, 1, 0); PG8_STAGE(PG8_SA(0, 1), a2 + hstepA, voffA);
            PG8_WAIT_L(8); PG8_BAR; PG8_WAIT_L(0); PG8_MMA(0, 0, At, B0); PG8_BAR; PG8_SCHED;
            PG8_LDB(B1, 1, 1); PG8_STAGE(PG8_SB(1, 0), b3, voffB);
            PG8_BAR; PG8_WAIT_L(0); PG8_MMA(0, 1, At, B1); PG8_BAR;
            PG8_LDA(At, 1, 1); PG8_STAGE(PG8_SA(1, 0), a3, voffA);
            PG8_BAR; PG8_WAIT_L(0); PG8_MMA(1, 0, At, B0); PG8_BAR; PG8_SCHED;
            PG8_STAGE(PG8_SB(1, 1), b3 + hstepB, voffB);
            PG8_WAIT_V(6); PG8_BAR; PG8_MMA(1, 1, At, B1); PG8_BAR;
            }
        }
        if constexpr (ALIGN_EPI) { if (wr == 0) PG8_BAR; }
        if constexpr (!Epi::AFTER_DRAIN) { E(acc, cur, wr, wc, fr, fq, est); S.done(cur); }
        if (!has_next) break;
        bool zacc = true; if constexpr (Epi::KEEP) zacc = E.zero_after(cur);
        if (zacc)
#pragma unroll
        for (int a = 0; a < 2; ++a)
#pragma unroll
            for (int b = 0; b < 2; ++b)
#pragma unroll
                for (int m = 0; m < 4; ++m)
#pragma unroll
                    for (int n = 0; n < 2; ++n) acc[a][b][m][n] = (f32x4){0.f, 0.f, 0.f, 0.f};
        cur = nxt; cA = nA; cB = nB; ++ui; E.pre(est, cur, wr);
        if constexpr (ALIGN_EPI) { if (wr == 1) PG8_BAR; }
    }
    PG8_WAIT_V(0);
    if constexpr (!ALIGN_EPI) { if (wr == 0) PG8_BAR; }
    PG8_BAR;
    if constexpr (Epi::AFTER_DRAIN) { E.fused(acc, cur, wr, wc, fr, fq, lds, wid, lane); S.done(cur); }
#undef PG8_SA
#undef PG8_SB
#undef PG8_STAGE
#undef PG8_LDA
#undef PG8_LDB
#undef PG8_MMA
#undef PG8_WAIT_V
#undef PG8_WAIT_L
#undef PG8_BAR
#undef PG8_SCHED
}
}

#define LAS __attribute__((address_space(3)))
typedef unsigned short bf16;
typedef unsigned v4u __attribute__((ext_vector_type(4)));
typedef unsigned v2u __attribute__((ext_vector_type(2)));
typedef float f32x4 __attribute__((ext_vector_type(4)));
typedef float f32x16 __attribute__((ext_vector_type(16)));
typedef short bf16x8 __attribute__((ext_vector_type(8)));
typedef short s16x4 __attribute__((ext_vector_type(4)));
typedef short v4i16_t __attribute__((ext_vector_type(4)));

constexpr int NWAVES = 8, NTHR = 512;
constexpr int M = 16384, DM = 1024, FF = 2816, DIN = 6752, ZP = 6912, SEQ = 4096, DEPTH = 4;
constexpr float EPS = 1e-6f, LOG2E = 1.4426950408889634f;
constexpr int ZQ_NA = 0, ZK_NA = 512, ZV_NA = 1024, ZGQ = 1536, ZGK = 1792, ZGV = 2048, ZGR = 2560, ZGFL = 3072, ZGBL = 3088, ZCQ = 3104, ZCKV = 3360, ZKR = 3616, ZGATE = 3680;
constexpr size_t MiB = 1u << 20;
constexpr size_t WS_WT = 1 * MiB, WS_XN = 57 * MiB, WS_Z = 89 * MiB, WS_QR = 305 * MiB, WS_KVR = 329 * MiB, WS_KF = 361 * MiB, WS_U = 385 * MiB, WS_DD = 449 * MiB, WS_PS = 450 * MiB, WS_END = 453 * MiB;
constexpr size_t WT_13A = 0, WT_2A = 11534336, WT_IN = 17301504, WT_UQ = 31457280, WT_UKV = 31850496, WT_BR = 32374784, WT_OUT = 35520512, WT_13B = 37617664, WT_2B = 49152000;
constexpr int LDS_BYTES = 135168;

struct Args { const float* in[29]; float* out; unsigned char* ws; };
__device__ __forceinline__ const float* kin(int i) { typedef const __attribute__((address_space(4))) unsigned long long* kp_t; kp_t kp = (kp_t)__builtin_amdgcn_kernarg_segment_ptr(); const unsigned long long v = *(volatile kp_t)(kp + i); return (const float*)(const __attribute__((address_space(1))) float*)v; }

#define LDS_WAIT() asm volatile("s_waitcnt lgkmcnt(0)" ::: "memory")
__device__ __forceinline__ unsigned pk2(float lo, float hi) { return pg8::cvt_pk_bf16(lo, hi); }
__device__ __forceinline__ float bf2f(bf16 h) { return __builtin_bit_cast(float, (unsigned)h << 16); }
__device__ __forceinline__ bf16 f2bf(float f) { return (bf16)(pk2(f, 0.f) & 0xffffu); }
__device__ __forceinline__ float wave_sum(float v, int lane) {
#pragma unroll
    for (int o = 1; o < 64; o <<= 1) v += pg8::sx(v, o, lane);
    return v;
}
__device__ __forceinline__ int opaque_tid_w(int wv) { int t; asm volatile("v_mbcnt_lo_u32_b32 %0, -1, 0\n\tv_mbcnt_hi_u32_b32 %0, -1, %0\n\tv_lshl_or_b32 %0, %1, 6, %0" : "=&v"(t) : "s"(wv)); return t; }
__device__ __forceinline__ int opaque_s(int v) { asm volatile("" : "+s"(v)); return v; }
__device__ __forceinline__ int crow(int r, int hi) { return (r & 3) + 8 * (r >> 2) + 4 * hi; }
__device__ __forceinline__ s16x4 vtr(const LAS char* p) { return __builtin_bit_cast(s16x4, __builtin_amdgcn_ds_read_tr16_b64_v4i16((LAS v4i16_t*)p)); }
__device__ __forceinline__ bf16x8 tr_frag(const LAS char* p0, const LAS char* p1) { const s16x4 a = vtr(p0), b = vtr(p1); return (bf16x8){a[0], a[1], a[2], a[3], b[0], b[1], b[2], b[3]}; }
__device__ __forceinline__ bf16x8 pack8(float a0, float a1, float a2, float a3, float a4, float a5, float a6, float a7) {
    v4u w; w.x = pk2(a0, a1); w.y = pk2(a2, a3); w.z = pk2(a4, a5); w.w = pk2(a6, a7); return __builtin_bit_cast(bf16x8, w);
}
#define MFMA32(a, b, c) __builtin_amdgcn_mfma_f32_32x32x16_bf16((a), (b), (c), 0, 0, 0)
#define MFMA16(a, b, c) __builtin_amdgcn_mfma_f32_16x16x32_bf16((a), (b), (c), 0, 0, 0)

#define XB_TMO      128
#define XB_XCNT(j)  (256  + 64 * (j))
#define XB_XSUB(j)  (1280 + 64 * (j))
#define XB_XGEN(j)  (2304 + 64 * (j))
#define XB_TOP      3328
#define XB_TOPGEN   3392
#define XCD_BAR_WORDS 3456
#define XB_SPIN_CAP (1u << 18)

__device__ __forceinline__ unsigned xb_ld(unsigned* p)              { return __hip_atomic_load(p, __ATOMIC_RELAXED, __HIP_MEMORY_SCOPE_AGENT); }
__device__ __forceinline__ unsigned xb_add(unsigned* p, unsigned v) { return __hip_atomic_fetch_add(p, v, __ATOMIC_RELAXED, __HIP_MEMORY_SCOPE_AGENT); }
__device__ __forceinline__ unsigned xb_xcc_id() { return (unsigned)__builtin_amdgcn_s_getreg((3 << 11) | 20) & 0xFu; }
#define XB_SPIN(cond, bar) do { unsigned _sp = 0; while (cond) { __builtin_amdgcn_s_sleep(1); \
    if ((++_sp & 255u) == 0u) { if (xb_ld(&(bar)[XB_TMO])) break; if (_sp > XB_SPIN_CAP) { atomicAdd(&(bar)[XB_TMO], 1u); break; } } } } while (0)

struct XcdBarrier {
    unsigned* bar; unsigned x;
    volatile LAS unsigned* st;
};

__device__ __forceinline__ XcdBarrier xcd_barrier_post(unsigned* bar, volatile LAS unsigned* st) {
    XcdBarrier b; b.bar = bar; b.x = xb_xcc_id(); b.st = st;
    if (threadIdx.x == 0) (void)xb_add(&bar[XB_XCNT(b.x)], 1u);
    return b;
}
__device__ __forceinline__ void xcd_barrier_complete(unsigned* bar, unsigned x, unsigned& nloc, unsigned& nx) {
    const unsigned G = gridDim.x * gridDim.y * gridDim.z;
    unsigned sum, cnt, mine, sp = 0u;
    for (;;) {
        sum = 0u; cnt = 0u; mine = 0u;
#pragma unroll
        for (unsigned j = 0; j < 16; ++j) { const unsigned c = xb_ld(&bar[XB_XCNT(j)]); sum += c; cnt += (c > 0u) ? 1u : 0u; mine = (j == x) ? c : mine; }
        if (sum == G) break;
        __builtin_amdgcn_s_sleep(1);
        if ((++sp & 255u) == 0u) { if (xb_ld(&bar[XB_TMO])) break; if (sp > XB_SPIN_CAP) { atomicAdd(&bar[XB_TMO], 1u); break; } }
    }
    nloc = mine > 0u ? mine : 1u; nx = cnt > 0u ? cnt : 1u;
}

__device__ __forceinline__ void xcd_barrier(const XcdBarrier& b, const bool leader) {
    asm volatile("s_waitcnt vmcnt(0)" ::: "memory");
    __syncthreads();
    if (leader) {
        unsigned* bar = b.bar;
        __builtin_amdgcn_s_waitcnt(0);
        unsigned nloc = b.st[0], nx = b.st[1];
        if (nloc == 0u) { xcd_barrier_complete(bar, b.x, nloc, nx); b.st[0] = nloc; b.st[1] = nx; }
        const unsigned old = xb_add(&bar[XB_XSUB(b.x)], 1u);
        const unsigned gen = old / nloc;
        if (old + 1u == (gen + 1u) * nloc) {
            __builtin_amdgcn_fence(__ATOMIC_RELEASE, "agent");
            asm volatile("s_waitcnt vmcnt(0)" ::: "memory");
            const unsigned og = xb_add(&bar[XB_TOP], 1u);
            const unsigned tg = og / nx;
            if (og + 1u == (tg + 1u) * nx) xb_add(&bar[XB_TOPGEN], 1u);
            else XB_SPIN(xb_ld(&bar[XB_TOPGEN]) == tg, bar);
            __builtin_amdgcn_fence(__ATOMIC_ACQUIRE, "agent");
            xb_add(&bar[XB_XGEN(b.x)], 1u);
            asm volatile("s_waitcnt vmcnt(0)" ::: "memory");
        } else {
            XB_SPIN(xb_ld(&bar[XB_XGEN(b.x)]) == gen, bar);
            __builtin_amdgcn_fence(__ATOMIC_ACQUIRE, "agent");
            asm volatile("s_waitcnt vmcnt(0)" ::: "memory");
        }
    }
    __syncthreads();
}

__device__ __forceinline__ void tr_item(const float* __restrict__ W, int K, int N, bf16* WT, int k0, int n0, int drow0, LAS float* scr, int lane, const float* g) {
    f32x4 wv4[8];
#pragma unroll
    for (int i = 0; i < 8; ++i) wv4[i] = __builtin_nontemporal_load((const f32x4*)(W + (size_t)(k0 + (lane >> 3) + 8 * i) * N + n0 + 4 * (lane & 7)));
#pragma unroll
    for (int i = 0; i < 8; ++i) { LAS float* d = scr + ((lane >> 3) + 8 * i) * 33 + 4 * (lane & 7); d[0] = wv4[i].x; d[1] = wv4[i].y; d[2] = wv4[i].z; d[3] = wv4[i].w; }
    LDS_WAIT();
    const int c = lane & 7;
    f32x4 ga = {1.f, 1.f, 1.f, 1.f}, gb = ga;
    if (g) { ga = *(const f32x4*)(g + k0 + 8 * c); gb = *(const f32x4*)(g + k0 + 8 * c + 4); }
#pragma unroll
    for (int j = 0; j < 4; ++j) { const int n = (lane >> 3) + 8 * j; const LAS float* s = scr + (8 * c) * 33 + n;
        v4u o; o.x = pk2(s[0 * 33] * ga[0], s[1 * 33] * ga[1]); o.y = pk2(s[2 * 33] * ga[2], s[3 * 33] * ga[3]); o.z = pk2(s[4 * 33] * gb[0], s[5 * 33] * gb[1]); o.w = pk2(s[6 * 33] * gb[2], s[7 * 33] * gb[3]);
        *(v4u*)(WT + (size_t)(drow0 + n) * K + k0 + 8 * c) = o; }
    LDS_WAIT();
}
struct MatDesc { const float* W; bf16* WT; const float* g; int K, N, mode, roff; };
__device__ __forceinline__ MatDesc mat_desc(int idx, int l, const Args& a, unsigned char* wt) {
    MatDesc d; d.mode = 0; d.roff = 0; d.g = nullptr;
    switch (idx) {
    case 0:  d.W = kin(2) + (size_t)l * DM * FF;  d.WT = (bf16*)(wt + WT_13A); d.K = DM; d.N = FF; d.mode = 1; d.roff = 0; d.g = kin(1) + l * DM; break;
    case 1:  d.W = kin(3) + (size_t)l * DM * FF;  d.WT = (bf16*)(wt + WT_13A); d.K = DM; d.N = FF; d.mode = 1; d.roff = 1; d.g = kin(1) + l * DM; break;
    case 2:  d.W = kin(4) + (size_t)l * FF * DM;  d.WT = (bf16*)(wt + WT_2A);  d.K = FF; d.N = DM; break;
    case 3:  d.W = kin(6) + (size_t)l * DM * DIN; d.WT = (bf16*)(wt + WT_IN);  d.K = DM; d.N = DIN; d.g = kin(5) + l * DM; break;
    case 4:  d.W = kin(17) + (size_t)l * 256 * 768;  d.WT = (bf16*)(wt + WT_UQ);  d.K = 256; d.N = 768; break;
    case 5:  d.W = kin(18) + (size_t)l * 256 * 1024; d.WT = (bf16*)(wt + WT_UKV); d.K = 256; d.N = 1024; break;
    case 6:  d.W = kin(21) + (size_t)l * 512 * 1024; d.WT = (bf16*)(wt + WT_BR);  d.K = 512; d.N = 1024; d.roff = 0; break;
    case 7:  d.W = kin(22) + (size_t)l * 512 * 1024; d.WT = (bf16*)(wt + WT_BR);  d.K = 512; d.N = 1024; d.roff = 1024; break;
    case 8:  d.W = kin(23) + (size_t)l * 512 * 1024; d.WT = (bf16*)(wt + WT_BR);  d.K = 512; d.N = 1024; d.roff = 2048; break;
    case 9:  d.W = kin(24) + (size_t)l * DM * DM;  d.WT = (bf16*)(wt + WT_OUT); d.K = DM; d.N = DM; break;
    case 10: d.W = kin(26) + (size_t)l * DM * FF;  d.WT = (bf16*)(wt + WT_13B); d.K = DM; d.N = FF; d.mode = 1; d.roff = 0; d.g = kin(25) + l * DM; break;
    case 11: d.W = kin(27) + (size_t)l * DM * FF;  d.WT = (bf16*)(wt + WT_13B); d.K = DM; d.N = FF; d.mode = 1; d.roff = 1; d.g = kin(25) + l * DM; break;
    default: d.W = kin(28) + (size_t)l * FF * DM;  d.WT = (bf16*)(wt + WT_2B);  d.K = FF; d.N = DM; break;
    }
    return d;
}
__device__ __forceinline__ void convert_set(const Args& a, int l, LAS unsigned char* lds, const int wv, const unsigned mask, const int pw, const int np, const bool do_pad) {
    const int tid = opaque_tid_w(wv), lane = tid & 63, wave = __builtin_amdgcn_readfirstlane(tid >> 6), gtid = blockIdx.x * NTHR + tid, gthreads = gridDim.x * NTHR;
    unsigned char* wt = ((unsigned char*)kin(30)) + WS_WT;
    LAS float* scr = (LAS float*)(lds + wave * 8704);
    int it = pw;
    for (int mi = 0; mi < 13; ++mi) {
        if (!((mask >> mi) & 1u)) continue;
        const MatDesc d = mat_desc(mi, l, a, wt);
        const int nblk = d.N / 32, cnt = (d.K / 64) * nblk;
        for (; it < cnt; it += np) {
            const int kb = it / nblk, nb = it - kb * nblk, n0 = 32 * nb;
            const int drow0 = d.mode ? (256 * (n0 >> 7) + 128 * d.roff + (n0 & 127)) : (d.roff + n0);
            tr_item(d.W, d.K, d.N, d.WT, 64 * kb, n0, drow0, scr, lane, d.g);
        }
        it -= cnt;
    }
    if (do_pad) {
        v4u* pad = (v4u*)(wt + WT_IN + (size_t)DIN * DM * 2);
        const int npad = (ZP - DIN) * DM * 2 / 16;
        unsigned zz = 0u; asm volatile("" : "+v"(zz));
        for (int i = gtid; i < npad; i += gthreads) pad[i] = (v4u){zz, zz, zz, zz};
    }
}
__device__ __forceinline__ void convert_tail(const Args& a, int l, LAS unsigned char* lds, const int wv, const unsigned mask, const int nwg) {
    const int G = gridDim.x, bx = opaque_s(blockIdx.x), rem = nwg % G;
    if (rem != 0 && bx < rem) return;
    const int pw = (rem == 0 ? bx : bx - rem) * NWAVES + wv, np = (rem == 0 ? G : G - rem) * NWAVES;
    convert_set(a, l, lds, wv, mask, pw, np, false);
}
__device__ __forceinline__ void xprep_phase(const float* x, bf16* XB, unsigned* SS, const int wv) {
    const int tid = opaque_tid_w(wv), lane = tid & 63, wave = __builtin_amdgcn_readfirstlane(tid >> 6), gw = blockIdx.x * NWAVES + wave, NGW = gridDim.x * NWAVES;
    for (int m = gw; m < M; m += NGW) {
        const f32x4* xr = (const f32x4*)(x + (size_t)m * DM) + lane;
        f32x4 v[4]; float s = 0.f;
#pragma unroll
        for (int j = 0; j < 4; ++j) { v[j] = xr[64 * j]; s += (v[j].x * v[j].x + v[j].y * v[j].y) + (v[j].z * v[j].z + v[j].w * v[j].w); }
        s = wave_sum(s, lane); if (lane == 0) __hip_atomic_store(SS + m, (unsigned)(s * 4096.0f + 0.5f), __ATOMIC_RELAXED, __HIP_MEMORY_SCOPE_AGENT);
        v2u* o = (v2u*)(XB + (size_t)m * DM) + lane;
#pragma unroll
        for (int j = 0; j < 4; ++j) { v2u w; w.x = pk2(v[j].x, v[j].y); w.y = pk2(v[j].z, v[j].w); o[64 * j] = w; }
    }
}
__device__ __forceinline__ void token_prep_phase(const Args& a, int l, bf16* Z, const int wv) {
    const int tid = opaque_tid_w(wv), lane = tid & 63, wave = __builtin_amdgcn_readfirstlane(tid >> 6), gw = blockIdx.x * NWAVES + wave, NGW = gridDim.x * NWAVES;
    const float* gna = (lane < 32 ? kin(7) : kin(8)) + l * 64 + ((16 * lane) & 63);
    const float* gc = (lane < 32 ? kin(15) : kin(16)) + l * 256 + ((8 * lane) & 255);
    float g1[16], g2[8];
#pragma unroll
    for (int j = 0; j < 16; ++j) g1[j] = gna[j] * (lane < 32 ? 0.125f * LOG2E : 1.0f);
#pragma unroll
    for (int j = 0; j < 8; ++j) g2[j] = gc[j];
    for (int m0 = gw; m0 < M; m0 += 4 * NGW) {
        v4u w0[4], w1[4], wc_[4];
#pragma unroll
        for (int t = 0; t < 4; ++t) { const bf16* zr = Z + (size_t)(m0 + t * NGW) * ZP; w0[t] = *(const v4u*)(zr + 16 * lane); w1[t] = *(const v4u*)(zr + 16 * lane + 8); wc_[t] = *(const v4u*)(zr + ZCQ + 8 * lane); }
#pragma unroll
        for (int t = 0; t < 4; ++t) { bf16* zr = Z + (size_t)(m0 + t * NGW) * ZP;
        { float v[16]; const unsigned ww[8] = {w0[t].x, w0[t].y, w0[t].z, w0[t].w, w1[t].x, w1[t].y, w1[t].z, w1[t].w};
          float ss = 0.f;
#pragma unroll
          for (int j = 0; j < 8; ++j) { v[2 * j] = pg8::bflo(ww[j]); v[2 * j + 1] = pg8::bfhi(ww[j]); ss += v[2 * j] * v[2 * j] + v[2 * j + 1] * v[2 * j + 1]; }
          ss += pg8::sx(ss, 1, lane); ss += pg8::sx(ss, 2, lane);
          const float r = 1.0f / sqrtf(ss * (1.0f / 64.0f) + EPS);
          v4u o0, o1;
          o0.x = pk2(v[0] * r * g1[0], v[1] * r * g1[1]); o0.y = pk2(v[2] * r * g1[2], v[3] * r * g1[3]); o0.z = pk2(v[4] * r * g1[4], v[5] * r * g1[5]); o0.w = pk2(v[6] * r * g1[6], v[7] * r * g1[7]);
          o1.x = pk2(v[8] * r * g1[8], v[9] * r * g1[9]); o1.y = pk2(v[10] * r * g1[10], v[11] * r * g1[11]); o1.z = pk2(v[12] * r * g1[12], v[13] * r * g1[13]); o1.w = pk2(v[14] * r * g1[14], v[15] * r * g1[15]);
          *(v4u*)(zr + 16 * lane) = o0; *(v4u*)(zr + 16 * lane + 8) = o1; }
        { float v[8]; const unsigned ww[4] = {wc_[t].x, wc_[t].y, wc_[t].z, wc_[t].w}; float ss = 0.f;
#pragma unroll
          for (int j = 0; j < 4; ++j) { v[2 * j] = pg8::bflo(ww[j]); v[2 * j + 1] = pg8::bfhi(ww[j]); ss += v[2 * j] * v[2 * j] + v[2 * j + 1] * v[2 * j + 1]; }
#pragma unroll
          for (int o = 1; o < 32; o <<= 1) ss += pg8::sx(ss, o, lane);
          const float r = 1.0f / sqrtf(ss * (1.0f / 256.0f) + EPS);
          v4u o; o.x = pk2(v[0] * r * g2[0], v[1] * r * g2[1]); o.y = pk2(v[2] * r * g2[2], v[3] * r * g2[3]); o.z = pk2(v[4] * r * g2[4], v[5] * r * g2[5]); o.w = pk2(v[6] * r * g2[6], v[7] * r * g2[7]);
          *(v4u*)(zr + ZCQ + 8 * lane) = o; } }
    }
}

constexpr int GP = 144;
constexpr int GL_QF = 0, GL_QB = 9216, GL_KF = 18432, GL_KB = 27648, GL_A = 36864  , GL_V = 55296  , GL_G = 73728;
constexpr int GL_BF = GL_G, GL_BB = GL_G + 16640, GL_GLF = GL_G + 33280, GL_GLB = GL_G + 37376, BP = 65;
constexpr int GL_S = GL_G;
constexpr int GL_O = 0;
__device__ __forceinline__ float log_sigmoid(float x) { return fminf(x, 0.f) - 0.6931471805599453f * __builtin_amdgcn_logf(1.0f + __builtin_amdgcn_exp2f(-1.4426950408889634f * fabsf(x))); }

__device__ __forceinline__ void gla_item(const Args& a, int l, int mode, int b, int h, int c, bf16* Z, float* U, const bf16* SP, float* Dd, LAS unsigned char* lds_u, const int wv) {
    LAS char* lds = (LAS char*)lds_u;
    const int tid = opaque_tid_w(wv), lane = tid & 63, wave = __builtin_amdgcn_readfirstlane(tid >> 6), r32 = lane & 31, hi = lane >> 5, i16 = lane & 15, blk = (lane >> 4) & 1;
    const int bh = b * 4 + h; const size_t tok0 = (size_t)b * SEQ + 64 * c;
    LAS float* sBf = (LAS float*)(lds + GL_BF); LAS float* sBb = (LAS float*)(lds + GL_BB); LAS float* sGlf = (LAS float*)(lds + GL_GLF); LAS float* sGlb = (LAS float*)(lds + GL_GLB);
    for (int idx = tid; idx < 2048; idx += NTHR) { const int dx = idx >> 10, t = (idx >> 4) & 63, r = idx & 15;
        const float v = bf2f(Z[(tok0 + t) * ZP + (dx ? ZGBL : ZGFL) + r]); (dx ? sGlb : sGlf)[t * 16 + r] = v; }
#pragma unroll
    for (int i = 0; i < 2; ++i) { const int idx = tid + NTHR * i, t = idx >> 4, ch = idx & 15;
        *(LAS v4u*)(lds + GL_V + t * 288 + ch * 16) = *(const v4u*)(Z + (tok0 + t) * ZP + ZGV + 128 * h + 8 * ch); }
    const int j = tid & 63, tg = tid >> 6;
    float upf[16], upb[16];
    { const float* pf = kin(10) + (size_t)l * 16 * 256 + 64 * h + j; const float* pb = kin(12) + (size_t)l * 16 * 256 + 64 * h + j;
#pragma unroll
      for (int r = 0; r < 16; ++r) { upf[r] = pf[r * 256]; upb[r] = pb[r * 256]; } }
    const float biasf = kin(11)[l * 256 + 64 * h + j], biasb = kin(13)[l * 256 + 64 * h + j];
    bf16 qraw[8], kraw[8];
#pragma unroll
    for (int i = 0; i < 8; ++i) { const int t = tg + 8 * i; qraw[i] = Z[(tok0 + t) * ZP + ZGQ + 64 * h + j]; kraw[i] = Z[(tok0 + t) * ZP + ZGK + 64 * h + j]; }
    __syncthreads();
#pragma unroll
    for (int i = 0; i < 8; ++i) { const int t = tg + 8 * i; float lf = biasf, lb = biasb;
#pragma unroll
        for (int r = 0; r < 16; ++r) { lf += sGlf[t * 16 + r] * upf[r]; lb += sGlb[t * 16 + r] * upb[r]; }
        sBf[t * BP + j] = log_sigmoid(lf) * (1.0f / 16.0f); sBb[t * BP + j] = log_sigmoid(lb) * (1.0f / 16.0f); }
    __syncthreads();
    { LAS float* sB = (wave < 4) ? sBf : sBb; const int jb = (wave & 3) * 16;
      float x[16];
#pragma unroll
      for (int cc = 0; cc < 16; ++cc) x[cc] = sB[lane * BP + jb + cc];
#pragma unroll
      for (int d = 1; d < 64; d <<= 1) {
#pragma unroll
          for (int cc = 0; cc < 16; ++cc) { const float y = __builtin_bit_cast(float, __builtin_amdgcn_ds_bpermute(((wave < 4) ? (lane - d) : (lane + d)) << 2, __builtin_bit_cast(int, x[cc]))); const bool ok = (wave < 4) ? (lane >= d) : (lane + d < 64); x[cc] += ok ? y : 0.f; } }
#pragma unroll
      for (int cc = 0; cc < 16; ++cc) sB[lane * BP + jb + cc] = x[cc]; }
    __syncthreads();
    { const float bl = sBf[63 * BP + j], bs0 = sBb[j];
#pragma unroll
      for (int i = 0; i < 8; ++i) { const int t = tg + 8 * i;
          const float q = bf2f(qraw[i]) * 0.125f, k = bf2f(kraw[i]);
          const float bf = sBf[t * BP + j], bs = sBb[t * BP + j];
          if (mode == 1) {
              *(LAS bf16*)(lds + GL_QF + t * GP + j * 2) = f2bf(q * __expf(bf)); *(LAS bf16*)(lds + GL_KF + t * GP + j * 2) = f2bf(k * __expf(-bf));
              *(LAS bf16*)(lds + GL_QB + t * GP + j * 2) = f2bf(q * __expf(bs)); *(LAS bf16*)(lds + GL_KB + t * GP + j * 2) = f2bf(k * __expf(-bs));
          } else {
              *(LAS bf16*)(lds + GL_A + j * GP + t * 2) = f2bf(k * __expf(bl - bf)); *(LAS bf16*)(lds + GL_A + 9216 + j * GP + t * 2) = f2bf(k * __expf(bs0 - bs));
          } }
      if (mode == 0 && tg == 0) { Dd[((size_t)(0 * 16 + bh) * 64 + c) * 64 + j] = __expf(bl); Dd[((size_t)(1 * 16 + bh) * 64 + c) * 64 + j] = __expf(bs0); } }
    __syncthreads();
    if (mode == 0) {
        const int dir = wave >> 2, dvt = wave & 3;
        float* Ub = U + ((size_t)(dir * 16 + bh) * 64 + c) * 8192;
#pragma unroll
        for (int dkt = 0; dkt < 2; ++dkt) { f32x16 acc = {};
#pragma unroll
            for (int s = 0; s < 4; ++s) {
                const bf16x8 A = *(const LAS bf16x8*)(lds + GL_A + dir * 9216 + (32 * dkt + r32) * GP + (16 * s + 8 * hi) * 2);
                const LAS char* vp = lds + GL_V + (16 * s + 8 * hi + (i16 >> 2)) * 288 + (32 * dvt + 16 * blk + 4 * (i16 & 3)) * 2;
                const bf16x8 B = tr_frag(vp, vp + 4 * 288);
                acc = MFMA32(A, B, acc); }
#pragma unroll
            for (int r = 0; r < 16; ++r) Ub[(32 * dkt + crow(r, hi)) * 128 + 32 * dvt + r32] = acc[r]; }
        __syncthreads();
        return;
    }
    { const int dir = wave >> 2, ti = (wave >> 1) & 1, tj = wave & 1; f32x16 acc = {};
      const int qo = dir ? GL_QB : GL_QF, ko = dir ? GL_KB : GL_KF;
#pragma unroll
      for (int s = 0; s < 4; ++s) {
          const bf16x8 A = *(const LAS bf16x8*)(lds + qo + (32 * ti + r32) * GP + (16 * s + 8 * hi) * 2);
          const bf16x8 B = *(const LAS bf16x8*)(lds + ko + (32 * tj + r32) * GP + (16 * s + 8 * hi) * 2);
          acc = MFMA32(A, B, acc); }
      const int jj = 32 * tj + r32;
#pragma unroll
      for (int r = 0; r < 16; ++r) { const int ii = 32 * ti + crow(r, hi); const bool keep = dir ? (jj > ii) : (jj <= ii);
          *(LAS bf16*)(lds + GL_A + dir * 9216 + ii * GP + jj * 2) = f2bf(keep ? acc[r] : 0.f); } }
#pragma unroll
    for (int i = 0; i < 4; ++i) { const int idx = tid + NTHR * i, dir = idx >> 10, e8 = idx & 1023, dk = e8 >> 4, c8 = e8 & 15;
        *(LAS v4u*)(lds + GL_S + dir * 18432 + dk * 288 + c8 * 16) = *(const v4u*)(SP + ((size_t)(dir * 16 + bh) * 64 + c) * 8192 + dk * 128 + 8 * c8); }
    __syncthreads();
    f32x16 oacc = {};
    const int ti = wave >> 2, dvt = wave & 3;
#pragma unroll
    for (int dir = 0; dir < 2; ++dir) {
        const int qo = dir ? GL_QB : GL_QF;
#pragma unroll
        for (int s = 0; s < 4; ++s) {
            const bf16x8 A1 = *(const LAS bf16x8*)(lds + GL_A + dir * 9216 + (32 * ti + r32) * GP + (16 * s + 8 * hi) * 2);
            const LAS char* vp = lds + GL_V + (16 * s + 8 * hi + (i16 >> 2)) * 288 + (32 * dvt + 16 * blk + 4 * (i16 & 3)) * 2;
            oacc = MFMA32(A1, tr_frag(vp, vp + 4 * 288), oacc);
            const bf16x8 A2 = *(const LAS bf16x8*)(lds + qo + (32 * ti + r32) * GP + (16 * s + 8 * hi) * 2);
            const LAS char* sp = lds + GL_S + dir * 18432 + (16 * s + 8 * hi + (i16 >> 2)) * 288 + (32 * dvt + 16 * blk + 4 * (i16 & 3)) * 2;
            oacc = MFMA32(A2, tr_frag(sp, sp + 4 * 288), oacc); } }
    __syncthreads();
#pragma unroll
    for (int r = 0; r < 16; ++r) *(LAS float*)(lds + GL_O + ((32 * ti + crow(r, hi)) * 132 + 32 * dvt + r32) * 4) = oacc[r];
    __syncthreads();
    { const int row = tid >> 3, seg = tid & 7; float v[16]; float ss = 0.f;
#pragma unroll
      for (int q4 = 0; q4 < 4; ++q4) { const f32x4 t = *(const LAS f32x4*)(lds + GL_O + (row * 132 + 16 * seg + 4 * q4) * 4); v[4 * q4] = t.x; v[4 * q4 + 1] = t.y; v[4 * q4 + 2] = t.z; v[4 * q4 + 3] = t.w; }
#pragma unroll
      for (int q = 0; q < 16; ++q) ss += v[q] * v[q];
      ss += pg8::sx(ss, 1, lane); ss += pg8::sx(ss, 2, lane); ss += pg8::sx(ss, 4, lane);
      const float rr = 1.0f / sqrtf(ss * (1.0f / 128.0f) + EPS);
      bf16* zr = Z + (tok0 + row) * ZP;
      const v4u g0 = *(const v4u*)(zr + ZGR + 128 * h + 16 * seg), g1 = *(const v4u*)(zr + ZGR + 128 * h + 16 * seg + 8);
      const unsigned gw_[8] = {g0.x, g0.y, g0.z, g0.w, g1.x, g1.y, g1.z, g1.w};
      const float* gn = kin(14) + l * 128 + 16 * seg;
      unsigned ow[8];
#pragma unroll
      for (int q = 0; q < 8; ++q) { const float ga = pg8::bflo(gw_[q]), gb = pg8::bfhi(gw_[q]);
          const float ya = (v[2 * q] * rr * gn[2 * q]) * (ga * pg8::fsigmoid(ga)), yb = (v[2 * q + 1] * rr * gn[2 * q + 1]) * (gb * pg8::fsigmoid(gb));
          ow[q] = pk2(ya, yb); }
      *(v4u*)(zr + ZGV + 128 * h + 16 * seg) = (v4u){ow[0], ow[1], ow[2], ow[3]}; *(v4u*)(zr + ZGV + 128 * h + 16 * seg + 8) = (v4u){ow[4], ow[5], ow[6], ow[7]}; }
    __syncthreads();
}
__device__ __forceinline__ void gla_scan_phase(const float* U, bf16* SP, const float* Dd, const int wv) {
    const int gtid = blockIdx.x * NTHR + opaque_tid_w(wv), gthreads = gridDim.x * NTHR;
    for (int ch = gtid; ch < 2 * 16 * 4096; ch += gthreads) {
        const int e = ch & 4095, db = ch >> 12, dir = db >> 4;
        const float* Ub = U + (size_t)db * 64 * 8192 + 2 * e; unsigned* Sb = (unsigned*)SP + (size_t)db * 64 * 4096 + e; const float* Db = Dd + (size_t)db * 64 * 64 + (e >> 6);
        float s0 = 0.f, s1 = 0.f;
        for (int cc = 0; cc < 64; cc += 16) { float u0[16], u1[16], d[16];
#pragma unroll
            for (int k = 0; k < 16; ++k) { const int c = dir ? 63 - (cc + k) : cc + k; const float* p = Ub + (size_t)c * 8192; u0[k] = p[0]; u1[k] = p[1]; d[k] = Db[c * 64]; }
#pragma unroll
            for (int k = 0; k < 16; ++k) { const int c = dir ? 63 - (cc + k) : cc + k; Sb[(size_t)c * 4096] = pk2(s0, s1); s0 = d[k] * s0 + u0[k]; s1 = d[k] * s1 + u1[k]; } }
    }
}

__device__ __forceinline__ void na_phase(const Args& a, int l, bf16* Z, LAS unsigned char* lds_u, bf16* O, int OP, const int wv) {
    const int tid = opaque_tid_w(wv), lane = tid & 63, wave = __builtin_amdgcn_readfirstlane(tid >> 6), NGW = gridDim.x * NWAVES;
    const int bxs = opaque_s(blockIdx.x), Gs = gridDim.x, vcu = (Gs % 8 == 0) ? (bxs % 8) * (Gs / 8) + bxs / 8 : bxs, gw = vcu * NWAVES + wave;
    LAS char* wvl = (LAS char*)lds_u + wave * 16384;
    const int l15 = lane & 15, quad = lane >> 4;
    for (int it = gw; it < 8192; it += NGW) {
        const int j = it & 3, r = (it >> 2) & 63, h = (it >> 8) & 7, b = it >> 11;
        const int r0 = min(max(r - 4, 0), 56), k0 = min(max(16 * j - 8, 0), 32);
        const size_t tq = (size_t)b * SEQ + r * 64 + 16 * j + l15;
        const bf16* qp = Z + tq * ZP + ZQ_NA + 64 * h + 8 * quad;
        const bf16x8 qf0 = *(const bf16x8*)qp, qf1 = *(const bf16x8*)(qp + 32);
        f32x4 s[16];
#pragma unroll
        for (int kt = 0; kt < 16; ++kt) { const size_t tk = (size_t)b * SEQ + (r0 + (kt >> 1)) * 64 + k0 + 16 * (kt & 1) + l15;
            const bf16* kp = Z + tk * ZP + ZK_NA + 64 * h + 8 * quad;
            const bf16x8 kf0 = *(const bf16x8*)kp, kf1 = *(const bf16x8*)(kp + 32);
            f32x4 acc = {0.f, 0.f, 0.f, 0.f}; acc = MFMA16(kf0, qf0, acc); acc = MFMA16(kf1, qf1, acc); s[kt] = acc; if ((kt & 7) == 7) asm volatile("" ::: "memory"); }
        v4u vreg[16];
#pragma unroll
        for (int i = 0; i < 16; ++i) { const int id = lane + 64 * i, tl = id >> 3, ch = id & 7;
            const size_t tk = (size_t)b * SEQ + (r0 + (tl >> 5)) * 64 + k0 + (tl & 31); vreg[i] = *(const v4u*)(Z + tk * ZP + ZV_NA + 64 * h + 8 * ch); }
        const int qc = 16 * j + l15, c0 = min(max(qc - 8, 0), 48);
        const float* rp = kin(9) + (size_t)((l * 8 + h) * 15) * 31;
        float mx = -1e30f;
#pragma unroll
        for (int kt = 0; kt < 16; ++kt)
#pragma unroll
            for (int i = 0; i < 4; ++i) { const int kc = k0 + 16 * (kt & 1) + 4 * quad + i, kr = r0 + (kt >> 1), dr = kr - r + 7, dc = min(max(kc - qc + 15, 0), 30);
                const bool ok = (kc >= c0) && (kc < c0 + 16);
                const float v = ok ? s[kt][i] + rp[dr * 31 + dc] * LOG2E : -1e30f; s[kt][i] = v; mx = fmaxf(mx, v); }
        mx = fmaxf(mx, pg8::sx(mx, 16, lane)); mx = fmaxf(mx, pg8::sx(mx, 32, lane));
        float lsum = 0.f;
#pragma unroll
        for (int kt = 0; kt < 16; ++kt)
#pragma unroll
            for (int i = 0; i < 4; ++i) { const float p = __builtin_amdgcn_exp2f(s[kt][i] - mx); s[kt][i] = p; lsum += p; }
        lsum += pg8::sx(lsum, 16, lane); lsum += pg8::sx(lsum, 32, lane);
        const float inv = 1.0f / lsum;
        f32x4 o[4];
#pragma unroll
        for (int c = 0; c < 4; ++c) o[c] = (f32x4){0.f, 0.f, 0.f, 0.f};
#define NA_LOADV(half) do { _Pragma("unroll") for (int i = 0; i < 16; ++i) { const int id = lane + 64 * i, tl = id >> 3, ch = id & 7; \
            const size_t tk = (size_t)b * SEQ + (r0 + 4 * (half) + (tl >> 5)) * 64 + k0 + (tl & 31); vreg[i] = *(const v4u*)(Z + tk * ZP + ZV_NA + 64 * h + 8 * ch); } } while (0)
#define NA_STOREV() do { _Pragma("unroll") for (int i = 0; i < 16; ++i) { const int id = lane + 64 * i, tl = id >> 3, ch = id & 7; *(LAS v4u*)(wvl + tl * 128 + ch * 16) = vreg[i]; } } while (0)
#pragma unroll
        for (int half = 0; half < 2; ++half) {
            LDS_WAIT();
            NA_STOREV();
            if (half == 0) NA_LOADV(1);
            LDS_WAIT();
#pragma unroll
            for (int s4 = 0; s4 < 4; ++s4) { const int sw = 4 * half + s4;
                const bf16x8 pf = pack8(s[2 * sw][0], s[2 * sw][1], s[2 * sw][2], s[2 * sw][3], s[2 * sw + 1][0], s[2 * sw + 1][1], s[2 * sw + 1][2], s[2 * sw + 1][3]);
#pragma unroll
                for (int c = 0; c < 4; ++c) { const LAS char* vp = wvl + (32 * s4 + 4 * quad + (l15 >> 2)) * 128 + (16 * c + 4 * (l15 & 3)) * 2;
                    o[c] = MFMA16(tr_frag(vp, vp + 16 * 128), pf, o[c]); } }
        }
#undef NA_LOADV
#undef NA_STOREV
        bf16* op = O + tq * OP + 64 * h + 4 * quad;
#pragma unroll
        for (int c = 0; c < 4; ++c) { v2u w; w.x = pk2(o[c][0] * inv, o[c][1] * inv); w.y = pk2(o[c][2] * inv, o[c][3] * inv); *(v2u*)(op + 16 * c) = w; }
    }
    LDS_WAIT();
}

__device__ __forceinline__ void mla_prep_phase(const Args& a, int l, const bf16* Z, bf16* QR, const bf16* KVR, bf16* KF, const int wv) {
    const int tid = opaque_tid_w(wv), lane = tid & 63, wave = __builtin_amdgcn_readfirstlane(tid >> 6), gw = blockIdx.x * NWAVES + wave, NGW = gridDim.x * NWAVES;
    const float* qn = kin(19) + l * 192; const float* kn = kin(20) + l * 192;
    const float gq0 = qn[2 * lane], gq1 = qn[2 * lane + 1], gq2 = qn[128 + lane];
    const float gk0 = kn[2 * lane], gk1 = kn[2 * lane + 1], gk2 = kn[128 + lane];
    const float inv_freq = exp2f(-(float)(lane & 31) * (13.287712379549449f / 32.0f));
    const float qs = 0.07216878364870322f * LOG2E;
    for (int m0 = gw; m0 < M; m0 += 2 * NGW) {
        unsigned qw[2][4], kw[2][4]; float qrp[2][4], krp[2], sn[2], cs[2];
#pragma unroll
        for (int t = 0; t < 2; ++t) { const int m = m0 + t * NGW;
            krp[t] = bf2f(Z[(size_t)m * ZP + ZKR + lane]);
#pragma unroll
            for (int h = 0; h < 4; ++h) { const bf16* qp = QR + (size_t)m * 768 + 192 * h; qw[t][h] = *(const unsigned*)(qp + 2 * lane); qrp[t][h] = bf2f(qp[128 + lane]);
                kw[t][h] = *(const unsigned*)(KVR + (size_t)m * 1024 + 256 * h + 2 * lane); }
            sincosf((float)(m & (SEQ - 1)) * inv_freq, &sn[t], &cs[t]); }
        float sq[2][4], sk[2][4];
#pragma unroll
        for (int t = 0; t < 2; ++t)
#pragma unroll
            for (int h = 0; h < 4; ++h) { const float a0 = pg8::bflo(qw[t][h]), a1 = pg8::bfhi(qw[t][h]), b0 = pg8::bflo(kw[t][h]), b1 = pg8::bfhi(kw[t][h]);
                sq[t][h] = a0 * a0 + a1 * a1 + qrp[t][h] * qrp[t][h]; sk[t][h] = b0 * b0 + b1 * b1 + krp[t] * krp[t]; }
#pragma unroll
        for (int o = 1; o < 64; o <<= 1)
#pragma unroll
            for (int t = 0; t < 2; ++t)
#pragma unroll
                for (int h = 0; h < 4; ++h) { sq[t][h] += pg8::sx(sq[t][h], o, lane); sk[t][h] += pg8::sx(sk[t][h], o, lane); }
#pragma unroll
        for (int t = 0; t < 2; ++t) { const int m = m0 + t * NGW;
#pragma unroll
            for (int h = 0; h < 4; ++h) {
                { bf16* qp = QR + (size_t)m * 768 + 192 * h; const float r = 1.0f / sqrtf(sq[t][h] * (1.0f / 192.0f) + EPS);
                  const float x = qrp[t][h] * r * gq2, y = pg8::sx(x, 32, lane); const float ro = (lane < 32) ? (x * cs[t] - y * sn[t]) : (y * sn[t] + x * cs[t]);
                  *(unsigned*)(qp + 2 * lane) = pk2(pg8::bflo(qw[t][h]) * r * gq0 * qs, pg8::bfhi(qw[t][h]) * r * gq1 * qs); qp[128 + lane] = f2bf(ro * qs); }
                { bf16* ko = KF + (size_t)m * 768 + 192 * h; const float r = 1.0f / sqrtf(sk[t][h] * (1.0f / 192.0f) + EPS);
                  const float x = krp[t] * r * gk2, y = pg8::sx(x, 32, lane); const float ro = (lane < 32) ? (x * cs[t] - y * sn[t]) : (y * sn[t] + x * cs[t]);
                  *(unsigned*)(ko + 2 * lane) = pk2(pg8::bflo(kw[t][h]) * r * gk0, pg8::bfhi(kw[t][h]) * r * gk1); ko[128 + lane] = f2bf(ro); } } }
    }
}

constexpr int MK_P = 400, MV_P = 288, MK_BYTES = 64 * MK_P, MV_BYTES = 64 * MV_P, MV_OFF = 2 * MK_BYTES;
__device__ __forceinline__ void mla_attn_unit(LAS unsigned char* lds_u, const bf16* QF, const bf16* KF, const bf16* KVR, bf16* Z, int b, int h, int qb, const int wv) {
    LAS char* lds = (LAS char*)lds_u;
    const int tid = opaque_tid_w(wv), lane = tid & 63, wave = __builtin_amdgcn_readfirstlane(tid >> 6), r32 = lane & 31, hi = lane >> 5, i16 = lane & 15, blk = (lane >> 4) & 1;
    const size_t tokb = (size_t)b * SEQ;
    const size_t qtok = tokb + 256 * qb + 32 * wave + r32;
    bf16x8 qf[12];
    { const bf16* qp = QF + qtok * 768 + 192 * h + 8 * hi;
#pragma unroll
      for (int s = 0; s < 12; ++s) qf[s] = *(const bf16x8*)(qp + 16 * s); }
    f32x16 o[4];
#pragma unroll
    for (int c = 0; c < 4; ++c) o[c] = f32x16{};
    float mrun = -1e30f, lrun = 0.f;
    int krow[3], kch[3];
#pragma unroll
    for (int i = 0; i < 3; ++i) { const int id = tid + NTHR * i; krow[i] = id / 24; kch[i] = id - krow[i] * 24; }
    const bf16* kbase = KF + tokb * 768 + 192 * h; const bf16* vbase = KVR + tokb * 1024 + 256 * h + 128;
    v4u kreg[3], vreg[2];
#define MLA_LOAD(t) do { _Pragma("unroll") for (int i = 0; i < 3; ++i) kreg[i] = *(const v4u*)(kbase + (size_t)(64 * (t) + krow[i]) * 768 + 8 * kch[i]); \
        _Pragma("unroll") for (int i = 0; i < 2; ++i) { const int id = tid + NTHR * i; vreg[i] = *(const v4u*)(vbase + (size_t)(64 * (t) + (id >> 4)) * 1024 + 8 * (id & 15)); } } while (0)
#define MLA_STORE(kbuf, vbuf) do { _Pragma("unroll") for (int i = 0; i < 3; ++i) *(LAS v4u*)(lds + (kbuf) * MK_BYTES + krow[i] * MK_P + kch[i] * 16) = kreg[i]; \
        _Pragma("unroll") for (int i = 0; i < 2; ++i) { const int id = tid + NTHR * i; *(LAS v4u*)(lds + MV_OFF + (vbuf) * MV_BYTES + (id >> 4) * MV_P + (id & 15) * 16) = vreg[i]; } } while (0)
#define SB() __builtin_amdgcn_sched_barrier(0)
    bf16x8 fr8[8];
#define MLA_VLD(vb_, j, n) do { const LAS char* vp = (vb_) + (16 * ((n) >> 2) + 4 * hi + (i16 >> 2)) * MV_P + (32 * ((n) & 3) + 16 * blk + 4 * (i16 & 3)) * 2; fr8[j] = tr_frag(vp, vp + 8 * MV_P); } while (0)
#define MLA_PV(vb_) do { _Pragma("unroll") for (int j = 0; j < 8; ++j) MLA_VLD(vb_, j, j); SB(); \
        _Pragma("unroll") for (int n = 0; n < 16; ++n) { o[n & 3] = MFMA32(fr8[n & 7], pf[n >> 2], o[n & 3]); if (n < 8) MLA_VLD(vb_, n & 7, n + 8); SB(); } } while (0)
    const bool late = wave >= 4;
    bf16x8 pf[4] = {};
    MLA_LOAD(0); MLA_STORE(0, 0);
    __syncthreads();
    int vcur = 0, vprev = 2;
    for (int t = 0; t < 64; ++t) {
        const int cur = t & 1;
        if (t + 1 < 64) MLA_LOAD(t + 1);
        const LAS char* kb = lds + cur * MK_BYTES; const LAS char* vb = lds + MV_OFF + vcur * MV_BYTES;
        if (late && t > 0) MLA_PV(lds + MV_OFF + vprev * MV_BYTES);
        f32x16 p0 = f32x16{}, p1 = f32x16{};
#define MLA_KLD(j, s, half) fr8[j] = *(const LAS bf16x8*)(kb + ((half) * 32 + r32) * MK_P + (16 * (s) + 8 * hi) * 2)
#pragma unroll
        for (int i = 0; i < 4; ++i) { MLA_KLD(2 * i, i, 0); MLA_KLD(2 * i + 1, i, 1); }
        SB();
#pragma unroll
        for (int g = 0; g < 3; ++g)
#pragma unroll
            for (int i = 0; i < 4; ++i) {
                p0 = MFMA32(fr8[2 * i], qf[4 * g + i], p0); if (g < 2) MLA_KLD(2 * i, 4 * (g + 1) + i, 0);
                p1 = MFMA32(fr8[2 * i + 1], qf[4 * g + i], p1); if (g < 2) MLA_KLD(2 * i + 1, 4 * (g + 1) + i, 1);
                SB(); }
#undef MLA_KLD
        float mx = fmaxf(p0[0], p1[0]);
#pragma unroll
        for (int r = 1; r < 16; ++r) mx = fmaxf(mx, fmaxf(p0[r], p1[r]));
        mx = fmaxf(mx, pg8::sx(mx, 32, lane));
        if (__any(mx > mrun)) {
            const float mn_ = fmaxf(mrun, mx), f = __builtin_amdgcn_exp2f(mrun - mn_); mrun = mn_; lrun *= f;
#pragma unroll
            for (int c = 0; c < 4; ++c)
#pragma unroll
                for (int r = 0; r < 16; ++r) o[c][r] *= f;
        }
        const float mn = mrun;
        float ls = 0.f;
#pragma unroll
        for (int r = 0; r < 16; ++r) { p0[r] = __builtin_amdgcn_exp2f(p0[r] - mn); p1[r] = __builtin_amdgcn_exp2f(p1[r] - mn); ls += p0[r] + p1[r]; }
        lrun += ls;
        pf[0] = pack8(p0[0], p0[1], p0[2], p0[3], p0[4], p0[5], p0[6], p0[7]); pf[1] = pack8(p0[8], p0[9], p0[10], p0[11], p0[12], p0[13], p0[14], p0[15]);
        pf[2] = pack8(p1[0], p1[1], p1[2], p1[3], p1[4], p1[5], p1[6], p1[7]); pf[3] = pack8(p1[8], p1[9], p1[10], p1[11], p1[12], p1[13], p1[14], p1[15]);
        if (!late) MLA_PV(vb);
        const int vnext = (vcur == 2) ? 0 : vcur + 1;
        if (t + 1 < 64) MLA_STORE(cur ^ 1, vnext);
        vprev = vcur; vcur = vnext;
        __syncthreads();
    }
    if (late) MLA_PV(lds + MV_OFF + vprev * MV_BYTES);
#undef MLA_LOAD
#undef MLA_STORE
#undef MLA_PV
#undef MLA_VLD
#undef SB
    lrun += pg8::sx(lrun, 32, lane);
    const float inv = 1.0f / lrun;
    bf16* op = Z + qtok * ZP + ZCQ + 128 * h + 4 * hi;
#pragma unroll
    for (int c = 0; c < 4; ++c)
#pragma unroll
        for (int g4 = 0; g4 < 4; ++g4) { v2u w; w.x = pk2(o[c][4 * g4] * inv, o[c][4 * g4 + 1] * inv); w.y = pk2(o[c][4 * g4 + 2] * inv, o[c][4 * g4 + 3] * inv);
            *(v2u*)(op + 32 * c + 8 * g4) = w; }
}

__device__ __forceinline__ void zero_f32(float* p, int n, const int wv) { const int t0 = opaque_s(blockIdx.x) * NTHR + opaque_tid_w(wv); for (int i = t0; i < n; i += gridDim.x * NTHR) __hip_atomic_store((unsigned*)p + i, 0u, __ATOMIC_RELAXED, __HIP_MEMORY_SCOPE_AGENT); }
#ifndef DUP_MASK
#define DUP_MASK 0
#endif
#ifndef PH_MASK
#define PH_MASK 0xFFFF
#endif
#if DUP_MASK & 8
#define GSYNC() do { xcd_barrier(xbar, leader); xcd_barrier(xbar, leader); } while (0)
#else
#define GSYNC() xcd_barrier(xbar, leader)
#endif
__global__ void __launch_bounds__(NTHR, 2) mega_fwd(Args a) {
    extern __shared__ __attribute__((aligned(16))) unsigned char lds_raw[];
    LAS unsigned char* lds = (LAS unsigned char*)lds_raw;
    cg::grid_group grid = cg::this_grid();
    const int wv = __builtin_amdgcn_readfirstlane((int)threadIdx.x >> 6);
    const bool leader = (threadIdx.x == 0);
    if (threadIdx.x < 2) ((volatile LAS unsigned*)(lds + 131072))[threadIdx.x] = 0u;
    __syncthreads();
    const XcdBarrier xbar = xcd_barrier_post((unsigned*)((unsigned char*)kin(30)), (volatile LAS unsigned*)(lds + 131072));
    const int G = gridDim.x, bx = blockIdx.x;
    const int vcu = (G % 8 == 0) ? (bx % 8) * (G / 8) + bx / 8 : bx;
#define ws ((unsigned char*)kin(30))
#define XB ((bf16*)(ws + WS_XN))
#define MIXB ((bf16*)(ws + WS_QR))
#define Z ((bf16*)(ws + WS_Z))
#define Hb ((bf16*)(ws + WS_Z))
#define SSa ((unsigned*)(ws + WS_PS))
#define SSb (SSa + M)
#define SSc (SSa + 2 * M)
#define QR ((bf16*)(ws + WS_QR))
#define KVR ((bf16*)(ws + WS_KVR))
#define KF ((bf16*)(ws + WS_KF))
#define U ((float*)(ws + WS_U))
#define MIXF ((float*)(ws + WS_U))
#define Dd ((float*)(ws + WS_DD))
#define wt (ws + WS_WT)
#define out ((float*)kin(29))
#ifdef TSEL_MASK
    unsigned long long tacc = 0, tprev = __builtin_amdgcn_s_memrealtime();
#endif
    for (int step = 0; step < DEPTH * 12; ++step) {
        const int l = step / 12, ph = step - l * 12;
        const float* xin = (l == 0) ? kin(0) : out;
        switch (ph) {
        case 0: {
#if (PH_MASK >> 0) & 1
        convert_set(a, l, lds, wv, (l == 0) ? 0x80Bu : 0x80Au  , opaque_s(bx) * NWAVES + wv, G * NWAVES, true);
        if (l == 0) { xprep_phase(kin(0), XB, SSc, wv); zero_f32((float*)SSa, 2 * M, wv); }
#endif
        } break;
        case 1: case 10: {
#if (PH_MASK >> 1) & 1
        { const bool second = (ph == 10);
          pg8::Gemm g{XB, (const bf16*)(wt + (second ? WT_13B : WT_13A)), M, 2 * FF, DM, DM, DM}; pg8::StaticOrder S; S.init(M, 2 * FF, opaque_s(G), opaque_s(bx));
          pg8::EpiSwiGLU E{Hb, FF, second ? SSb : SSc}; pg8::gemm_phase<pg8::EpiSwiGLU, pg8::StaticOrder, true, true>(lds, g, S, E, wv);
#if DUP_MASK & 1
          __syncthreads(); pg8::gemm_phase<pg8::EpiSwiGLU, pg8::StaticOrder, true, true>(lds, g, S, E, wv);
#endif
          __syncthreads();
          convert_tail(a, l, lds, wv, second ? 0x1000u   : 0x404u  , (M / 256) * (2 * FF / 256));
          if (second && l + 1 < DEPTH) convert_tail(a, l + 1, lds, wv, 0x001u  , (M / 256) * (2 * FF / 256));
        }
#endif
        } break;
        case 2: case 9: case 11: {
#if (PH_MASK >> 2) & 1
        { const bool isout = (ph == 9);
          const bf16* Ap = isout ? MIXB : Hb; const size_t wo = isout ? WT_OUT : (ph == 2 ? WT_2A : WT_2B); const int Kd = isout ? DM : FF;
          pg8::Gemm g{Ap, (const bf16*)(wt + wo), M, DM, Kd, Kd, Kd}; pg8::StaticOrder S; S.init(M, DM, opaque_s(G), opaque_s(bx));
          unsigned* SSp = SSa + (isout ? M : (ph == 2 ? 0 : 2 * M));
          pg8::EpiResid E{(ph == 2) ? xin : (const float*)out, out, DM, isout ? 1.0f : 0.5f, XB, SSp}; pg8::gemm_phase<pg8::EpiResid, pg8::StaticOrder, true, true>(lds, g, S, E, wv); }
#endif
        } break;
        case 3: {
#if (PH_MASK >> 4) & 1
        { pg8::Gemm g{XB, (const bf16*)(wt + WT_IN), M, ZP, DM, DM, DM}; pg8::StaticOrder S; S.init(M, ZP, opaque_s(G), opaque_s(bx));
          pg8::EpiBf16<true> E{Z, ZP, SSa}; pg8::gemm_phase<pg8::EpiBf16<true>, pg8::StaticOrder, true, true>(lds, g, S, E, wv); }
        __syncthreads();
        convert_tail(a, l, lds, wv, 0x3F0u  , (M / 256) * (ZP / 256));
#endif
        } break;
        case 4: {
#if (PH_MASK >> 5) & 1
        zero_f32((float*)SSa, 3 * M, wv);
        token_prep_phase(a, l, Z, wv);
        for (int it = opaque_s(bx); it < 1024; it += G) gla_item(a, l, 0, it >> 8, (it >> 6) & 3, it & 63, Z, U, (const bf16*)XB, Dd, lds, wv);
#if DUP_MASK & 32
        for (int it = opaque_s(bx); it < 1024; it += G) gla_item(a, l, 0, it >> 8, (it >> 6) & 3, it & 63, Z, U, (const bf16*)XB, Dd, lds, wv);
#endif
#endif
        } break;
        case 5: {
#if (PH_MASK >> 6) & 1
        { pg8::Gemm g{Z + ZCQ, (const bf16*)(wt + WT_UQ), M, 768, 256, ZP, 256}; pg8::StaticOrder S; S.init(M, 768, opaque_s(G), opaque_s(bx));
          pg8::EpiBf16<false> E{QR, 768, nullptr}; pg8::gemm_phase<pg8::EpiBf16<false>, pg8::StaticOrder, true, true>(lds, g, S, E, wv); }
        __syncthreads();
        { pg8::Gemm g{Z + ZCKV, (const bf16*)(wt + WT_UKV), M, 1024, 256, ZP, 256}; pg8::StaticOrder S; S.init(M, 1024, opaque_s(G), opaque_s(bx));
          pg8::EpiBf16<false> E{KVR, 1024, nullptr}; pg8::gemm_phase<pg8::EpiBf16<false>, pg8::StaticOrder, true, true>(lds, g, S, E, wv); }
        __syncthreads();
        for (int st = 0; st < 2; ++st) {
            if ((st == 0) == (wv < 4)) gla_scan_phase(U, (bf16*)XB, Dd, wv);
            else na_phase(a, l, Z, lds, Z + ZQ_NA, ZP, wv);
        }
#endif
        } break;
        case 6: {
#if (PH_MASK >> 7) & 1
        for (int st = 0; st < 2; ++st) {
            if ((st == 0) == ((opaque_s(bx) & 1) == 0)) mla_prep_phase(a, l, Z, QR, KVR, KF, wv);
            else for (int it = opaque_s(bx); it < 1024; it += G) gla_item(a, l, 1, it >> 8, (it >> 6) & 3, it & 63, Z, U, (const bf16*)XB, Dd, lds, wv);
            __syncthreads();
        }
#endif
        } break;
        case 7: {
#if (PH_MASK >> 8) & 1
        for (int u = opaque_s(vcu); u < 256; u += G) { mla_attn_unit(lds, QR, KF, KVR, Z, (u >> 4) >> 2, (u >> 4) & 3, u & 15, wv); __syncthreads(); }
#if DUP_MASK & 2
        for (int u = opaque_s(vcu); u < 256; u += G) { mla_attn_unit(lds, QR, KF, KVR, Z, (u >> 4) >> 2, (u >> 4) & 3, u & 15, wv); __syncthreads(); }
#endif
#endif
        } break;
        case 8: {
#if (PH_MASK >> 9) & 1
        { pg8::Gemm g{Z, (const bf16*)(wt + WT_BR), M, 1024, 512, ZP, 512}; pg8::MergeOrder S{opaque_s(G), opaque_s(vcu), ZQ_NA, ZGV, ZCQ};
          pg8::EpiMerge E{Z, ZP, ZGATE, MIXB}; pg8::gemm_phase<pg8::EpiMerge, pg8::MergeOrder, true, true>(lds, g, S, E, wv); }
#endif
        } break;
        default: break;
        }
        if (step == 0) grid.sync();
        else GSYNC();
#ifdef TSEL_MASK
        { const unsigned long long tnow = __builtin_amdgcn_s_memrealtime(); if ((TSEL_MASK >> ph) & 1) tacc += tnow - tprev; tprev = tnow; }
#endif
    }
#ifdef TSEL_MASK
    if (blockIdx.x == 0) { const unsigned long long t0 = __builtin_amdgcn_s_memrealtime(); while (__builtin_amdgcn_s_memrealtime() - t0 < 9ull * tacc) __builtin_amdgcn_s_sleep(8); }
#endif
}

#undef ws
#undef XB
#undef MIXB
#undef Z
#undef Hb
#undef SSa
#undef SSb
#undef SSc
#undef QR
#undef KVR
#undef KF
#undef U
#undef MIXF
#undef Dd
#undef wt
#undef out
extern "C" void kernel_launch(void* const* d_in, const int* in_sizes, int n_in, void* d_out, int out_size, void* d_ws, size_t ws_size, hipStream_t stream) {
    static int grid = 0;
    if (grid == 0) {
        if (n_in != 29 || out_size != M * DM || ws_size < WS_END) { fprintf(stderr, "kernel_launch: unexpected shapes / workspace (%d inputs, out %d, ws %zu)\n", n_in, out_size, ws_size); grid = -1; return; }
        int dev = 0, cus = 0, per_cu = 0;
        (void)hipGetDevice(&dev); (void)hipDeviceGetAttribute(&cus, hipDeviceAttributeMultiprocessorCount, dev);
        (void)hipFuncSetAttribute((const void*)mega_fwd, hipFuncAttributeMaxDynamicSharedMemorySize, LDS_BYTES);
        if (hipOccupancyMaxActiveBlocksPerMultiprocessor(&per_cu, (const void*)mega_fwd, NTHR, LDS_BYTES) != hipSuccess || per_cu < 1) per_cu = 1;
        (void)hipGetLastError();
        grid = cus * per_cu; if (grid > 256) grid = 256;
        if (grid <= 0) grid = 256;
    }
    if (grid < 0) return;
    if (hipMemsetAsync(d_ws, 0, 16384, stream) != hipSuccess) { fprintf(stderr, "kernel_launch: memset failed\n"); return; }
    Args a{};
    for (int i = 0; i < 29; ++i) a.in[i] = (const float*)d_in[i];
    a.out = (float*)d_out; a.ws = (unsigned char*)d_ws;
    void* args[] = {&a};
    hipError_t e = hipLaunchCooperativeKernel((const void*)mega_fwd, dim3(grid), dim3(NTHR), args, LDS_BYTES, stream);
    if (e != hipSuccess) fprintf(stderr, "cooperative launch failed: %s (grid %d)\n", hipGetErrorString(e), grid);
}
```

```cpp
#include <hip/hip_runtime.h>
#include <hip/hip_cooperative_groups.h>
#include <cstdio>
#include <cstdint>
namespace cg = cooperative_groups;

namespace pg8 {
#define PG8_LAS __attribute__((address_space(3)))
typedef unsigned short bf16_t;
typedef short bf16x8 __attribute__((ext_vector_type(8)));
typedef float f32x4 __attribute__((ext_vector_type(4)));
typedef unsigned u32x4 __attribute__((ext_vector_type(4)));
typedef unsigned u32x2 __attribute__((ext_vector_type(2)));
constexpr int BM = 256, BK = 64, HALF = 128, HTB = HALF * BK * 2  , STAGE_BYTES = 8 * HTB, NXCD = 8, WGM = 8;

__host__ __device__ __forceinline__ int lds_byte(int r, int c) { const int st = (r >> 4) * 2 + (c >> 5), rr = r & 15, cc = c & 31, ob = rr * 64 + cc * 2; return st * 1024 + (ob ^ (((ob >> 9) & 1) << 5)); }
__host__ __device__ __forceinline__ void stage_rc(int b, int& R, int& C) { const int st = b / 1024, sb = b % 1024, swz = sb ^ (((sb >> 9) & 1) << 5); R = (st >> 1) * 16 + swz / 64; C = (st & 1) * 32 + (swz % 64) / 2; }
__host__ __device__ __forceinline__ int perm32(int rho) { const int n = rho >> 4, i = rho & 15; return 8 * (i >> 2) + 4 * n + (i & 3); }

struct Unit { int pm, pn; };
struct Gemm { const bf16_t* A; const bf16_t* Bt; int M, N, K, lda, ldb; };

struct StaticOrder {
    int nM, nN, nwg, G, c;
    __host__ __device__ void init(int M, int N, int G_, int c_) { nM = M / BM; nN = N / BM; nwg = nM * nN; G = G_; c = c_; }
    __host__ __device__ __forceinline__ bool next(int i, Unit& u) const {
        const long L = (long)i * G + c; if (L >= nwg) return false;
        int wgid = (int)L; { const int q = nwg / NXCD, r = nwg % NXCD, xcd = wgid % NXCD, off = wgid / NXCD; wgid = (xcd < r ? xcd * (q + 1) : r * (q + 1) + (xcd - r) * q) + off; }
        const int nig = WGM * nN, gid = wgid / nig, fm = gid * WGM, gsz = (nM - fm) < WGM ? (nM - fm) : WGM;
        u.pm = fm + ((wgid % nig) % gsz); u.pn = (wgid % nig) / gsz; return true;
    }
    __device__ __forceinline__ size_t aoff(const Unit& u, const Gemm& g) const { return (size_t)u.pm * BM * g.lda * 2; }
    __device__ __forceinline__ size_t boff(const Unit& u, const Gemm& g) const { return (size_t)u.pn * BM * g.ldb * 2; }
    __device__ __forceinline__ void a_ready(const Unit&) const {}
    __device__ __forceinline__ void done(const Unit&) const {}
};
struct MergeOrder {
    int G, c; int acol0, acol1, acol2;
    __device__ __forceinline__ bool next(int k, Unit& u) const { const int t = c + (k / 3) * G; if (t >= 256) return false; const int i = k % 3; u.pm = i * 64 + (t >> 2); u.pn = i * 4 + (t & 3); return true; }
    __device__ __forceinline__ size_t aoff(const Unit& u, const Gemm& g) const { const int i = u.pm >> 6; const int ac = acol0 + i * (acol1 - acol0) + (i >> 1) * (acol2 - 2 * acol1 + acol0); return ((size_t)(u.pm & 63) * BM * g.lda + ac) * 2; }
    __device__ __forceinline__ size_t boff(const Unit& u, const Gemm& g) const { return (size_t)u.pn * BM * g.ldb * 2; }
    __device__ __forceinline__ void a_ready(const Unit&) const {}
    __device__ __forceinline__ void done(const Unit&) const {}
};

__device__ __forceinline__ unsigned cvt_pk_bf16(float lo, float hi) { unsigned r; asm volatile("v_cvt_pk_bf16_f32 %0, %1, %2" : "=v"(r) : "v"(lo), "v"(hi)); return r; }
__device__ __forceinline__ float sx(float v, int mask, int lane) { return __builtin_bit_cast(float, __builtin_amdgcn_ds_bpermute((lane ^ mask) << 2, __builtin_bit_cast(int, v))); }
__device__ __forceinline__ float bflo(unsigned w) { return __builtin_bit_cast(float, w << 16); }
__device__ __forceinline__ float bfhi(unsigned w) { return __builtin_bit_cast(float, w & 0xffff0000u); }
__device__ __forceinline__ float fsigmoid(float x) { return __builtin_amdgcn_rcpf(1.0f + __builtin_amdgcn_exp2f(-1.4426950408889634f * x)); }

struct RowSS { unsigned raw[8]; };
struct NoState {};
__device__ __forceinline__ void load_rowss(RowSS& st, const unsigned* SS, const Unit& u, int wr) {
    int ln; asm volatile("v_mbcnt_lo_u32_b32 %0, -1, 0\n\tv_mbcnt_hi_u32_b32 %0, -1, %0" : "=&v"(ln)); const int row0 = u.pm * BM + wr * 64 + (ln & 15);
#pragma unroll
    for (int ai = 0; ai < 2; ++ai)
#pragma unroll
        for (int m = 0; m < 4; ++m) st.raw[ai * 4 + m] = __hip_atomic_load(SS + row0 + ai * HALF + m * 16, __ATOMIC_RELAXED, __HIP_MEMORY_SCOPE_AGENT);
}
__device__ __forceinline__ float rs_of(unsigned raw) { return 1.0f / sqrtf((float)raw * (1.0f / (4096.0f * 1024.0f)) + 1e-6f); }
template <bool SCALE> struct EpiBf16 {
    static constexpr bool PERM = true, AFTER_DRAIN = false, KEEP = false;
    bf16_t* O; int ldc; const unsigned* SS;
    typedef RowSS State;
    __device__ __forceinline__ void pre(State& st, const Unit& u, int wr) const { if (SCALE) load_rowss(st, SS, u, wr); }
    __device__ __forceinline__ void operator()(const f32x4 (&acc)[2][2][4][2], const Unit& u, int wr, int wc, int fr_, int fq_, const State& st) const {
        int ln; asm volatile("v_mbcnt_lo_u32_b32 %0, -1, 0\n\tv_mbcnt_hi_u32_b32 %0, -1, %0" : "=&v"(ln)); const int fr = ln & 15, fq = ln >> 4;
        const int row0 = u.pm * BM + wr * 64 + fr; const int col0 = u.pn * BM + wc * 32 + 8 * fq;
#pragma unroll
        for (int ai = 0; ai < 2; ++ai)
#pragma unroll
            for (int m = 0; m < 4; ++m) { bf16_t* rowp = O + (size_t)(row0 + ai * HALF + m * 16) * ldc + col0;
                float rs = 1.0f; if (SCALE) rs = rs_of(st.raw[ai * 4 + m]);
#pragma unroll
                for (int bj = 0; bj < 2; ++bj) { const f32x4 v0 = acc[ai][bj][m][0] * rs, v1 = acc[ai][bj][m][1] * rs;
                    u32x4 w; w.x = cvt_pk_bf16(v0[0], v0[1]); w.y = cvt_pk_bf16(v0[2], v0[3]); w.z = cvt_pk_bf16(v1[0], v1[1]); w.w = cvt_pk_bf16(v1[2], v1[3]);
                    *(u32x4*)(rowp + bj * HALF) = w; } }
    }
};
struct EpiSwiGLU {
    static constexpr bool PERM = true, AFTER_DRAIN = false, KEEP = false;
    bf16_t* O; int ldc; const unsigned* SS;
    typedef RowSS State;
    __device__ __forceinline__ void pre(State& st, const Unit& u, int wr) const { load_rowss(st, SS, u, wr); }
    __device__ __forceinline__ void operator()(const f32x4 (&acc)[2][2][4][2], const Unit& u, int wr, int wc, int fr_, int fq_, const State& st) const {
        int ln; asm volatile("v_mbcnt_lo_u32_b32 %0, -1, 0\n\tv_mbcnt_hi_u32_b32 %0, -1, %0" : "=&v"(ln)); const int fr = ln & 15, fq = ln >> 4;
        const int row0 = u.pm * BM + wr * 64 + fr; const int col0 = u.pn * HALF + wc * 32 + 8 * fq;
#pragma unroll
        for (int ai = 0; ai < 2; ++ai)
#pragma unroll
            for (int m = 0; m < 4; ++m) { bf16_t* rowp = O + (size_t)(row0 + ai * HALF + m * 16) * ldc + col0;
                const float rs = rs_of(st.raw[ai * 4 + m]);
                float h[8];
#pragma unroll
                for (int n = 0; n < 2; ++n)
#pragma unroll
                    for (int j = 0; j < 4; ++j) { const float gt = acc[ai][0][m][n][j] * rs, up = acc[ai][1][m][n][j] * rs; h[4 * n + j] = gt * fsigmoid(gt) * up; }
                u32x4 w; w.x = cvt_pk_bf16(h[0], h[1]); w.y = cvt_pk_bf16(h[2], h[3]); w.z = cvt_pk_bf16(h[4], h[5]); w.w = cvt_pk_bf16(h[6], h[7]);
                *(u32x4*)rowp = w; }
    }
};
struct EpiResid {
    static constexpr bool PERM = false, AFTER_DRAIN = false, KEEP = false;
    const float* base; float* out; int ldc; float alpha; bf16_t* XB; unsigned* SS;
    typedef NoState State;
    __device__ __forceinline__ void pre(State&, const Unit&, int) const {}
    __device__ __forceinline__ void operator()(const f32x4 (&acc)[2][2][4][2], const Unit& u, int wr, int wc, int fr_, int fq_, const State&) const {
        int ln; asm volatile("v_mbcnt_lo_u32_b32 %0, -1, 0\n\tv_mbcnt_hi_u32_b32 %0, -1, %0" : "=&v"(ln)); const int fr = ln & 15, fq = ln >> 4;
        const int row0 = u.pm * BM + wr * 64 + fr, col0 = u.pn * BM + wc * 32 + 4 * fq;
        float al = alpha; asm volatile("" : "+v"(al));
        bf16_t* xb = XB; unsigned* ssp = SS; asm volatile("" : "+s"(xb), "+s"(ssp));
#pragma unroll
        for (int ai = 0; ai < 2; ++ai)
#pragma unroll
            for (int m = 0; m < 4; ++m) { const size_t off = (size_t)(row0 + ai * HALF + m * 16) * ldc + col0; float ss = 0.f;
#pragma unroll
                for (int bj = 0; bj < 2; ++bj)
#pragma unroll
                    for (int n = 0; n < 2; ++n) { const f32x4 b = *(const f32x4*)(base + off + bj * HALF + n * 16); const f32x4 v = b + acc[ai][bj][m][n] * al;
                        *(f32x4*)(out + off + bj * HALF + n * 16) = v; ss += (v[0] * v[0] + v[1] * v[1]) + (v[2] * v[2] + v[3] * v[3]);
                        u32x2 w; w.x = cvt_pk_bf16(v[0], v[1]); w.y = cvt_pk_bf16(v[2], v[3]); *(u32x2*)(xb + off + bj * HALF + n * 16) = w; }
                { const int ln = fq * 16 + fr; ss += sx(ss, 16, ln); ss += sx(ss, 32, ln); }
                if (fq == 0) (void)__hip_atomic_fetch_add(ssp + row0 + ai * HALF + m * 16, (unsigned)(ss * 4096.0f + 0.5f), __ATOMIC_RELAXED, __HIP_MEMORY_SCOPE_AGENT); }
    }
};
struct EpiMerge {
    static constexpr bool PERM = false, AFTER_DRAIN = false, KEEP = true;
    const bf16_t* Z; int ldz, gcol; bf16_t* MIXB;
    typedef NoState State;
    __device__ __forceinline__ void pre(State&, const Unit&, int) const {}
    __device__ __forceinline__ bool zero_after(const Unit& u) const { return (u.pm >> 6) == 2; }
    __device__ __forceinline__ void operator()(f32x4 (&acc)[2][2][4][2], const Unit& u, int wr, int wc, int fr_, int fq_, const State&) const {
        int ln; asm volatile("v_mbcnt_lo_u32_b32 %0, -1, 0\n\tv_mbcnt_hi_u32_b32 %0, -1, %0" : "=&v"(ln)); const int fr = ln & 15, fq = ln >> 4;
        const int i = u.pm >> 6, pm = u.pm & 63, pn = u.pn & 3;
        const int row0 = pm * BM + wr * 64 + fr, col0 = pn * BM + wc * 32 + 4 * fq;
#pragma unroll
        for (int ai = 0; ai < 2; ++ai)
#pragma unroll
            for (int m = 0; m < 4; ++m) { const int row = row0 + ai * HALF + m * 16;
#pragma unroll
                for (int bj = 0; bj < 2; ++bj)
#pragma unroll
                    for (int n = 0; n < 2; ++n) { const int col = col0 + bj * HALF + n * 16;
                        const bf16_t* gp = Z + (size_t)row * ldz + gcol + i * 1024 + col;
                        const u32x2 ga = *(const u32x2*)gp;
                        f32x4 ea; ea[0] = __builtin_amdgcn_exp2f(-1.4426950408889634f * bflo(ga.x)); ea[1] = __builtin_amdgcn_exp2f(-1.4426950408889634f * bfhi(ga.x));
                        ea[2] = __builtin_amdgcn_exp2f(-1.4426950408889634f * bflo(ga.y)); ea[3] = __builtin_amdgcn_exp2f(-1.4426950408889634f * bfhi(ga.y));
                        f32x4 v = acc[ai][bj][m][n];
                        if (i < 2) { const u32x2 gb = *(const u32x2*)(gp + 1024);
                            f32x4 eb; eb[0] = __builtin_amdgcn_exp2f(-1.4426950408889634f * bflo(gb.x)); eb[1] = __builtin_amdgcn_exp2f(-1.4426950408889634f * bfhi(gb.x));
                            eb[2] = __builtin_amdgcn_exp2f(-1.4426950408889634f * bflo(gb.y)); eb[3] = __builtin_amdgcn_exp2f(-1.4426950408889634f * bfhi(gb.y));
#pragma unroll
                            for (int j = 0; j < 4; ++j) v[j] *= (1.0f + eb[j]) * __builtin_amdgcn_rcpf(1.0f + ea[j]);
                            acc[ai][bj][m][n] = v;
                        } else {
#pragma unroll
                            for (int j = 0; j < 4; ++j) v[j] *= __builtin_amdgcn_rcpf(1.0f + ea[j]);
                            u32x2 w; w.x = cvt_pk_bf16(v[0], v[1]); w.y = cvt_pk_bf16(v[2], v[3]); *(u32x2*)(MIXB + (size_t)row * 1024 + col) = w; } } }
    }
};

template <class Epi, class Sched, bool ALIGN_EPI = false, bool SP2 = false>
__device__ __forceinline__ void gemm_phase(PG8_LAS unsigned char* lds, const Gemm g, const Sched& S, const Epi& E, const int wv) {
    int tid_o; asm volatile("v_mbcnt_lo_u32_b32 %0, -1, 0\n\tv_mbcnt_hi_u32_b32 %0, -1, %0\n\tv_lshl_or_b32 %0, %1, 6, %0" : "=&v"(tid_o) : "s"(wv)); const int tid = tid_o, wid = __builtin_amdgcn_readfirstlane(tid >> 6), lane = tid & 63, wr = wid >> 2, wc = wid & 3, fr = lane & 15, fq = lane >> 4;
    const int K = g.K, nt = K / BK;
    unsigned voffA[2], voffB[2];
#pragma unroll
    for (int i = 0; i < 2; ++i) { int R, C; stage_rc(tid * 16 + i * 8192, R, C); const int Rb = Epi::PERM ? ((R & ~31) + perm32(R & 31)) : R;
        voffA[i] = (unsigned)(R * g.lda + C) * 2u; voffB[i] = (unsigned)(Rb * g.ldb + C) * 2u; }
    const size_t kstep = (size_t)(BK * 2);
    const size_t hstepA = (size_t)HALF * g.lda * 2, hstepB = (size_t)HALF * g.ldb * 2;
    const unsigned ldsw = (unsigned)wid * 1024u;
    const int aoff = lds_byte(wr * 64 + fr, fq * 8), boff = lds_byte(wc * 32 + fr, fq * 8);
#define PG8_SA(b, h) (((b) * 2 + (h)) * HTB)
#define PG8_SB(b, h) ((4 + (b) * 2 + (h)) * HTB)
#define PG8_STAGE(bufoff, gbase, voff) do { _Pragma("unroll") for (int _i = 0; _i < 2; ++_i) \
        __builtin_amdgcn_global_load_lds((const unsigned*)((const char*)(gbase) + (voff)[_i]), (PG8_LAS unsigned*)(lds + (bufoff) + ldsw + _i * 8192), 16, 0, 0); } while (0)
#define PG8_LDA(dst, b, h) do { _Pragma("unroll") for (int m = 0; m < 4; ++m) _Pragma("unroll") for (int k = 0; k < 2; ++k) dst[m][k] = *(const PG8_LAS bf16x8*)(lds + PG8_SA(b, h) + aoff + m * 2048 + k * 1024); } while (0)
#define PG8_LDB(dst, b, h) do { _Pragma("unroll") for (int n = 0; n < 2; ++n) _Pragma("unroll") for (int k = 0; k < 2; ++k) dst[n][k] = *(const PG8_LAS bf16x8*)(lds + PG8_SB(b, h) + boff + n * 2048 + k * 1024); } while (0)
#define PG8_MMA(ai, bj, At, Bt) do { __builtin_amdgcn_s_setprio(1); _Pragma("unroll") for (int m = 0; m < 4; ++m) _Pragma("unroll") for (int n = 0; n < 2; ++n) _Pragma("unroll") for (int k = 0; k < 2; ++k) \
        acc[ai][bj][m][n] = __builtin_amdgcn_mfma_f32_16x16x32_bf16(Bt[n][k], At[m][k], acc[ai][bj][m][n], 0, 0, 0); __builtin_amdgcn_s_setprio(0); } while (0)
#define PG8_WAIT_V(n) asm volatile("s_waitcnt vmcnt(" #n ")" ::: "memory")
#define PG8_WAIT_L(n) asm volatile("s_waitcnt lgkmcnt(" #n ")" ::: "memory")
#define PG8_BAR __builtin_amdgcn_s_barrier()
#define PG8_SCHED __builtin_amdgcn_sched_barrier(0)
    Unit cur, nxt; int ui = 0;
    if (!S.next(0, cur)) return;
    f32x4 acc[2][2][4][2];
#pragma unroll
    for (int a = 0; a < 2; ++a)
#pragma unroll
        for (int b = 0; b < 2; ++b)
#pragma unroll
            for (int m = 0; m < 4; ++m)
#pragma unroll
                for (int n = 0; n < 2; ++n) acc[a][b][m][n] = (f32x4){0.f, 0.f, 0.f, 0.f};
    bf16x8 At[4][2], B0[2][2], B1[2][2];
    const char* cA = (const char*)g.A + S.aoff(cur, g); const char* cB = (const char*)g.Bt + S.boff(cur, g);
    S.a_ready(cur);
    typename Epi::State est; E.pre(est, cur, wr);
    if constexpr (SP2) {
        PG8_STAGE(PG8_SB(0, 0), cB, voffB); PG8_STAGE(PG8_SB(0, 1), cB + hstepB, voffB); PG8_STAGE(PG8_SA(0, 0), cA, voffA); PG8_STAGE(PG8_SA(0, 1), cA + hstepA, voffA);
        if (wr == 1) PG8_BAR;
        PG8_WAIT_V(2); PG8_BAR;
        PG8_STAGE(PG8_SB(1, 0), cB + kstep, voffB); PG8_STAGE(PG8_SA(1, 0), cA + kstep, voffA); PG8_STAGE(PG8_SB(1, 1), cB + hstepB + kstep, voffB);
        PG8_WAIT_V(6); PG8_BAR;
    } else {
        PG8_STAGE(PG8_SB(0, 0), cB, voffB); PG8_STAGE(PG8_SA(0, 0), cA, voffA); PG8_STAGE(PG8_SB(0, 1), cB + hstepB, voffB); PG8_STAGE(PG8_SA(0, 1), cA + hstepA, voffA);
        if (wr == 1) PG8_BAR;
        PG8_WAIT_V(4); PG8_BAR;
        PG8_STAGE(PG8_SB(1, 0), cB + kstep, voffB); PG8_STAGE(PG8_SA(1, 0), cA + kstep, voffA); PG8_STAGE(PG8_SB(1, 1), cB + hstepB + kstep, voffB);
        PG8_WAIT_V(6); PG8_BAR;
    }
    for (;;) {
        const bool has_next = S.next(ui + 1, nxt);
        const char* nA = has_next ? (const char*)g.A + S.aoff(nxt, g) : cA; const char* nB = has_next ? (const char*)g.Bt + S.boff(nxt, g) : cB;
        for (int t = 0; t < nt; t += 2) {
            const bool last = (t == nt - 2);
            const char* a1 = cA + (size_t)(t + 1) * kstep;
            const char* a2 = last ? nA : cA + (size_t)(t + 2) * kstep; const char* b2 = last ? nB : cB + (size_t)(t + 2) * kstep;
            const char* a3 = a2 + kstep; const char* b3 = b2 + kstep;
            if (last && has_next) S.a_ready(nxt);
            if constexpr (SP2) {
            PG8_LDB(B0, 0, 0); PG8_LDB(B1, 0, 1); PG8_SCHED; PG8_LDA(At, 0, 0); PG8_STAGE(PG8_SA(1, 1), a1 + hstepA, voffA);
            PG8_WAIT_V(8); PG8_WAIT_L(0); PG8_BAR; PG8_MMA(0, 0, At, B0); PG8_MMA(0, 1, At, B1); PG8_BAR; PG8_SCHED;
            PG8_LDA(At, 0, 1); PG8_STAGE(PG8_SB(0, 0), b2, voffB); PG8_STAGE(PG8_SB(0, 1), b2 + hstepB, voffB); PG8_STAGE(PG8_SA(0, 0), a2, voffA);
            PG8_WAIT_V(8); PG8_WAIT_L(0); PG8_BAR; PG8_MMA(1, 0, At, B0); PG8_MMA(1, 1, At, B1); PG8_BAR; PG8_SCHED;
            PG8_LDB(B0, 1, 0); PG8_LDB(B1, 1, 1); PG8_SCHED; PG8_LDA(At, 1, 0); PG8_STAGE(PG8_SA(0, 1), a2 + hstepA, voffA);
            PG8_WAIT_V(8); PG8_WAIT_L(0); PG8_BAR; PG8_MMA(0, 0, At, B0); PG8_MMA(0, 1, At, B1); PG8_BAR; PG8_SCHED;
            PG8_LDA(At, 1, 1); PG8_STAGE(PG8_SB(1, 0), b3, voffB); PG8_STAGE(PG8_SB(1, 1), b3 + hstepB, voffB); PG8_STAGE(PG8_SA(1, 0), a3, voffA);
            PG8_WAIT_V(8); PG8_WAIT_L(0); PG8_BAR; PG8_MMA(1, 0, At, B0); PG8_MMA(1, 1, At, B1); PG8_BAR; PG8_SCHED;
            } else {
            PG8_LDB(B0, 0, 0); PG8_SCHED; PG8_LDA(At, 0, 0); PG8_STAGE(PG8_SA(1, 1), a1 + hstepA, voffA);
            PG8_WAIT_L(8); PG8_BAR; PG8_WAIT_L(0); PG8_MMA(0, 0, At, B0); PG8_BAR; PG8_SCHED;
            PG8_LDB(B1, 0, 1); PG8_STAGE(PG8_SB(0, 0), b2, voffB);
            PG8_BAR; PG8_WAIT_L(0); PG8_MMA(0, 1, At, B1); PG8_BAR;
            PG8_LDA(At, 0, 1); PG8_STAGE(PG8_SA(0, 0), a2, voffA);
            PG8_BAR; PG8_WAIT_L(0); PG8_MMA(1, 0, At, B0); PG8_BAR; PG8_SCHED;
            PG8_STAGE(PG8_SB(0, 1), b2 + hstepB, voffB);
            PG8_WAIT_V(6); PG8_BAR; PG8_MMA(1, 1, At, B1); PG8_BAR;
            PG8_LDB(B0, 1, 0); PG8_SCHED; PG8_LDA(At, 1, 0); PG8_STAGE(PG8_SA(0, 1), a2 + hstepA, voffA);
            PG8_WAIT_L(8); PG8_BAR; PG8_WAIT_L(0); PG8_MMA(0, 0, At, B0); PG8_BAR; PG8_SCHED;
            PG8_LDB(B1, 1, 1); PG8_STAGE(PG8_SB(1, 0), b3, voffB);
            PG8_BAR; PG8_WAIT_L(0); PG8_MMA(0, 1, At, B1); PG8_BAR;
            PG8_LDA(At, 1, 1); PG8_STAGE(PG8_SA(1, 0), a3, voffA);
            PG8_BAR; PG8_WAIT_L(0); PG8_MMA(1, 0, At, B0); PG8_BAR; PG8_SCHED;
            PG8_STAGE(PG8_SB(1, 1), b3 + hstepB, voffB);
            PG8_WAIT_V(6); PG8_BAR; PG8_MMA(1, 1, At, B1); PG8_BAR;
            }
        }
        if constexpr (ALIGN_EPI) { if (wr == 0) PG8_BAR; }
        if constexpr (!Epi::AFTER_DRAIN) { E(acc, cur, wr, wc, fr, fq, est); S.done(cur); }
        if (!has_next) break;
        bool zacc = true; if constexpr (Epi::KEEP) zacc = E.zero_after(cur);
        if (zacc)
#pragma unroll
        for (int a = 0; a < 2; ++a)
#pragma unroll
            for (int b = 0; b < 2; ++b)
#pragma unroll
                for (int m = 0; m < 4; ++m)
#pragma unroll
                    for (int n = 0; n < 2; ++n) acc[a][b][m][n] = (f32x4){0.f, 0.f, 0.f, 0.f};
        cur = nxt; cA = nA; cB = nB; ++ui; E.pre(est, cur, wr);
        if constexpr (ALIGN_EPI) { if (wr == 1) PG8_BAR; }
    }
    PG8_WAIT_V(0);
    if constexpr (!ALIGN_EPI) { if (wr == 0) PG8_BAR; }
    PG8_BAR;
    if constexpr (Epi::AFTER_DRAIN) { E.fused(acc, cur, wr, wc, fr, fq, lds, wid, lane); S.done(cur); }
#undef PG8_SA
#undef PG8_SB
#undef PG8_STAGE
#undef PG8_LDA
#undef PG8_LDB
#undef PG8_MMA
#undef PG8_WAIT_V
#undef PG8_WAIT_L
#undef PG8_BAR
#undef PG8_SCHED
}
}

#define LAS __attribute__((address_space(3)))
typedef unsigned short bf16;
typedef unsigned v4u __attribute__((ext_vector_type(4)));
typedef unsigned v2u __attribute__((ext_vector_type(2)));
typedef float f32x4 __attribute__((ext_vector_type(4)));
typedef float f32x16 __attribute__((ext_vector_type(16)));
typedef short bf16x8 __attribute__((ext_vector_type(8)));
typedef short s16x4 __attribute__((ext_vector_type(4)));
typedef short v4i16_t __attribute__((ext_vector_type(4)));

constexpr int NWAVES = 8, NTHR = 512;
constexpr int M = 16384, DM = 1024, FF = 2816, DIN = 6752, ZP = 6912, SEQ = 4096, DEPTH = 4;
constexpr float EPS = 1e-6f, LOG2E = 1.4426950408889634f;
constexpr int ZQ_NA = 0, ZK_NA = 512, ZV_NA = 1024, ZGQ = 1536, ZGK = 1792, ZGV = 2048, ZGR = 2560, ZGFL = 3072, ZGBL = 3088, ZCQ = 3104, ZCKV = 3360, ZKR = 3616, ZGATE = 3680;
constexpr size_t MiB = 1u << 20;
constexpr size_t WS_WT = 1 * MiB, WS_XN = 57 * MiB, WS_Z = 89 * MiB, WS_QR = 305 * MiB, WS_KVR = 329 * MiB, WS_KF = 361 * MiB, WS_U = 385 * MiB, WS_DD = 449 * MiB, WS_PS = 450 * MiB, WS_END = 453 * MiB;
constexpr size_t WT_13A = 0, WT_2A = 11534336, WT_IN = 17301504, WT_UQ = 31457280, WT_UKV = 31850496, WT_BR = 32374784, WT_OUT = 35520512, WT_13B = 37617664, WT_2B = 49152000;
constexpr int LDS_BYTES = 135168;

struct Args { const float* in[29]; float* out; unsigned char* ws; };
__device__ __forceinline__ const float* kin(int i) { typedef const __attribute__((address_space(4))) unsigned long long* kp_t; kp_t kp = (kp_t)__builtin_amdgcn_kernarg_segment_ptr(); const unsigned long long v = *(volatile kp_t)(kp + i); return (const float*)(const __attribute__((address_space(1))) float*)v; }

#define LDS_WAIT() asm volatile("s_waitcnt lgkmcnt(0)" ::: "memory")
__device__ __forceinline__ unsigned pk2(float lo, float hi) { return pg8::cvt_pk_bf16(lo, hi); }
__device__ __forceinline__ float bf2f(bf16 h) { return __builtin_bit_cast(float, (unsigned)h << 16); }
__device__ __forceinline__ bf16 f2bf(float f) { return (bf16)(pk2(f, 0.f) & 0xffffu); }
__device__ __forceinline__ float wave_sum(float v, int lane) {
#pragma unroll
    for (int o = 1; o < 64; o <<= 1) v += pg8::sx(v, o, lane);
    return v;
}
__device__ __forceinline__ int opaque_tid_w(int wv) { int t; asm volatile("v_mbcnt_lo_u32_b32 %0, -1, 0\n\tv_mbcnt_hi_u32_b32 %0, -1, %0\n\tv_lshl_or_b32 %0, %1, 6, %0" : "=&v"(t) : "s"(wv)); return t; }
__device__ __forceinline__ int opaque_s(int v) { asm volatile("" : "+s"(v)); return v; }
__device__ __forceinline__ int crow(int r, int hi) { return (r & 3) + 8 * (r >> 2) + 4 * hi; }
__device__ __forceinline__ s16x4 vtr(const LAS char* p) { return __builtin_bit_cast(s16x4, __builtin_amdgcn_ds_read_tr16_b64_v4i16((LAS v4i16_t*)p)); }
__device__ __forceinline__ bf16x8 tr_frag(const LAS char* p0, const LAS char* p1) { const s16x4 a = vtr(p0), b = vtr(p1); return (bf16x8){a[0], a[1], a[2], a[3], b[0], b[1], b[2], b[3]}; }
__device__ __forceinline__ bf16x8 pack8(float a0, float a1, float a2, float a3, float a4, float a5, float a6, float a7) {
    v4u w; w.x = pk2(a0, a1); w.y = pk2(a2, a3); w.z = pk2(a4, a5); w.w = pk2(a6, a7); return __builtin_bit_cast(bf16x8, w);
}
#define MFMA32(a, b, c) __builtin_amdgcn_mfma_f32_32x32x16_bf16((a), (b), (c), 0, 0, 0)
#define MFMA16(a, b, c) __builtin_amdgcn_mfma_f32_16x16x32_bf16((a), (b), (c), 0, 0, 0)

#define XB_TMO      128
#define XB_XCNT(j)  (256  + 64 * (j))
#define XB_XSUB(j)  (1280 + 64 * (j))
#define XB_XGEN(j)  (2304 + 64 * (j))
#define XB_TOP      3328
#define XB_TOPGEN   3392
#define XCD_BAR_WORDS 3456
#define XB_SPIN_CAP (1u << 18)

__device__ __forceinline__ unsigned xb_ld(unsigned* p)              { return __hip_atomic_load(p, __ATOMIC_RELAXED, __HIP_MEMORY_SCOPE_AGENT); }
__device__ __forceinline__ unsigned xb_add(unsigned* p, unsigned v) { return __hip_atomic_fetch_add(p, v, __ATOMIC_RELAXED, __HIP_MEMORY_SCOPE_AGENT); }
__device__ __forceinline__ unsigned xb_xcc_id() { return (unsigned)__builtin_amdgcn_s_getreg((3 << 11) | 20) & 0xFu; }
#define XB_SPIN(cond, bar) do { unsigned _sp = 0; while (cond) { __builtin_amdgcn_s_sleep(1); \
    if ((++_sp & 255u) == 0u) { if (xb_ld(&(bar)[XB_TMO])) break; if (_sp > XB_SPIN_CAP) { atomicAdd(&(bar)[XB_TMO], 1u); break; } } } } while (0)

struct XcdBarrier {
    unsigned* bar; unsigned x;
    volatile LAS unsigned* st;
};

__device__ __forceinline__ XcdBarrier xcd_barrier_post(unsigned* bar, volatile LAS unsigned* st) {
    XcdBarrier b; b.bar = bar; b.x = xb_xcc_id(); b.st = st;
    if (threadIdx.x == 0) (void)xb_add(&bar[XB_XCNT(b.x)], 1u);
    return b;
}
__device__ __forceinline__ void xcd_barrier_complete(unsigned* bar, unsigned x, unsigned& nloc, unsigned& nx) {
    const unsigned G = gridDim.x * gridDim.y * gridDim.z;
    unsigned sum, cnt, mine, sp = 0u;
    for (;;) {
        sum = 0u; cnt = 0u; mine = 0u;
#pragma unroll
        for (unsigned j = 0; j < 16; ++j) { const unsigned c = xb_ld(&bar[XB_XCNT(j)]); sum += c; cnt += (c > 0u) ? 1u : 0u; mine = (j == x) ? c : mine; }
        if (sum == G) break;
        __builtin_amdgcn_s_sleep(1);
        if ((++sp & 255u) == 0u) { if (xb_ld(&bar[XB_TMO])) break; if (sp > XB_SPIN_CAP) { atomicAdd(&bar[XB_TMO], 1u); break; } }
    }
    nloc = mine > 0u ? mine : 1u; nx = cnt > 0u ? cnt : 1u;
}

__device__ __forceinline__ void xcd_barrier(const XcdBarrier& b, const bool leader) {
    asm volatile("s_waitcnt vmcnt(0)" ::: "memory");
    __syncthreads();
    if (leader) {
        unsigned* bar = b.bar;
        __builtin_amdgcn_s_waitcnt(0);
        unsigned nloc = b.st[0], nx = b.st[1];
        if (nloc == 0u) { xcd_barrier_complete(bar, b.x, nloc, nx); b.st[0] = nloc; b.st[1] = nx; }
        const unsigned old = xb_add(&bar[XB_XSUB(b.x)], 1u);
        const unsigned gen = old / nloc;
        if (old + 1u == (gen + 1u) * nloc) {
            __builtin_amdgcn_fence(__ATOMIC_RELEASE, "agent");
            asm volatile("s_waitcnt vmcnt(0)" ::: "memory");
            const unsigned og = xb_add(&bar[XB_TOP], 1u);
            const unsigned tg = og / nx;
            if (og + 1u == (tg + 1u) * nx) xb_add(&bar[XB_TOPGEN], 1u);
            else XB_SPIN(xb_ld(&bar[XB_TOPGEN]) == tg, bar);
            __builtin_amdgcn_fence(__ATOMIC_ACQUIRE, "agent");
            xb_add(&bar[XB_XGEN(b.x)], 1u);
            asm volatile("s_waitcnt vmcnt(0)" ::: "memory");
        } else {
            XB_SPIN(xb_ld(&bar[XB_XGEN(b.x)]) == gen, bar);
            __builtin_amdgcn_fence(__ATOMIC_ACQUIRE, "agent");
            asm volatile("s_waitcnt vmcnt(0)" ::: "memory");
        }
    }
    __syncthreads();
}

__device__ __forceinline__ void tr_item(const float* __restrict__ W, int K, int N, bf16* WT, int k0, int n0, int drow0, LAS float* scr, int lane, const float* g) {
    f32x4 wv4[8];
#pragma unroll
    for (int i = 0; i < 8; ++i) wv4[i] = __builtin_nontemporal_load((const f32x4*)(W + (size_t)(k0 + (lane >> 3) + 8 * i) * N + n0 + 4 * (lane & 7)));
#pragma unroll
    for (int i = 0; i < 8; ++i) { LAS float* d = scr + ((lane >> 3) + 8 * i) * 33 + 4 * (lane & 7); d[0] = wv4[i].x; d[1] = wv4[i].y; d[2] = wv4[i].z; d[3] = wv4[i].w; }
    LDS_WAIT();
    const int c = lane & 7;
    f32x4 ga = {1.f, 1.f, 1.f, 1.f}, gb = ga;
    if (g) { ga = *(const f32x4*)(g + k0 + 8 * c); gb = *(const f32x4*)(g + k0 + 8 * c + 4); }
#pragma unroll
    for (int j = 0; j < 4; ++j) { const int n = (lane >> 3) + 8 * j; const LAS float* s = scr + (8 * c) * 33 + n;
        v4u o; o.x = pk2(s[0 * 33] * ga[0], s[1 * 33] * ga[1]); o.y = pk2(s[2 * 33] * ga[2], s[3 * 33] * ga[3]); o.z = pk2(s[4 * 33] * gb[0], s[5 * 33] * gb[1]); o.w = pk2(s[6 * 33] * gb[2], s[7 * 33] * gb[3]);
        *(v4u*)(WT + (size_t)(drow0 + n) * K + k0 + 8 * c) = o; }
    LDS_WAIT();
}
struct MatDesc { const float* W; bf16* WT; const float* g; int K, N, mode, roff; };
__device__ __forceinline__ MatDesc mat_desc(int idx, int l, const Args& a, unsigned char* wt) {
    MatDesc d; d.mode = 0; d.roff = 0; d.g = nullptr;
    switch (idx) {
    case 0:  d.W = kin(2) + (size_t)l * DM * FF;  d.WT = (bf16*)(wt + WT_13A); d.K = DM; d.N = FF; d.mode = 1; d.roff = 0; d.g = kin(1) + l * DM; break;
    case 1:  d.W = kin(3) + (size_t)l * DM * FF;  d.WT = (bf16*)(wt + WT_13A); d.K = DM; d.N = FF; d.mode = 1; d.roff = 1; d.g = kin(1) + l * DM; break;
    case 2:  d.W = kin(4) + (size_t)l * FF * DM;  d.WT = (bf16*)(wt + WT_2A);  d.K = FF; d.N = DM; break;
    case 3:  d.W = kin(6) + (size_t)l * DM * DIN; d.WT = (bf16*)(wt + WT_IN);  d.K = DM; d.N = DIN; d.g = kin(5) + l * DM; break;
    case 4:  d.W = kin(17) + (size_t)l * 256 * 768;  d.WT = (bf16*)(wt + WT_UQ);  d.K = 256; d.N = 768; break;
    case 5:  d.W = kin(18) + (size_t)l * 256 * 1024; d.WT = (bf16*)(wt + WT_UKV); d.K = 256; d.N = 1024; break;
    case 6:  d.W = kin(21) + (size_t)l * 512 * 1024; d.WT = (bf16*)(wt + WT_BR);  d.K = 512; d.N = 1024; d.roff = 0; break;
    case 7:  d.W = kin(22) + (size_t)l * 512 * 1024; d.WT = (bf16*)(wt + WT_BR);  d.K = 512; d.N = 1024; d.roff = 1024; break;
    case 8:  d.W = kin(23) + (size_t)l * 512 * 1024; d.WT = (bf16*)(wt + WT_BR);  d.K = 512; d.N = 1024; d.roff = 2048; break;
    case 9:  d.W = kin(24) + (size_t)l * DM * DM;  d.WT = (bf16*)(wt + WT_OUT); d.K = DM; d.N = DM; break;
    case 10: d.W = kin(26) + (size_t)l * DM * FF;  d.WT = (bf16*)(wt + WT_13B); d.K = DM; d.N = FF; d.mode = 1; d.roff = 0; d.g = kin(25) + l * DM; break;
    case 11: d.W = kin(27) + (size_t)l * DM * FF;  d.WT = (bf16*)(wt + WT_13B); d.K = DM; d.N = FF; d.mode = 1; d.roff = 1; d.g = kin(25) + l * DM; break;
    default: d.W = kin(28) + (size_t)l * FF * DM;  d.WT = (bf16*)(wt + WT_2B);  d.K = FF; d.N = DM; break;
    }
    return d;
}
__device__ __forceinline__ void convert_set(const Args& a, int l, LAS unsigned char* lds, const int wv, const unsigned mask, const int pw, const int np, const bool do_pad) {
    const int tid = opaque_tid_w(wv), lane = tid & 63, wave = __builtin_amdgcn_readfirstlane(tid >> 6), gtid = blockIdx.x * NTHR + tid, gthreads = gridDim.x * NTHR;
    unsigned char* wt = ((unsigned char*)kin(30)) + WS_WT;
    LAS float* scr = (LAS float*)(lds + wave * 8704);
    int it = pw;
    for (int mi = 0; mi < 13; ++mi) {
        if (!((mask >> mi) & 1u)) continue;
        const MatDesc d = mat_desc(mi, l, a, wt);
        const int nblk = d.N / 32, cnt = (d.K / 64) * nblk;
        for (; it < cnt; it += np) {
            const int kb = it / nblk, nb = it - kb * nblk, n0 = 32 * nb;
            const int drow0 = d.mode ? (256 * (n0 >> 7) + 128 * d.roff + (n0 & 127)) : (d.roff + n0);
            tr_item(d.W, d.K, d.N, d.WT, 64 * kb, n0, drow0, scr, lane, d.g);
        }
        it -= cnt;
    }
    if (do_pad) {
        v4u* pad = (v4u*)(wt + WT_IN + (size_t)DIN * DM * 2);
        const int npad = (ZP - DIN) * DM * 2 / 16;
        unsigned zz = 0u; asm volatile("" : "+v"(zz));
        for (int i = gtid; i < npad; i += gthreads) pad[i] = (v4u){zz, zz, zz, zz};
    }
}
__device__ __forceinline__ void convert_tail(const Args& a, int l, LAS unsigned char* lds, const int wv, const unsigned mask, const int nwg) {
    const int G = gridDim.x, bx = opaque_s(blockIdx.x), rem = nwg % G;
    if (rem != 0 && bx < rem) return;
    const int pw = (rem == 0 ? bx : bx - rem) * NWAVES + wv, np = (rem == 0 ? G : G - rem) * NWAVES;
    convert_set(a, l, lds, wv, mask, pw, np, false);
}
__device__ __forceinline__ void xprep_phase(const float* x, bf16* XB, unsigned* SS, const int wv) {
    const int tid = opaque_tid_w(wv), lane = tid & 63, wave = __builtin_amdgcn_readfirstlane(tid >> 6), gw = blockIdx.x * NWAVES + wave, NGW = gridDim.x * NWAVES;
    for (int m = gw; m < M; m += NGW) {
        const f32x4* xr = (const f32x4*)(x + (size_t)m * DM) + lane;
        f32x4 v[4]; float s = 0.f;
#pragma unroll
        for (int j = 0; j < 4; ++j) { v[j] = xr[64 * j]; s += (v[j].x * v[j].x + v[j].y * v[j].y) + (v[j].z * v[j].z + v[j].w * v[j].w); }
        s = wave_sum(s, lane); if (lane == 0) __hip_atomic_store(SS + m, (unsigned)(s * 4096.0f + 0.5f), __ATOMIC_RELAXED, __HIP_MEMORY_SCOPE_AGENT);
        v2u* o = (v2u*)(XB + (size_t)m * DM) + lane;
#pragma unroll
        for (int j = 0; j < 4; ++j) { v2u w; w.x = pk2(v[j].x, v[j].y); w.y = pk2(v[j].z, v[j].w); o[64 * j] = w; }
    }
}
__device__ __forceinline__ void token_prep_phase(const Args& a, int l, bf16* Z, const int wv) {
    const int tid = opaque_tid_w(wv), lane = tid & 63, wave = __builtin_amdgcn_readfirstlane(tid >> 6), gw = blockIdx.x * NWAVES + wave, NGW = gridDim.x * NWAVES;
    const float* gna = (lane < 32 ? kin(7) : kin(8)) + l * 64 + ((16 * lane) & 63);
    const float* gc = (lane < 32 ? kin(15) : kin(16)) + l * 256 + ((8 * lane) & 255);
    float g1[16], g2[8];
#pragma unroll
    for (int j = 0; j < 16; ++j) g1[j] = gna[j] * (lane < 32 ? 0.125f * LOG2E : 1.0f);
#pragma unroll
    for (int j = 0; j < 8; ++j) g2[j] = gc[j];
    for (int m0 = gw; m0 < M; m0 += 4 * NGW) {
        v4u w0[4], w1[4], wc_[4];
#pragma unroll
        for (int t = 0; t < 4; ++t) { const bf16* zr = Z + (size_t)(m0 + t * NGW) * ZP; w0[t] = *(const v4u*)(zr + 16 * lane); w1[t] = *(const v4u*)(zr + 16 * lane + 8); wc_[t] = *(const v4u*)(zr + ZCQ + 8 * lane); }
#pragma unroll
        for (int t = 0; t < 4; ++t) { bf16* zr = Z + (size_t)(m0 + t * NGW) * ZP;
        { float v[16]; const unsigned ww[8] = {w0[t].x, w0[t].y, w0[t].z, w0[t].w, w1[t].x, w1[t].y, w1[t].z, w1[t].w};
          float ss = 0.f;
#pragma unroll
          for (int j = 0; j < 8; ++j) { v[2 * j] = pg8::bflo(ww[j]); v[2 * j + 1] = pg8::bfhi(ww[j]); ss += v[2 * j] * v[2 * j] + v[2 * j + 1] * v[2 * j + 1]; }
          ss += pg8::sx(ss, 1, lane); ss += pg8::sx(ss, 2, lane);
          const float r = 1.0f / sqrtf(ss * (1.0f / 64.0f) + EPS);
          v4u o0, o1;
          o0.x = pk2(v[0] * r * g1[0], v[1] * r * g1[1]); o0.y = pk2(v[2] * r * g1[2], v[3] * r * g1[3]); o0.z = pk2(v[4] * r * g1[4], v[5] * r * g1[5]); o0.w = pk2(v[6] * r * g1[6], v[7] * r * g1[7]);
          o1.x = pk2(v[8] * r * g1[8], v[9] * r * g1[9]); o1.y = pk2(v[10] * r * g1[10], v[11] * r * g1[11]); o1.z = pk2(v[12] * r * g1[12], v[13] * r * g1[13]); o1.w = pk2(v[14] * r * g1[14], v[15] * r * g1[15]);
          *(v4u*)(zr + 16 * lane) = o0; *(v4u*)(zr + 16 * lane + 8) = o1; }
        { float v[8]; const unsigned ww[4] = {wc_[t].x, wc_[t].y, wc_[t].z, wc_[t].w}; float ss = 0.f;
#pragma unroll
          for (int j = 0; j < 4; ++j) { v[2 * j] = pg8::bflo(ww[j]); v[2 * j + 1] = pg8::bfhi(ww[j]); ss += v[2 * j] * v[2 * j] + v[2 * j + 1] * v[2 * j + 1]; }
#pragma unroll
          for (int o = 1; o < 32; o <<= 1) ss += pg8::sx(ss, o, lane);
          const float r = 1.0f / sqrtf(ss * (1.0f / 256.0f) + EPS);
          v4u o; o.x = pk2(v[0] * r * g2[0], v[1] * r * g2[1]); o.y = pk2(v[2] * r * g2[2], v[3] * r * g2[3]); o.z = pk2(v[4] * r * g2[4], v[5] * r * g2[5]); o.w = pk2(v[6] * r * g2[6], v[7] * r * g2[7]);
          *(v4u*)(zr + ZCQ + 8 * lane) = o; } }
    }
}

constexpr int GP = 144;
constexpr int GL_QF = 0, GL_QB = 9216, GL_KF = 18432, GL_KB = 27648, GL_A = 36864  , GL_V = 55296  , GL_G = 73728;
constexpr int GL_BF = GL_G, GL_BB = GL_G + 16640, GL_GLF = GL_G + 33280, GL_GLB = GL_G + 37376, BP = 65;
constexpr int GL_S = GL_G;
constexpr int GL_O = 0;
__device__ __forceinline__ float log_sigmoid(float x) { return fminf(x, 0.f) - 0.6931471805599453f * __builtin_amdgcn_logf(1.0f + __builtin_amdgcn_exp2f(-1.4426950408889634f * fabsf(x))); }

__device__ __forceinline__ void gla_item(const Args& a, int l, int mode, int b, int h, int c, bf16* Z, float* U, const bf16* SP, float* Dd, LAS unsigned char* lds_u, const int wv) {
    LAS char* lds = (LAS char*)lds_u;
    const int tid = opaque_tid_w(wv), lane = tid & 63, wave = __builtin_amdgcn_readfirstlane(tid >> 6), r32 = lane & 31, hi = lane >> 5, i16 = lane & 15, blk = (lane >> 4) & 1;
    const int bh = b * 4 + h; const size_t tok0 = (size_t)b * SEQ + 64 * c;
    LAS float* sBf = (LAS float*)(lds + GL_BF); LAS float* sBb = (LAS float*)(lds + GL_BB); LAS float* sGlf = (LAS float*)(lds + GL_GLF); LAS float* sGlb = (LAS float*)(lds + GL_GLB);
    for (int idx = tid; idx < 2048; idx += NTHR) { const int dx = idx >> 10, t = (idx >> 4) & 63, r = idx & 15;
        const float v = bf2f(Z[(tok0 + t) * ZP + (dx ? ZGBL : ZGFL) + r]); (dx ? sGlb : sGlf)[t * 16 + r] = v; }
#pragma unroll
    for (int i = 0; i < 2; ++i) { const int idx = tid + NTHR * i, t = idx >> 4, ch = idx & 15;
        *(LAS v4u*)(lds + GL_V + t * 288 + ch * 16) = *(const v4u*)(Z + (tok0 + t) * ZP + ZGV + 128 * h + 8 * ch); }
    const int j = tid & 63, tg = tid >> 6;
    float upf[16], upb[16];
    { const float* pf = kin(10) + (size_t)l * 16 * 256 + 64 * h + j; const float* pb = kin(12) + (size_t)l * 16 * 256 + 64 * h + j;
#pragma unroll
      for (int r = 0; r < 16; ++r) { upf[r] = pf[r * 256]; upb[r] = pb[r * 256]; } }
    const float biasf = kin(11)[l * 256 + 64 * h + j], biasb = kin(13)[l * 256 + 64 * h + j];
    bf16 qraw[8], kraw[8];
#pragma unroll
    for (int i = 0; i < 8; ++i) { const int t = tg + 8 * i; qraw[i] = Z[(tok0 + t) * ZP + ZGQ + 64 * h + j]; kraw[i] = Z[(tok0 + t) * ZP + ZGK + 64 * h + j]; }
    __syncthreads();
#pragma unroll
    for (int i = 0; i < 8; ++i) { const int t = tg + 8 * i; float lf = biasf, lb = biasb;
#pragma unroll
        for (int r = 0; r < 16; ++r) { lf += sGlf[t * 16 + r] * upf[r]; lb += sGlb[t * 16 + r] * upb[r]; }
        sBf[t * BP + j] = log_sigmoid(lf) * (1.0f / 16.0f); sBb[t * BP + j] = log_sigmoid(lb) * (1.0f / 16.0f); }
    __syncthreads();
    { LAS float* sB = (wave < 4) ? sBf : sBb; const int jb = (wave & 3) * 16;
      float x[16];
#pragma unroll
      for (int cc = 0; cc < 16; ++cc) x[cc] = sB[lane * BP + jb + cc];
#pragma unroll
      for (int d = 1; d < 64; d <<= 1) {
#pragma unroll
          for (int cc = 0; cc < 16; ++cc) { const float y = __builtin_bit_cast(float, __builtin_amdgcn_ds_bpermute(((wave < 4) ? (lane - d) : (lane + d)) << 2, __builtin_bit_cast(int, x[cc]))); const bool ok = (wave < 4) ? (lane >= d) : (lane + d < 64); x[cc] += ok ? y : 0.f; } }
#pragma unroll
      for (int cc = 0; cc < 16; ++cc) sB[lane * BP + jb + cc] = x[cc]; }
    __syncthreads();
    { const float bl = sBf[63 * BP + j], bs0 = sBb[j];
#pragma unroll
      for (int i = 0; i < 8; ++i) { const int t = tg + 8 * i;
          const float q = bf2f(qraw[i]) * 0.125f, k = bf2f(kraw[i]);
          const float bf = sBf[t * BP + j], bs = sBb[t * BP + j];
          if (mode == 1) {
              *(LAS bf16*)(lds + GL_QF + t * GP + j * 2) = f2bf(q * __expf(bf)); *(LAS bf16*)(lds + GL_KF + t * GP + j * 2) = f2bf(k * __expf(-bf));
              *(LAS bf16*)(lds + GL_QB + t * GP + j * 2) = f2bf(q * __expf(bs)); *(LAS bf16*)(lds + GL_KB + t * GP + j * 2) = f2bf(k * __expf(-bs));
          } else {
              *(LAS bf16*)(lds + GL_A + j * GP + t * 2) = f2bf(k * __expf(bl - bf)); *(LAS bf16*)(lds + GL_A + 9216 + j * GP + t * 2) = f2bf(k * __expf(bs0 - bs));
          } }
      if (mode == 0 && tg == 0) { Dd[((size_t)(0 * 16 + bh) * 64 + c) * 64 + j] = __expf(bl); Dd[((size_t)(1 * 16 + bh) * 64 + c) * 64 + j] = __expf(bs0); } }
    __syncthreads();
    if (mode == 0) {
        const int dir = wave >> 2, dvt = wave & 3;
        float* Ub = U + ((size_t)(dir * 16 + bh) * 64 + c) * 8192;
#pragma unroll
        for (int dkt = 0; dkt < 2; ++dkt) { f32x16 acc = {};
#pragma unroll
            for (int s = 0; s < 4; ++s) {
                const bf16x8 A = *(const LAS bf16x8*)(lds + GL_A + dir * 9216 + (32 * dkt + r32) * GP + (16 * s + 8 * hi) * 2);
                const LAS char* vp = lds + GL_V + (16 * s + 8 * hi + (i16 >> 2)) * 288 + (32 * dvt + 16 * blk + 4 * (i16 & 3)) * 2;
                const bf16x8 B = tr_frag(vp, vp + 4 * 288);
                acc = MFMA32(A, B, acc); }
#pragma unroll
            for (int r = 0; r < 16; ++r) Ub[(32 * dkt + crow(r, hi)) * 128 + 32 * dvt + r32] = acc[r]; }
        __syncthreads();
        return;
    }
    { const int dir = wave >> 2, ti = (wave >> 1) & 1, tj = wave & 1; f32x16 acc = {};
      const int qo = dir ? GL_QB : GL_QF, ko = dir ? GL_KB : GL_KF;
#pragma unroll
      for (int s = 0; s < 4; ++s) {
          const bf16x8 A = *(const LAS bf16x8*)(lds + qo + (32 * ti + r32) * GP + (16 * s + 8 * hi) * 2);
          const bf16x8 B = *(const LAS bf16x8*)(lds + ko + (32 * tj + r32) * GP + (16 * s + 8 * hi) * 2);
          acc = MFMA32(A, B, acc); }
      const int jj = 32 * tj + r32;
#pragma unroll
      for (int r = 0; r < 16; ++r) { const int ii = 32 * ti + crow(r, hi); const bool keep = dir ? (jj > ii) : (jj <= ii);
          *(LAS bf16*)(lds + GL_A + dir * 9216 + ii * GP + jj * 2) = f2bf(keep ? acc[r] : 0.f); } }
#pragma unroll
    for (int i = 0; i < 4; ++i) { const int idx = tid + NTHR * i, dir = idx >> 10, e8 = idx & 1023, dk = e8 >> 4, c8 = e8 & 15;
        *(LAS v4u*)(lds + GL_S + dir * 18432 + dk * 288 + c8 * 16) = *(const v4u*)(SP + ((size_t)(dir * 16 + bh) * 64 + c) * 8192 + dk * 128 + 8 * c8); }
    __syncthreads();
    f32x16 oacc = {};
    const int ti = wave >> 2, dvt = wave & 3;
#pragma unroll
    for (int dir = 0; dir < 2; ++dir) {
        const int qo = dir ? GL_QB : GL_QF;
#pragma unroll
        for (int s = 0; s < 4; ++s) {
            const bf16x8 A1 = *(const LAS bf16x8*)(lds + GL_A + dir * 9216 + (32 * ti + r32) * GP + (16 * s + 8 * hi) * 2);
            const LAS char* vp = lds + GL_V + (16 * s + 8 * hi + (i16 >> 2)) * 288 + (32 * dvt + 16 * blk + 4 * (i16 & 3)) * 2;
            oacc = MFMA32(A1, tr_frag(vp, vp + 4 * 288), oacc);
            const bf16x8 A2 = *(const LAS bf16x8*)(lds + qo + (32 * ti + r32) * GP + (16 * s + 8 * hi) * 2);
            const LAS char* sp = lds + GL_S + dir * 18432 + (16 * s + 8 * hi + (i16 >> 2)) * 288 + (32 * dvt + 16 * blk + 4 * (i16 & 3)) * 2;
            oacc = MFMA32(A2, tr_frag(sp, sp + 4 * 288), oacc); } }
    __syncthreads();
#pragma unroll
    for (int r = 0; r < 16; ++r) *(LAS float*)(lds + GL_O + ((32 * ti + crow(r, hi)) * 132 + 32 * dvt + r32) * 4) = oacc[r];
    __syncthreads();
    { const int row = tid >> 3, seg = tid & 7; float v[16]; float ss = 0.f;
#pragma unroll
      for (int q4 = 0; q4 < 4; ++q4) { const f32x4 t = *(const LAS f32x4*)(lds + GL_O + (row * 132 + 16 * seg + 4 * q4) * 4); v[4 * q4] = t.x; v[4 * q4 + 1] = t.y; v[4 * q4 + 2] = t.z; v[4 * q4 + 3] = t.w; }
#pragma unroll
      for (int q = 0; q < 16; ++q) ss += v[q] * v[q];
      ss += pg8::sx(ss, 1, lane); ss += pg8::sx(ss, 2, lane); ss += pg8::sx(ss, 4, lane);
      const float rr = 1.0f / sqrtf(ss * (1.0f / 128.0f) + EPS);
      bf16* zr = Z + (tok0 + row) * ZP;
      const v4u g0 = *(const v4u*)(zr + ZGR + 128 * h + 16 * seg), g1 = *(const v4u*)(zr + ZGR + 128 * h + 16 * seg + 8);
      const unsigned gw_[8] = {g0.x, g0.y, g0.z, g0.w, g1.x, g1.y, g1.z, g1.w};
      const float* gn = kin(14) + l * 128 + 16 * seg;
      unsigned ow[8];
#pragma unroll
      for (int q = 0; q < 8; ++q) { const float ga = pg8::bflo(gw_[q]), gb = pg8::bfhi(gw_[q]);
          const float ya = (v[2 * q] * rr * gn[2 * q]) * (ga * pg8::fsigmoid(ga)), yb = (v[2 * q + 1] * rr * gn[2 * q + 1]) * (gb * pg8::fsigmoid(gb));
          ow[q] = pk2(ya, yb); }
      *(v4u*)(zr + ZGV + 128 * h + 16 * seg) = (v4u){ow[0], ow[1], ow[2], ow[3]}; *(v4u*)(zr + ZGV + 128 * h + 16 * seg + 8) = (v4u){ow[4], ow[5], ow[6], ow[7]}; }
    __syncthreads();
}
__device__ __forceinline__ void gla_scan_phase(const float* U, bf16* SP, const float* Dd, const int wv) {
    const int gtid = blockIdx.x * NTHR + opaque_tid_w(wv), gthreads = gridDim.x * NTHR;
    for (int ch = gtid; ch < 2 * 16 * 4096; ch += gthreads) {
        const int e = ch & 4095, db = ch >> 12, dir = db >> 4;
        const float* Ub = U + (size_t)db * 64 * 8192 + 2 * e; unsigned* Sb = (unsigned*)SP + (size_t)db * 64 * 4096 + e; const float* Db = Dd + (size_t)db * 64 * 64 + (e >> 6);
        float s0 = 0.f, s1 = 0.f;
        for (int cc = 0; cc < 64; cc += 16) { float u0[16], u1[16], d[16];
#pragma unroll
            for (int k = 0; k < 16; ++k) { const int c = dir ? 63 - (cc + k) : cc + k; const float* p = Ub + (size_t)c * 8192; u0[k] = p[0]; u1[k] = p[1]; d[k] = Db[c * 64]; }
#pragma unroll
            for (int k = 0; k < 16; ++k) { const int c = dir ? 63 - (cc + k) : cc + k; Sb[(size_t)c * 4096] = pk2(s0, s1); s0 = d[k] * s0 + u0[k]; s1 = d[k] * s1 + u1[k]; } }
    }
}

__device__ __forceinline__ void na_phase(const Args& a, int l, bf16* Z, LAS unsigned char* lds_u, bf16* O, int OP, const int wv) {
    const int tid = opaque_tid_w(wv), lane = tid & 63, wave = __builtin_amdgcn_readfirstlane(tid >> 6), NGW = gridDim.x * NWAVES;
    const int bxs = opaque_s(blockIdx.x), Gs = gridDim.x, vcu = (Gs % 8 == 0) ? (bxs % 8) * (Gs / 8) + bxs / 8 : bxs, gw = vcu * NWAVES + wave;
    LAS char* wvl = (LAS char*)lds_u + wave * 16384;
    const int l15 = lane & 15, quad = lane >> 4;
    for (int it = gw; it < 8192; it += NGW) {
        const int j = it & 3, r = (it >> 2) & 63, h = (it >> 8) & 7, b = it >> 11;
        const int r0 = min(max(r - 4, 0), 56), k0 = min(max(16 * j - 8, 0), 32);
        const size_t tq = (size_t)b * SEQ + r * 64 + 16 * j + l15;
        const bf16* qp = Z + tq * ZP + ZQ_NA + 64 * h + 8 * quad;
        const bf16x8 qf0 = *(const bf16x8*)qp, qf1 = *(const bf16x8*)(qp + 32);
        f32x4 s[16];
#pragma unroll
        for (int kt = 0; kt < 16; ++kt) { const size_t tk = (size_t)b * SEQ + (r0 + (kt >> 1)) * 64 + k0 + 16 * (kt & 1) + l15;
            const bf16* kp = Z + tk * ZP + ZK_NA + 64 * h + 8 * quad;
            const bf16x8 kf0 = *(const bf16x8*)kp, kf1 = *(const bf16x8*)(kp + 32);
            f32x4 acc = {0.f, 0.f, 0.f, 0.f}; acc = MFMA16(kf0, qf0, acc); acc = MFMA16(kf1, qf1, acc); s[kt] = acc; if ((kt & 7) == 7) asm volatile("" ::: "memory"); }
        v4u vreg[16];
#pragma unroll
        for (int i = 0; i < 16; ++i) { const int id = lane + 64 * i, tl = id >> 3, ch = id & 7;
            const size_t tk = (size_t)b * SEQ + (r0 + (tl >> 5)) * 64 + k0 + (tl & 31); vreg[i] = *(const v4u*)(Z + tk * ZP + ZV_NA + 64 * h + 8 * ch); }
        const int qc = 16 * j + l15, c0 = min(max(qc - 8, 0), 48);
        const float* rp = kin(9) + (size_t)((l * 8 + h) * 15) * 31;
        float mx = -1e30f;
#pragma unroll
        for (int kt = 0; kt < 16; ++kt)
#pragma unroll
            for (int i = 0; i < 4; ++i) { const int kc = k0 + 16 * (kt & 1) + 4 * quad + i, kr = r0 + (kt >> 1), dr = kr - r + 7, dc = min(max(kc - qc + 15, 0), 30);
                const bool ok = (kc >= c0) && (kc < c0 + 16);
                const float v = ok ? s[kt][i] + rp[dr * 31 + dc] * LOG2E : -1e30f; s[kt][i] = v; mx = fmaxf(mx, v); }
        mx = fmaxf(mx, pg8::sx(mx, 16, lane)); mx = fmaxf(mx, pg8::sx(mx, 32, lane));
        float lsum = 0.f;
#pragma unroll
        for (int kt = 0; kt < 16; ++kt)
#pragma unroll
            for (int i = 0; i < 4; ++i) { const float p = __builtin_amdgcn_exp2f(s[kt][i] - mx); s[kt][i] = p; lsum += p; }
        lsum += pg8::sx(lsum, 16, lane); lsum += pg8::sx(lsum, 32, lane);
        const float inv = 1.0f / lsum;
        f32x4 o[4];
#pragma unroll
        for (int c = 0; c < 4; ++c) o[c] = (f32x4){0.f, 0.f, 0.f, 0.f};
#define NA_LOADV(half) do { _Pragma("unroll") for (int i = 0; i < 16; ++i) { const int id = lane + 64 * i, tl = id >> 3, ch = id & 7; \
            const size_t tk = (size_t)b * SEQ + (r0 + 4 * (half) + (tl >> 5)) * 64 + k0 + (tl & 31); vreg[i] = *(const v4u*)(Z + tk * ZP + ZV_NA + 64 * h + 8 * ch); } } while (0)
#define NA_STOREV() do { _Pragma("unroll") for (int i = 0; i < 16; ++i) { const int id = lane + 64 * i, tl = id >> 3, ch = id & 7; *(LAS v4u*)(wvl + tl * 128 + ch * 16) = vreg[i]; } } while (0)
#pragma unroll
        for (int half = 0; half < 2; ++half) {
            LDS_WAIT();
            NA_STOREV();
            if (half == 0) NA_LOADV(1);
            LDS_WAIT();
#pragma unroll
            for (int s4 = 0; s4 < 4; ++s4) { const int sw = 4 * half + s4;
                const bf16x8 pf = pack8(s[2 * sw][0], s[2 * sw][1], s[2 * sw][2], s[2 * sw][3], s[2 * sw + 1][0], s[2 * sw + 1][1], s[2 * sw + 1][2], s[2 * sw + 1][3]);
#pragma unroll
                for (int c = 0; c < 4; ++c) { const LAS char* vp = wvl + (32 * s4 + 4 * quad + (l15 >> 2)) * 128 + (16 * c + 4 * (l15 & 3)) * 2;
                    o[c] = MFMA16(tr_frag(vp, vp + 16 * 128), pf, o[c]); } }
        }
#undef NA_LOADV
#undef NA_STOREV
        bf16* op = O + tq * OP + 64 * h + 4 * quad;
#pragma unroll
        for (int c = 0; c < 4; ++c) { v2u w; w.x = pk2(o[c][0] * inv, o[c][1] * inv); w.y = pk2(o[c][2] * inv, o[c][3] * inv); *(v2u*)(op + 16 * c) = w; }
    }
    LDS_WAIT();
}

__device__ __forceinline__ void mla_prep_phase(const Args& a, int l, const bf16* Z, bf16* QR, const bf16* KVR, bf16* KF, const int wv) {
    const int tid = opaque_tid_w(wv), lane = tid & 63, wave = __builtin_amdgcn_readfirstlane(tid >> 6), gw = blockIdx.x * NWAVES + wave, NGW = gridDim.x * NWAVES;
    const float* qn = kin(19) + l * 192; const float* kn = kin(20) + l * 192;
    const float gq0 = qn[2 * lane], gq1 = qn[2 * lane + 1], gq2 = qn[128 + lane];
    const float gk0 = kn[2 * lane], gk1 = kn[2 * lane + 1], gk2 = kn[128 + lane];
    const float inv_freq = exp2f(-(float)(lane & 31) * (13.287712379549449f / 32.0f));
    const float qs = 0.07216878364870322f * LOG2E;
    for (int m0 = gw; m0 < M; m0 += 2 * NGW) {
        unsigned qw[2][4], kw[2][4]; float qrp[2][4], krp[2], sn[2], cs[2];
#pragma unroll
        for (int t = 0; t < 2; ++t) { const int m = m0 + t * NGW;
            krp[t] = bf2f(Z[(size_t)m * ZP + ZKR + lane]);
#pragma unroll
            for (int h = 0; h < 4; ++h) { const bf16* qp = QR + (size_t)m * 768 + 192 * h; qw[t][h] = *(const unsigned*)(qp + 2 * lane); qrp[t][h] = bf2f(qp[128 + lane]);
                kw[t][h] = *(const unsigned*)(KVR + (size_t)m * 1024 + 256 * h + 2 * lane); }
            sincosf((float)(m & (SEQ - 1)) * inv_freq, &sn[t], &cs[t]); }
        float sq[2][4], sk[2][4];
#pragma unroll
        for (int t = 0; t < 2; ++t)
#pragma unroll
            for (int h = 0; h < 4; ++h) { const float a0 = pg8::bflo(qw[t][h]), a1 = pg8::bfhi(qw[t][h]), b0 = pg8::bflo(kw[t][h]), b1 = pg8::bfhi(kw[t][h]);
                sq[t][h] = a0 * a0 + a1 * a1 + qrp[t][h] * qrp[t][h]; sk[t][h] = b0 * b0 + b1 * b1 + krp[t] * krp[t]; }
#pragma unroll
        for (int o = 1; o < 64; o <<= 1)
#pragma unroll
            for (int t = 0; t < 2; ++t)
#pragma unroll
                for (int h = 0; h < 4; ++h) { sq[t][h] += pg8::sx(sq[t][h], o, lane); sk[t][h] += pg8::sx(sk[t][h], o, lane); }
#pragma unroll
        for (int t = 0; t < 2; ++t) { const int m = m0 + t * NGW;
#pragma unroll
            for (int h = 0; h < 4; ++h) {
                { bf16* qp = QR + (size_t)m * 768 + 192 * h; const float r = 1.0f / sqrtf(sq[t][h] * (1.0f / 192.0f) + EPS);
                  const float x = qrp[t][h] * r * gq2, y = pg8::sx(x, 32, lane); const float ro = (lane < 32) ? (x * cs[t] - y * sn[t]) : (y * sn[t] + x * cs[t]);
                  *(unsigned*)(qp + 2 * lane) = pk2(pg8::bflo(qw[t][h]) * r * gq0 * qs, pg8::bfhi(qw[t][h]) * r * gq1 * qs); qp[128 + lane] = f2bf(ro * qs); }
                { bf16* ko = KF + (size_t)m * 768 + 192 * h; const float r = 1.0f / sqrtf(sk[t][h] * (1.0f / 192.0f) + EPS);
                  const float x = krp[t] * r * gk2, y = pg8::sx(x, 32, lane); const float ro = (lane < 32) ? (x * cs[t] - y * sn[t]) : (y * sn[t] + x * cs[t]);
                  *(unsigned*)(ko + 2 * lane) = pk2(pg8::bflo(kw[t][h]) * r * gk0, pg8::bfhi(kw[t][h]) * r * gk1); ko[128 + lane] = f2bf(ro); } } }
    }
}

constexpr int MK_P = 400, MV_P = 288, MK_BYTES = 64 * MK_P, MV_BYTES = 64 * MV_P, MV_OFF = 2 * MK_BYTES;
__device__ __forceinline__ void mla_attn_unit(LAS unsigned char* lds_u, const bf16* QF, const bf16* KF, const bf16* KVR, bf16* Z, int b, int h, int qb, const int wv) {
    LAS char* lds = (LAS char*)lds_u;
    const int tid = opaque_tid_w(wv), lane = tid & 63, wave = __builtin_amdgcn_readfirstlane(tid >> 6), r32 = lane & 31, hi = lane >> 5, i16 = lane & 15, blk = (lane >> 4) & 1;
    const size_t tokb = (size_t)b * SEQ;
    const size_t qtok = tokb + 256 * qb + 32 * wave + r32;
    bf16x8 qf[12];
    { const bf16* qp = QF + qtok * 768 + 192 * h + 8 * hi;
#pragma unroll
      for (int s = 0; s < 12; ++s) qf[s] = *(const bf16x8*)(qp + 16 * s); }
    f32x16 o[4];
#pragma unroll
    for (int c = 0; c < 4; ++c) o[c] = f32x16{};
    float mrun = -1e30f, lrun = 0.f;
    int krow[3], kch[3];
#pragma unroll
    for (int i = 0; i < 3; ++i) { const int id = tid + NTHR * i; krow[i] = id / 24; kch[i] = id - krow[i] * 24; }
    const bf16* kbase = KF + tokb * 768 + 192 * h; const bf16* vbase = KVR + tokb * 1024 + 256 * h + 128;
    v4u kreg[3], vreg[2];
#define MLA_LOAD(t) do { _Pragma("unroll") for (int i = 0; i < 3; ++i) kreg[i] = *(const v4u*)(kbase + (size_t)(64 * (t) + krow[i]) * 768 + 8 * kch[i]); \
        _Pragma("unroll") for (int i = 0; i < 2; ++i) { const int id = tid + NTHR * i; vreg[i] = *(const v4u*)(vbase + (size_t)(64 * (t) + (id >> 4)) * 1024 + 8 * (id & 15)); } } while (0)
#define MLA_STORE(kbuf, vbuf) do { _Pragma("unroll") for (int i = 0; i < 3; ++i) *(LAS v4u*)(lds + (kbuf) * MK_BYTES + krow[i] * MK_P + kch[i] * 16) = kreg[i]; \
        _Pragma("unroll") for (int i = 0; i < 2; ++i) { const int id = tid + NTHR * i; *(LAS v4u*)(lds + MV_OFF + (vbuf) * MV_BYTES + (id >> 4) * MV_P + (id & 15) * 16) = vreg[i]; } } while (0)
#define SB() __builtin_amdgcn_sched_barrier(0)
    bf16x8 fr8[8];
#define MLA_VLD(vb_, j, n) do { const LAS char* vp = (vb_) + (16 * ((n) & 3) + 4 * hi + (i16 >> 2)) * MV_P + (32 * ((n) >> 2) + 16 * blk + 4 * (i16 & 3)) * 2; fr8[j] = tr_frag(vp, vp + 8 * MV_P); } while (0)
#define MLA_PV(vb_) do { _Pragma("unroll") for (int j = 0; j < 8; ++j) MLA_VLD(vb_, j, j); SB(); \
        _Pragma("unroll") for (int n = 0; n < 16; ++n) { o[n >> 2] = MFMA32(fr8[n & 7], pf[n & 3], o[n >> 2]); if (n < 8) MLA_VLD(vb_, n & 7, n + 8); SB(); } } while (0)
    const bool late = wave >= 4;
    bf16x8 pf[4] = {};
    MLA_LOAD(0); MLA_STORE(0, 0);
    __syncthreads();
    int vcur = 0, vprev = 2;
    for (int t = 0; t < 64; ++t) {
        const int cur = t & 1;
        if (t + 1 < 64) MLA_LOAD(t + 1);
        const LAS char* kb = lds + cur * MK_BYTES; const LAS char* vb = lds + MV_OFF + vcur * MV_BYTES;
        if (late && t > 0) MLA_PV(lds + MV_OFF + vprev * MV_BYTES);
        f32x16 p0 = f32x16{}, p1 = f32x16{};
#define MLA_KLD(j, s, half) fr8[j] = *(const LAS bf16x8*)(kb + ((half) * 32 + r32) * MK_P + (16 * (s) + 8 * hi) * 2)
#pragma unroll
        for (int i = 0; i < 4; ++i) { MLA_KLD(2 * i, i, 0); MLA_KLD(2 * i + 1, i, 1); }
        SB();
#pragma unroll
        for (int g = 0; g < 3; ++g)
#pragma unroll
            for (int i = 0; i < 4; ++i) {
                p0 = MFMA32(fr8[2 * i], qf[4 * g + i], p0); if (g < 2) MLA_KLD(2 * i, 4 * (g + 1) + i, 0);
                p1 = MFMA32(fr8[2 * i + 1], qf[4 * g + i], p1); if (g < 2) MLA_KLD(2 * i + 1, 4 * (g + 1) + i, 1);
                SB(); }
#undef MLA_KLD
        float mx = fmaxf(p0[0], p1[0]);
#pragma unroll
        for (int r = 1; r < 16; ++r) mx = fmaxf(mx, fmaxf(p0[r], p1[r]));
        mx = fmaxf(mx, pg8::sx(mx, 32, lane));
        if (__any(mx > mrun)) {
            const float mn_ = fmaxf(mrun, mx), f = __builtin_amdgcn_exp2f(mrun - mn_); mrun = mn_; lrun *= f;
#pragma unroll
            for (int c = 0; c < 4; ++c)
#pragma unroll
                for (int r = 0; r < 16; ++r) o[c][r] *= f;
        }
        const float mn = mrun;
        float ls = 0.f;
#pragma unroll
        for (int r = 0; r < 16; ++r) { p0[r] = __builtin_amdgcn_exp2f(p0[r] - mn); p1[r] = __builtin_amdgcn_exp2f(p1[r] - mn); ls += p0[r] + p1[r]; }
        lrun += ls;
        pf[0] = pack8(p0[0], p0[1], p0[2], p0[3], p0[4], p0[5], p0[6], p0[7]); pf[1] = pack8(p0[8], p0[9], p0[10], p0[11], p0[12], p0[13], p0[14], p0[15]);
        pf[2] = pack8(p1[0], p1[1], p1[2], p1[3], p1[4], p1[5], p1[6], p1[7]); pf[3] = pack8(p1[8], p1[9], p1[10], p1[11], p1[12], p1[13], p1[14], p1[15]);
        if (!late) MLA_PV(vb);
        const int vnext = (vcur == 2) ? 0 : vcur + 1;
        if (t + 1 < 64) MLA_STORE(cur ^ 1, vnext);
        vprev = vcur; vcur = vnext;
        __syncthreads();
    }
    if (late) MLA_PV(lds + MV_OFF + vprev * MV_BYTES);
#undef MLA_LOAD
#undef MLA_STORE
#undef MLA_PV
#undef MLA_VLD
#undef SB
    lrun += pg8::sx(lrun, 32, lane);
    const float inv = 1.0f / lrun;
    bf16* op = Z + qtok * ZP + ZCQ + 128 * h + 4 * hi;
#pragma unroll
    for (int c = 0; c < 4; ++c)
#pragma unroll
        for (int g4 = 0; g4 < 4; ++g4) { v2u w; w.x = pk2(o[c][4 * g4] * inv, o[c][4 * g4 + 1] * inv); w.y = pk2(o[c][4 * g4 + 2] * inv, o[c][4 * g4 + 3] * inv);
            *(v2u*)(op + 32 * c + 8 * g4) = w; }
}

__device__ __forceinline__ void zero_f32(float* p, int n, const int wv) { const int t0 = opaque_s(blockIdx.x) * NTHR + opaque_tid_w(wv); for (int i = t0; i < n; i += gridDim.x * NTHR) __hip_atomic_store((unsigned*)p + i, 0u, __ATOMIC_RELAXED, __HIP_MEMORY_SCOPE_AGENT); }
#ifndef DUP_MASK
#define DUP_MASK 0
#endif
#ifndef PH_MASK
#define PH_MASK 0xFFFF
#endif
#if DUP_MASK & 8
#define GSYNC() do { xcd_barrier(xbar, leader); xcd_barrier(xbar, leader); } while (0)
#else
#define GSYNC() xcd_barrier(xbar, leader)
#endif
__global__ void __launch_bounds__(NTHR, 2) mega_fwd(Args a) {
    extern __shared__ __attribute__((aligned(16))) unsigned char lds_raw[];
    LAS unsigned char* lds = (LAS unsigned char*)lds_raw;
    cg::grid_group grid = cg::this_grid();
    const int wv = __builtin_amdgcn_readfirstlane((int)threadIdx.x >> 6);
    const bool leader = (threadIdx.x == 0);
    if (threadIdx.x < 2) ((volatile LAS unsigned*)(lds + 131072))[threadIdx.x] = 0u;
    __syncthreads();
    XcdBarrier xbar; xbar.bar = (unsigned*)((unsigned char*)kin(30)); xbar.x = xb_xcc_id(); xbar.st = (volatile LAS unsigned*)(lds + 131072);
    if (blockIdx.x == 0) for (int i = threadIdx.x; i < 4096; i += NTHR) __hip_atomic_store(xbar.bar + i, 0u, __ATOMIC_RELAXED, __HIP_MEMORY_SCOPE_AGENT);
    const int G = gridDim.x, bx = blockIdx.x;
    const int vcu = (G % 8 == 0) ? (bx % 8) * (G / 8) + bx / 8 : bx;
#define ws ((unsigned char*)kin(30))
#define XB ((bf16*)(ws + WS_XN))
#define MIXB ((bf16*)(ws + WS_QR))
#define Z ((bf16*)(ws + WS_Z))
#define Hb ((bf16*)(ws + WS_Z))
#define SSa ((unsigned*)(ws + WS_PS))
#define SSb (SSa + M)
#define SSc (SSa + 2 * M)
#define QR ((bf16*)(ws + WS_QR))
#define KVR ((bf16*)(ws + WS_KVR))
#define KF ((bf16*)(ws + WS_KF))
#define U ((float*)(ws + WS_U))
#define MIXF ((float*)(ws + WS_U))
#define Dd ((float*)(ws + WS_DD))
#define wt (ws + WS_WT)
#define out ((float*)kin(29))
#ifdef TSEL_MASK
    unsigned long long tacc = 0, tprev = __builtin_amdgcn_s_memrealtime();
#endif
    for (int step = 0; step < DEPTH * 12; ++step) {
        const int l = step / 12, ph = step - l * 12;
        const float* xin = (l == 0) ? kin(0) : out;
        switch (ph) {
        case 0: {
#if (PH_MASK >> 0) & 1
        convert_set(a, l, lds, wv, (l == 0) ? 0x80Bu : 0x80Au  , opaque_s(bx) * NWAVES + wv, G * NWAVES, true);
        if (l == 0) { xprep_phase(kin(0), XB, SSc, wv); zero_f32((float*)SSa, 2 * M, wv); }
#endif
        } break;
        case 1: case 10: {
#if (PH_MASK >> 1) & 1
        { const bool second = (ph == 10);
          pg8::Gemm g{XB, (const bf16*)(wt + (second ? WT_13B : WT_13A)), M, 2 * FF, DM, DM, DM}; pg8::StaticOrder S; S.init(M, 2 * FF, opaque_s(G), opaque_s(bx));
          pg8::EpiSwiGLU E{Hb, FF, second ? SSb : SSc}; pg8::gemm_phase<pg8::EpiSwiGLU, pg8::StaticOrder, true, true>(lds, g, S, E, wv);
#if DUP_MASK & 1
          __syncthreads(); pg8::gemm_phase<pg8::EpiSwiGLU, pg8::StaticOrder, true, true>(lds, g, S, E, wv);
#endif
          __syncthreads();
          convert_tail(a, l, lds, wv, second ? 0x1000u   : 0x404u  , (M / 256) * (2 * FF / 256));
          if (second && l + 1 < DEPTH) convert_tail(a, l + 1, lds, wv, 0x001u  , (M / 256) * (2 * FF / 256));
        }
#endif
        } break;
        case 2: case 9: case 11: {
#if (PH_MASK >> 2) & 1
        { const bool isout = (ph == 9);
          const bf16* Ap = isout ? MIXB : Hb; const size_t wo = isout ? WT_OUT : (ph == 2 ? WT_2A : WT_2B); const int Kd = isout ? DM : FF;
          pg8::Gemm g{Ap, (const bf16*)(wt + wo), M, DM, Kd, Kd, Kd}; pg8::StaticOrder S; S.init(M, DM, opaque_s(G), opaque_s(bx));
          unsigned* SSp = SSa + (isout ? M : (ph == 2 ? 0 : 2 * M));
          pg8::EpiResid E{(ph == 2) ? xin : (const float*)out, out, DM, isout ? 1.0f : 0.5f, XB, SSp}; pg8::gemm_phase<pg8::EpiResid, pg8::StaticOrder, true, true>(lds, g, S, E, wv); }
#endif
        } break;
        case 3: {
#if (PH_MASK >> 4) & 1
        { pg8::Gemm g{XB, (const bf16*)(wt + WT_IN), M, ZP, DM, DM, DM}; pg8::StaticOrder S; S.init(M, ZP, opaque_s(G), opaque_s(bx));
          pg8::EpiBf16<true> E{Z, ZP, SSa}; pg8::gemm_phase<pg8::EpiBf16<true>, pg8::StaticOrder, true, true>(lds, g, S, E, wv); }
        __syncthreads();
        convert_tail(a, l, lds, wv, 0x3F0u  , (M / 256) * (ZP / 256));
#endif
        } break;
        case 4: {
#if (PH_MASK >> 5) & 1
        zero_f32((float*)SSa, 3 * M, wv);
        token_prep_phase(a, l, Z, wv);
        for (int it = opaque_s(bx); it < 1024; it += G) gla_item(a, l, 0, it >> 8, (it >> 6) & 3, it & 63, Z, U, (const bf16*)XB, Dd, lds, wv);
#if DUP_MASK & 32
        for (int it = opaque_s(bx); it < 1024; it += G) gla_item(a, l, 0, it >> 8, (it >> 6) & 3, it & 63, Z, U, (const bf16*)XB, Dd, lds, wv);
#endif
#endif
        } break;
        case 5: {
#if (PH_MASK >> 6) & 1
        { pg8::Gemm g{Z + ZCQ, (const bf16*)(wt + WT_UQ), M, 768, 256, ZP, 256}; pg8::StaticOrder S; S.init(M, 768, opaque_s(G), opaque_s(bx));
          pg8::EpiBf16<false> E{QR, 768, nullptr}; pg8::gemm_phase<pg8::EpiBf16<false>, pg8::StaticOrder, true, true>(lds, g, S, E, wv); }
        __syncthreads();
        { pg8::Gemm g{Z + ZCKV, (const bf16*)(wt + WT_UKV), M, 1024, 256, ZP, 256}; pg8::StaticOrder S; S.init(M, 1024, opaque_s(G), opaque_s(bx));
          pg8::EpiBf16<false> E{KVR, 1024, nullptr}; pg8::gemm_phase<pg8::EpiBf16<false>, pg8::StaticOrder, true, true>(lds, g, S, E, wv); }
        __syncthreads();
        for (int st = 0; st < 2; ++st) {
            if ((st == 0) == (wv < 4)) gla_scan_phase(U, (bf16*)XB, Dd, wv);
            else na_phase(a, l, Z, lds, Z + ZQ_NA, ZP, wv);
        }
#endif
        } break;
        case 6: {
#if (PH_MASK >> 7) & 1
        for (int st = 0; st < 2; ++st) {
            if ((st == 0) == ((opaque_s(bx) & 1) == 0)) mla_prep_phase(a, l, Z, QR, KVR, KF, wv);
            else for (int it = opaque_s(bx); it < 1024; it += G) gla_item(a, l, 1, it >> 8, (it >> 6) & 3, it & 63, Z, U, (const bf16*)XB, Dd, lds, wv);
            __syncthreads();
        }
#endif
        } break;
        case 7: {
#if (PH_MASK >> 8) & 1
        for (int u = opaque_s(vcu); u < 256; u += G) { mla_attn_unit(lds, QR, KF, KVR, Z, (u >> 4) >> 2, (u >> 4) & 3, u & 15, wv); __syncthreads(); }
#if DUP_MASK & 2
        for (int u = opaque_s(vcu); u < 256; u += G) { mla_attn_unit(lds, QR, KF, KVR, Z, (u >> 4) >> 2, (u >> 4) & 3, u & 15, wv); __syncthreads(); }
#endif
#endif
        } break;
        case 8: {
#if (PH_MASK >> 9) & 1
        { pg8::Gemm g{Z, (const bf16*)(wt + WT_BR), M, 1024, 512, ZP, 512}; pg8::MergeOrder S{opaque_s(G), opaque_s(vcu), ZQ_NA, ZGV, ZCQ};
          pg8::EpiMerge E{Z, ZP, ZGATE, MIXB}; pg8::gemm_phase<pg8::EpiMerge, pg8::MergeOrder, true, true>(lds, g, S, E, wv); }
#endif
        } break;
        default: break;
        }
        if (step == 0) { grid.sync(); if (leader) (void)xb_add(&xbar.bar[XB_XCNT(xbar.x)], 1u); }
        else GSYNC();
#ifdef TSEL_MASK
        { const unsigned long long tnow = __builtin_amdgcn_s_memrealtime(); if ((TSEL_MASK >> ph) & 1) tacc += tnow - tprev; tprev = tnow; }
#endif
    }
#ifdef TSEL_MASK
    if (blockIdx.x == 0) { const unsigned long long t0 = __builtin_amdgcn_s_memrealtime(); while (__builtin_amdgcn_s_memrealtime() - t0 < 9ull * tacc) __builtin_amdgcn_s_sleep(8); }
#endif
}

#undef ws
#undef XB
#undef MIXB
#undef Z
#undef Hb
#undef SSa
#undef SSb
#undef SSc
#undef QR
#undef KVR
#undef KF
#undef U
#undef MIXF
#undef Dd
#undef wt
#undef out
extern "C" void kernel_launch(void* const* d_in, const int* in_sizes, int n_in, void* d_out, int out_size, void* d_ws, size_t ws_size, hipStream_t stream) {
    static int grid = 0;
    if (grid == 0) {
        if (n_in != 29 || out_size != M * DM || ws_size < WS_END) { fprintf(stderr, "kernel_launch: unexpected shapes / workspace (%d inputs, out %d, ws %zu)\n", n_in, out_size, ws_size); grid = -1; return; }
        int dev = 0, cus = 0, per_cu = 0;
        (void)hipGetDevice(&dev); (void)hipDeviceGetAttribute(&cus, hipDeviceAttributeMultiprocessorCount, dev);
        (void)hipFuncSetAttribute((const void*)mega_fwd, hipFuncAttributeMaxDynamicSharedMemorySize, LDS_BYTES);
        if (hipOccupancyMaxActiveBlocksPerMultiprocessor(&per_cu, (const void*)mega_fwd, NTHR, LDS_BYTES) != hipSuccess || per_cu < 1) per_cu = 1;
        (void)hipGetLastError();
        grid = cus * per_cu; if (grid > 256) grid = 256;
        if (grid <= 0) grid = 256;
    }
    if (grid < 0) return;
    Args a{};
    for (int i = 0; i < 29; ++i) a.in[i] = (const float*)d_in[i];
    a.out = (float*)d_out; a.ws = (unsigned char*)d_ws;
    void* args[] = {&a};
    hipError_t e = hipLaunchCooperativeKernel((const void*)mega_fwd, dim3(grid), dim3(NTHR), args, LDS_BYTES, stream);
    if (e != hipSuccess) fprintf(stderr, "cooperative launch failed: %s (grid %d)\n", hipGetErrorString(e), grid);
}
```

```cpp
#include <hip/hip_runtime.h>
#include <hip/hip_cooperative_groups.h>
#include <cstdio>
#include <cstdint>
namespace cg = cooperative_groups;

namespace pg8 {
#define PG8_LAS __attribute__((address_space(3)))
typedef unsigned short bf16_t;
typedef short bf16x8 __attribute__((ext_vector_type(8)));
typedef float f32x4 __attribute__((ext_vector_type(4)));
typedef unsigned u32x4 __attribute__((ext_vector_type(4)));
typedef unsigned u32x2 __attribute__((ext_vector_type(2)));
constexpr int BM = 256, BK = 64, HALF = 128, HTB = HALF * BK * 2  , STAGE_BYTES = 8 * HTB, NXCD = 8, WGM = 8;

__host__ __device__ __forceinline__ int lds_byte(int r, int c) { const int st = (r >> 4) * 2 + (c >> 5), rr = r & 15, cc = c & 31, ob = rr * 64 + cc * 2; return st * 1024 + (ob ^ (((ob >> 9) & 1) << 5)); }
__host__ __device__ __forceinline__ void stage_rc(int b, int& R, int& C) { const int st = b / 1024, sb = b % 1024, swz = sb ^ (((sb >> 9) & 1) << 5); R = (st >> 1) * 16 + swz / 64; C = (st & 1) * 32 + (swz % 64) / 2; }
__host__ __device__ __forceinline__ int perm32(int rho) { const int n = rho >> 4, i = rho & 15; return 8 * (i >> 2) + 4 * n + (i & 3); }

struct Unit { int pm, pn; };
struct Gemm { const bf16_t* A; const bf16_t* Bt; int M, N, K, lda, ldb; };

struct StaticOrder {
    int nM, nN, nwg, G, c;
    __host__ __device__ void init(int M, int N, int G_, int c_) { nM = M / BM; nN = N / BM; nwg = nM * nN; G = G_; c = c_; }
    __host__ __device__ __forceinline__ bool next(int i, Unit& u) const {
        const long L = (long)i * G + c; if (L >= nwg) return false;
        int wgid = (int)L; { const int q = nwg / NXCD, r = nwg % NXCD, xcd = wgid % NXCD, off = wgid / NXCD; wgid = (xcd < r ? xcd * (q + 1) : r * (q + 1) + (xcd - r) * q) + off; }
        const int nig = WGM * nN, gid = wgid / nig, fm = gid * WGM, gsz = (nM - fm) < WGM ? (nM - fm) : WGM;
        u.pm = fm + ((wgid % nig) % gsz); u.pn = (wgid % nig) / gsz; return true;
    }
    __device__ __forceinline__ size_t aoff(const Unit& u, const Gemm& g) const { return (size_t)u.pm * BM * g.lda * 2; }
    __device__ __forceinline__ size_t boff(const Unit& u, const Gemm& g) const { return (size_t)u.pn * BM * g.ldb * 2; }
    __device__ __forceinline__ void a_ready(const Unit&) const {}
    __device__ __forceinline__ void done(const Unit&) const {}
};
struct MergeOrder {
    int G, c; int acol0, acol1, acol2;
    __device__ __forceinline__ bool next(int k, Unit& u) const { const int t = c + (k / 3) * G; if (t >= 256) return false; const int i = k % 3; u.pm = i * 64 + (t >> 2); u.pn = i * 4 + (t & 3); return true; }
    __device__ __forceinline__ size_t aoff(const Unit& u, const Gemm& g) const { const int i = u.pm >> 6; const int ac = acol0 + i * (acol1 - acol0) + (i >> 1) * (acol2 - 2 * acol1 + acol0); return ((size_t)(u.pm & 63) * BM * g.lda + ac) * 2; }
    __device__ __forceinline__ size_t boff(const Unit& u, const Gemm& g) const { return (size_t)u.pn * BM * g.ldb * 2; }
    __device__ __forceinline__ void a_ready(const Unit&) const {}
    __device__ __forceinline__ void done(const Unit&) const {}
};

__device__ __forceinline__ unsigned cvt_pk_bf16(float lo, float hi) { unsigned r; asm volatile("v_cvt_pk_bf16_f32 %0, %1, %2" : "=v"(r) : "v"(lo), "v"(hi)); return r; }
__device__ __forceinline__ float sx(float v, int mask, int lane) { return __builtin_bit_cast(float, __builtin_amdgcn_ds_bpermute((lane ^ mask) << 2, __builtin_bit_cast(int, v))); }
__device__ __forceinline__ float bflo(unsigned w) { return __builtin_bit_cast(float, w << 16); }
__device__ __forceinline__ float bfhi(unsigned w) { return __builtin_bit_cast(float, w & 0xffff0000u); }
__device__ __forceinline__ float fsigmoid(float x) { return __builtin_amdgcn_rcpf(1.0f + __builtin_amdgcn_exp2f(-1.4426950408889634f * x)); }

struct RowSS { unsigned raw[8]; };
struct NoState {};
__device__ __forceinline__ void load_rowss(RowSS& st, const unsigned* SS, const Unit& u, int wr) {
    int ln; asm volatile("v_mbcnt_lo_u32_b32 %0, -1, 0\n\tv_mbcnt_hi_u32_b32 %0, -1, %0" : "=&v"(ln)); const int row0 = u.pm * BM + wr * 64 + (ln & 15);
#pragma unroll
    for (int ai = 0; ai < 2; ++ai)
#pragma unroll
        for (int m = 0; m < 4; ++m) st.raw[ai * 4 + m] = __hip_atomic_load(SS + row0 + ai * HALF + m * 16, __ATOMIC_RELAXED, __HIP_MEMORY_SCOPE_AGENT);
}
__device__ __forceinline__ float rs_of(unsigned raw) { return 1.0f / sqrtf((float)raw * (1.0f / (4096.0f * 1024.0f)) + 1e-6f); }
template <bool SCALE> struct EpiBf16 {
    static constexpr bool PERM = true, AFTER_DRAIN = false, KEEP = false;
    bf16_t* O; int ldc; const unsigned* SS;
    typedef RowSS State;
    __device__ __forceinline__ void pre(State& st, const Unit& u, int wr) const { if (SCALE) load_rowss(st, SS, u, wr); }
    __device__ __forceinline__ void operator()(const f32x4 (&acc)[2][2][4][2], const Unit& u, int wr, int wc, int fr_, int fq_, const State& st) const {
        int ln; asm volatile("v_mbcnt_lo_u32_b32 %0, -1, 0\n\tv_mbcnt_hi_u32_b32 %0, -1, %0" : "=&v"(ln)); const int fr = ln & 15, fq = ln >> 4;
        const int row0 = u.pm * BM + wr * 64 + fr; const int col0 = u.pn * BM + wc * 32 + 8 * fq;
#pragma unroll
        for (int ai = 0; ai < 2; ++ai)
#pragma unroll
            for (int m = 0; m < 4; ++m) { bf16_t* rowp = O + (size_t)(row0 + ai * HALF + m * 16) * ldc + col0;
                float rs = 1.0f; if (SCALE) rs = rs_of(st.raw[ai * 4 + m]);
#pragma unroll
                for (int bj = 0; bj < 2; ++bj) { const f32x4 v0 = acc[ai][bj][m][0] * rs, v1 = acc[ai][bj][m][1] * rs;
                    u32x4 w; w.x = cvt_pk_bf16(v0[0], v0[1]); w.y = cvt_pk_bf16(v0[2], v0[3]); w.z = cvt_pk_bf16(v1[0], v1[1]); w.w = cvt_pk_bf16(v1[2], v1[3]);
                    *(u32x4*)(rowp + bj * HALF) = w; } }
    }
};
struct EpiSwiGLU {
    static constexpr bool PERM = true, AFTER_DRAIN = false, KEEP = false;
    bf16_t* O; int ldc; const unsigned* SS;
    typedef RowSS State;
    __device__ __forceinline__ void pre(State& st, const Unit& u, int wr) const { load_rowss(st, SS, u, wr); }
    __device__ __forceinline__ void operator()(const f32x4 (&acc)[2][2][4][2], const Unit& u, int wr, int wc, int fr_, int fq_, const State& st) const {
        int ln; asm volatile("v_mbcnt_lo_u32_b32 %0, -1, 0\n\tv_mbcnt_hi_u32_b32 %0, -1, %0" : "=&v"(ln)); const int fr = ln & 15, fq = ln >> 4;
        const int row0 = u.pm * BM + wr * 64 + fr; const int col0 = u.pn * HALF + wc * 32 + 8 * fq;
#pragma unroll
        for (int ai = 0; ai < 2; ++ai)
#pragma unroll
            for (int m = 0; m < 4; ++m) { bf16_t* rowp = O + (size_t)(row0 + ai * HALF + m * 16) * ldc + col0;
                const float rs = rs_of(st.raw[ai * 4 + m]);
                float h[8];
#pragma unroll
                for (int n = 0; n < 2; ++n)
#pragma unroll
                    for (int j = 0; j < 4; ++j) { const float gt = acc[ai][0][m][n][j] * rs, up = acc[ai][1][m][n][j] * rs; h[4 * n + j] = gt * fsigmoid(gt) * up; }
                u32x4 w; w.x = cvt_pk_bf16(h[0], h[1]); w.y = cvt_pk_bf16(h[2], h[3]); w.z = cvt_pk_bf16(h[4], h[5]); w.w = cvt_pk_bf16(h[6], h[7]);
                *(u32x4*)rowp = w; }
    }
};
struct EpiResid {
    static constexpr bool PERM = false, AFTER_DRAIN = false, KEEP = false;
    const float* base; float* out; int ldc; float alpha; bf16_t* XB; unsigned* SS;
    typedef NoState State;
    __device__ __forceinline__ void pre(State&, const Unit&, int) const {}
    __device__ __forceinline__ void operator()(const f32x4 (&acc)[2][2][4][2], const Unit& u, int wr, int wc, int fr_, int fq_, const State&) const {
        int ln; asm volatile("v_mbcnt_lo_u32_b32 %0, -1, 0\n\tv_mbcnt_hi_u32_b32 %0, -1, %0" : "=&v"(ln)); const int fr = ln & 15, fq = ln >> 4;
        const int row0 = u.pm * BM + wr * 64 + fr, col0 = u.pn * BM + wc * 32 + 4 * fq;
        float al = alpha; asm volatile("" : "+v"(al));
        bf16_t* xb = XB; unsigned* ssp = SS; asm volatile("" : "+s"(xb), "+s"(ssp));
#pragma unroll
        for (int ai = 0; ai < 2; ++ai)
#pragma unroll
            for (int m = 0; m < 4; ++m) { const size_t off = (size_t)(row0 + ai * HALF + m * 16) * ldc + col0; float ss = 0.f;
#pragma unroll
                for (int bj = 0; bj < 2; ++bj)
#pragma unroll
                    for (int n = 0; n < 2; ++n) { const f32x4 b = *(const f32x4*)(base + off + bj * HALF + n * 16); const f32x4 v = b + acc[ai][bj][m][n] * al;
                        *(f32x4*)(out + off + bj * HALF + n * 16) = v; ss += (v[0] * v[0] + v[1] * v[1]) + (v[2] * v[2] + v[3] * v[3]);
                        u32x2 w; w.x = cvt_pk_bf16(v[0], v[1]); w.y = cvt_pk_bf16(v[2], v[3]); *(u32x2*)(xb + off + bj * HALF + n * 16) = w; }
                { const int ln = fq * 16 + fr; ss += sx(ss, 16, ln); ss += sx(ss, 32, ln); }
                if (fq == 0) (void)__hip_atomic_fetch_add(ssp + row0 + ai * HALF + m * 16, (unsigned)(ss * 4096.0f + 0.5f), __ATOMIC_RELAXED, __HIP_MEMORY_SCOPE_AGENT); }
    }
};
struct EpiMerge {
    static constexpr bool PERM = false, AFTER_DRAIN = false, KEEP = true;
    const bf16_t* Z; int ldz, gcol; bf16_t* MIXB;
    typedef NoState State;
    __device__ __forceinline__ void pre(State&, const Unit&, int) const {}
    __device__ __forceinline__ bool zero_after(const Unit& u) const { return (u.pm >> 6) == 2; }
    __device__ __forceinline__ void operator()(f32x4 (&acc)[2][2][4][2], const Unit& u, int wr, int wc, int fr_, int fq_, const State&) const {
        int ln; asm volatile("v_mbcnt_lo_u32_b32 %0, -1, 0\n\tv_mbcnt_hi_u32_b32 %0, -1, %0" : "=&v"(ln)); const int fr = ln & 15, fq = ln >> 4;
        const int i = u.pm >> 6, pm = u.pm & 63, pn = u.pn & 3;
        const int row0 = pm * BM + wr * 64 + fr, col0 = pn * BM + wc * 32 + 4 * fq;
#pragma unroll
        for (int ai = 0; ai < 2; ++ai)
#pragma unroll
            for (int m = 0; m < 4; ++m) { const int row = row0 + ai * HALF + m * 16;
#pragma unroll
                for (int bj = 0; bj < 2; ++bj)
#pragma unroll
                    for (int n = 0; n < 2; ++n) { const int col = col0 + bj * HALF + n * 16;
                        const bf16_t* gp = Z + (size_t)row * ldz + gcol + i * 1024 + col;
                        const u32x2 ga = *(const u32x2*)gp;
                        f32x4 ea; ea[0] = __builtin_amdgcn_exp2f(-1.4426950408889634f * bflo(ga.x)); ea[1] = __builtin_amdgcn_exp2f(-1.4426950408889634f * bfhi(ga.x));
                        ea[2] = __builtin_amdgcn_exp2f(-1.4426950408889634f * bflo(ga.y)); ea[3] = __builtin_amdgcn_exp2f(-1.4426950408889634f * bfhi(ga.y));
                        f32x4 v = acc[ai][bj][m][n];
                        if (i < 2) { const u32x2 gb = *(const u32x2*)(gp + 1024);
                            f32x4 eb; eb[0] = __builtin_amdgcn_exp2f(-1.4426950408889634f * bflo(gb.x)); eb[1] = __builtin_amdgcn_exp2f(-1.4426950408889634f * bfhi(gb.x));
                            eb[2] = __builtin_amdgcn_exp2f(-1.4426950408889634f * bflo(gb.y)); eb[3] = __builtin_amdgcn_exp2f(-1.4426950408889634f * bfhi(gb.y));
#pragma unroll
                            for (int j = 0; j < 4; ++j) v[j] *= (1.0f + eb[j]) * __builtin_amdgcn_rcpf(1.0f + ea[j]);
                            acc[ai][bj][m][n] = v;
                        } else {
#pragma unroll
                            for (int j = 0; j < 4; ++j) v[j] *= __builtin_amdgcn_rcpf(1.0f + ea[j]);
                            u32x2 w; w.x = cvt_pk_bf16(v[0], v[1]); w.y = cvt_pk_bf16(v[2], v[3]); *(u32x2*)(MIXB + (size_t)row * 1024 + col) = w; } } }
    }
};

template <class Epi, class Sched, bool ALIGN_EPI = false, bool SP2 = false>
__device__ __forceinline__ void gemm_phase(PG8_LAS unsigned char* lds, const Gemm g, const Sched& S, const Epi& E, const int wv) {
    int tid_o; asm volatile("v_mbcnt_lo_u32_b32 %0, -1, 0\n\tv_mbcnt_hi_u32_b32 %0, -1, %0\n\tv_lshl_or_b32 %0, %1, 6, %0" : "=&v"(tid_o) : "s"(wv)); const int tid = tid_o, wid = __builtin_amdgcn_readfirstlane(tid >> 6), lane = tid & 63, wr = wid >> 2, wc = wid & 3, fr = lane & 15, fq = lane >> 4;
    const int K = g.K, nt = K / BK;
    unsigned voffA[2], voffB[2];
#pragma unroll
    for (int i = 0; i < 2; ++i) { int R, C; stage_rc(tid * 16 + i * 8192, R, C); const int Rb = Epi::PERM ? ((R & ~31) + perm32(R & 31)) : R;
        voffA[i] = (unsigned)(R * g.lda + C) * 2u; voffB[i] = (unsigned)(Rb * g.ldb + C) * 2u; }
    const size_t kstep = (size_t)(BK * 2);
    const size_t hstepA = (size_t)HALF * g.lda * 2, hstepB = (size_t)HALF * g.ldb * 2;
    const unsigned ldsw = (unsigned)wid * 1024u;
    const int aoff = lds_byte(wr * 64 + fr, fq * 8), boff = lds_byte(wc * 32 + fr, fq * 8);
#define PG8_SA(b, h) (((b) * 2 + (h)) * HTB)
#define PG8_SB(b, h) ((4 + (b) * 2 + (h)) * HTB)
#define PG8_STAGE(bufoff, gbase, voff) do { _Pragma("unroll") for (int _i = 0; _i < 2; ++_i) \
        __builtin_amdgcn_global_load_lds((const unsigned*)((const char*)(gbase) + (voff)[_i]), (PG8_LAS unsigned*)(lds + (bufoff) + ldsw + _i * 8192), 16, 0, 0); } while (0)
#define PG8_LDA(dst, b, h) do { _Pragma("unroll") for (int m = 0; m < 4; ++m) _Pragma("unroll") for (int k = 0; k < 2; ++k) dst[m][k] = *(const PG8_LAS bf16x8*)(lds + PG8_SA(b, h) + aoff + m * 2048 + k * 1024); } while (0)
#define PG8_LDB(dst, b, h) do { _Pragma("unroll") for (int n = 0; n < 2; ++n) _Pragma("unroll") for (int k = 0; k < 2; ++k) dst[n][k] = *(const PG8_LAS bf16x8*)(lds + PG8_SB(b, h) + boff + n * 2048 + k * 1024); } while (0)
#define PG8_MMA(ai, bj, At, Bt) do { __builtin_amdgcn_s_setprio(1); _Pragma("unroll") for (int m = 0; m < 4; ++m) _Pragma("unroll") for (int n = 0; n < 2; ++n) _Pragma("unroll") for (int k = 0; k < 2; ++k) \
        acc[ai][bj][m][n] = __builtin_amdgcn_mfma_f32_16x16x32_bf16(Bt[n][k], At[m][k], acc[ai][bj][m][n], 0, 0, 0); __builtin_amdgcn_s_setprio(0); } while (0)
#define PG8_WAIT_V(n) asm volatile("s_waitcnt vmcnt(" #n ")" ::: "memory")
#define PG8_WAIT_L(n) asm volatile("s_waitcnt lgkmcnt(" #n ")" ::: "memory")
#define PG8_BAR __builtin_amdgcn_s_barrier()
#define PG8_SCHED __builtin_amdgcn_sched_barrier(0)
    Unit cur, nxt; int ui = 0;
    if (!S.next(0, cur)) return;
    f32x4 acc[2][2][4][2];
#pragma unroll
    for (int a = 0; a < 2; ++a)
#pragma unroll
        for (int b = 0; b < 2; ++b)
#pragma unroll
            for (int m = 0; m < 4; ++m)
#pragma unroll
                for (int n = 0; n < 2; ++n) acc[a][b][m][n] = (f32x4){0.f, 0.f, 0.f, 0.f};
    bf16x8 At[4][2], B0[2][2], B1[2][2];
    const char* cA = (const char*)g.A + S.aoff(cur, g); const char* cB = (const char*)g.Bt + S.boff(cur, g);
    S.a_ready(cur);
    typename Epi::State est; E.pre(est, cur, wr);
    if constexpr (SP2) {
        PG8_STAGE(PG8_SB(0, 0), cB, voffB); PG8_STAGE(PG8_SB(0, 1), cB + hstepB, voffB); PG8_STAGE(PG8_SA(0, 0), cA, voffA); PG8_STAGE(PG8_SA(0, 1), cA + hstepA, voffA);
        if (wr == 1) PG8_BAR;
        PG8_WAIT_V(2); PG8_BAR;
        PG8_STAGE(PG8_SB(1, 0), cB + kstep, voffB); PG8_STAGE(PG8_SA(1, 0), cA + kstep, voffA); PG8_STAGE(PG8_SB(1, 1), cB + hstepB + kstep, voffB);
        PG8_WAIT_V(6); PG8_BAR;
    } else {
        PG8_STAGE(PG8_SB(0, 0), cB, voffB); PG8_STAGE(PG8_SA(0, 0), cA, voffA); PG8_STAGE(PG8_SB(0, 1), cB + hstepB, voffB); PG8_STAGE(PG8_SA(0, 1), cA + hstepA, voffA);
        if (wr == 1) PG8_BAR;
        PG8_WAIT_V(4); PG8_BAR;
        PG8_STAGE(PG8_SB(1, 0), cB + kstep, voffB); PG8_STAGE(PG8_SA(1, 0), cA + kstep, voffA); PG8_STAGE(PG8_SB(1, 1), cB + hstepB + kstep, voffB);
        PG8_WAIT_V(6); PG8_BAR;
    }
    for (;;) {
        const bool has_next = S.next(ui + 1, nxt);
        const char* nA = has_next ? (const char*)g.A + S.aoff(nxt, g) : cA; const char* nB = has_next ? (const char*)g.Bt + S.boff(nxt, g) : cB;
        for (int t = 0; t < nt; t += 2) {
            const bool last = (t == nt - 2);
            const char* a1 = cA + (size_t)(t + 1) * kstep;
            const char* a2 = last ? nA : cA + (size_t)(t + 2) * kstep; const char* b2 = last ? nB : cB + (size_t)(t + 2) * kstep;
            const char* a3 = a2 + kstep; const char* b3 = b2 + kstep;
            if (last && has_next) S.a_ready(nxt);
            if constexpr (SP2) {
            PG8_LDB(B0, 0, 0); PG8_LDB(B1, 0, 1); PG8_SCHED; PG8_LDA(At, 0, 0); PG8_STAGE(PG8_SA(1, 1), a1 + hstepA, voffA);
            PG8_WAIT_V(8); PG8_WAIT_L(0); PG8_BAR; PG8_MMA(0, 0, At, B0); PG8_MMA(0, 1, At, B1); PG8_BAR; PG8_SCHED;
            PG8_LDA(At, 0, 1); PG8_STAGE(PG8_SB(0, 0), b2, voffB); PG8_STAGE(PG8_SB(0, 1), b2 + hstepB, voffB); PG8_STAGE(PG8_SA(0, 0), a2, voffA);
            PG8_WAIT_V(8); PG8_WAIT_L(0); PG8_BAR; PG8_MMA(1, 0, At, B0); PG8_MMA(1, 1, At, B1); PG8_BAR; PG8_SCHED;
            PG8_LDB(B0, 1, 0); PG8_LDB(B1, 1, 1); PG8_SCHED; PG8_LDA(At, 1, 0); PG8_STAGE(PG8_SA(0, 1), a2 + hstepA, voffA);
            PG8_WAIT_V(8); PG8_WAIT_L(0); PG8_BAR; PG8_MMA(0, 0, At, B0); PG8_MMA(0, 1, At, B1); PG8_BAR; PG8_SCHED;
            PG8_LDA(At, 1, 1); PG8_STAGE(PG8_SB(1, 0), b3, voffB); PG8_STAGE(PG8_SB(1, 1), b3 + hstepB, voffB); PG8_STAGE(PG8_SA(1, 0), a3, voffA);
            PG8_WAIT_V(8); PG8_WAIT_L(0); PG8_BAR; PG8_MMA(1, 0, At, B0); PG8_MMA(1, 1, At, B1); PG8_BAR; PG8_SCHED;
            } else {
            PG8_LDB(B0, 0, 0); PG8_SCHED; PG8_LDA(At, 0, 0); PG8_STAGE(PG8_SA(1, 1), a1 + hstepA, voffA);
            PG8_WAIT_L(8); PG8_BAR; PG8_WAIT_L(0); PG8_MMA(0, 0, At, B0); PG8_BAR; PG8_SCHED;
            PG8_LDB(B1, 0, 1); PG8_STAGE(PG8_SB(0, 0), b2, voffB);
            PG8_BAR; PG8_WAIT_L(0); PG8_MMA(0, 1, At, B1); PG8_BAR;
            PG8_LDA(At, 0, 1); PG8_STAGE(PG8_SA(0, 0), a2, voffA);
            PG8_BAR; PG8_WAIT_L(0); PG8_MMA(1, 0, At, B0); PG8_BAR; PG8_SCHED;
            PG8_STAGE(PG8_SB(0, 1), b2 + hstepB, voffB);
            PG8_WAIT_V(6); PG8_BAR; PG8_MMA(1, 1, At, B1); PG8_BAR;
            PG8_LDB(B0, 1, 0); PG8_SCHED; PG8_LDA(At, 1, 0); PG8_STAGE(PG8_SA(0, 1), a2 + hstepA, voffA);
            PG8_WAIT_L(8); PG8_BAR; PG8_WAIT_L(0); PG8_MMA(0, 0, At, B0); PG8_BAR; PG8_SCHED;
            PG8_LDB(B1, 1, 1); PG8_STAGE(PG8_SB(1, 0), b3, voffB);
            PG8_BAR; PG8_WAIT_L(0); PG8_MMA(0, 1, At, B1); PG8_BAR;
            PG8_LDA(At, 1, 1); PG8_STAGE(PG8_SA(1, 0), a3, voffA);
            PG8_BAR; PG8_WAIT_L(0); PG8_MMA(1, 0, At, B0); PG8_BAR; PG8_SCHED;
            PG8_STAGE(PG8_SB(1, 1), b3 + hstepB, voffB);
            PG8_WAIT_V(6); PG8_BAR; PG8_MMA(1, 1, At, B1); PG8_BAR;
            }
        }
        if constexpr (ALIGN_EPI) { if (wr == 0) PG8_BAR; }
        if constexpr (!Epi::AFTER_DRAIN) { E(acc, cur, wr, wc, fr, fq, est); S.done(cur); }
        if (!has_next) break;
        bool zacc = true; if constexpr (Epi::KEEP) zacc = E.zero_after(cur);
        if (zacc)
#pragma unroll
        for (int a = 0; a < 2; ++a)
#pragma unroll
            for (int b = 0; b < 2; ++b)
#pragma unroll
                for (int m = 0; m < 4; ++m)
#pragma unroll
                    for (int n = 0; n < 2; ++n) acc[a][b][m][n] = (f32x4){0.f, 0.f, 0.f, 0.f};
        cur = nxt; cA = nA; cB = nB; ++ui; E.pre(est, cur, wr);
        if constexpr (ALIGN_EPI) { if (wr == 1) PG8_BAR; }
    }
    PG8_WAIT_V(0);
    if constexpr (!ALIGN_EPI) { if (wr == 0) PG8_BAR; }
    PG8_BAR;
    if constexpr (Epi::AFTER_DRAIN) { E.fused(acc, cur, wr, wc, fr, fq, lds, wid, lane); S.done(cur); }
#undef PG8_SA
#undef PG8_SB
#undef PG8_STAGE
#undef PG8_LDA
#undef PG8_LDB
#undef PG8_MMA
#undef PG8_WAIT_V
#undef PG8_WAIT_L
#undef PG8_BAR
#undef PG8_SCHED
}
}

#define LAS __attribute__((address_space(3)))
typedef unsigned short bf16;
typedef unsigned v4u __attribute__((ext_vector_type(4)));
typedef unsigned v2u __attribute__((ext_vector_type(2)));
typedef float f32x4 __attribute__((ext_vector_type(4)));
typedef float f32x16 __attribute__((ext_vector_type(16)));
typedef short bf16x8 __attribute__((ext_vector_type(8)));
typedef short s16x4 __attribute__((ext_vector_type(4)));
typedef short v4i16_t __attribute__((ext_vector_type(4)));

constexpr int NWAVES = 8, NTHR = 512;
constexpr int M = 16384, DM = 1024, FF = 2816, DIN = 6752, ZP = 6912, SEQ = 4096, DEPTH = 4;
constexpr float EPS = 1e-6f, LOG2E = 1.4426950408889634f;
constexpr int ZQ_NA = 0, ZK_NA = 512, ZV_NA = 1024, ZGQ = 1536, ZGK = 1792, ZGV = 2048, ZGR = 2560, ZGFL = 3072, ZGBL = 3088, ZCQ = 3104, ZCKV = 3360, ZKR = 3616, ZGATE = 3680;
constexpr size_t MiB = 1u << 20;
constexpr size_t WS_WT = 1 * MiB, WS_XN = 57 * MiB, WS_Z = 89 * MiB, WS_QR = 305 * MiB, WS_KVR = 329 * MiB, WS_KF = 361 * MiB, WS_U = 385 * MiB, WS_DD = 449 * MiB, WS_PS = 450 * MiB, WS_END = 453 * MiB;
constexpr size_t WT_13A = 0, WT_2A = 11534336, WT_IN = 17301504, WT_UQ = 31457280, WT_UKV = 31850496, WT_BR = 32374784, WT_OUT = 35520512, WT_13B = 37617664, WT_2B = 49152000;
constexpr int LDS_BYTES = 135168;

struct Args { const float* in[29]; float* out; unsigned char* ws; };
__device__ __forceinline__ const float* kin(int i) { typedef const __attribute__((address_space(4))) unsigned long long* kp_t; kp_t kp = (kp_t)__builtin_amdgcn_kernarg_segment_ptr(); const unsigned long long v = *(volatile kp_t)(kp + i); return (const float*)(const __attribute__((address_space(1))) float*)v; }

#define LDS_WAIT() asm volatile("s_waitcnt lgkmcnt(0)" ::: "memory")
__device__ __forceinline__ unsigned pk2(float lo, float hi) { return pg8::cvt_pk_bf16(lo, hi); }
__device__ __forceinline__ float bf2f(bf16 h) { return __builtin_bit_cast(float, (unsigned)h << 16); }
__device__ __forceinline__ bf16 f2bf(float f) { return (bf16)(pk2(f, 0.f) & 0xffffu); }
__device__ __forceinline__ float wave_sum(float v, int lane) {
#pragma unroll
    for (int o = 1; o < 64; o <<= 1) v += pg8::sx(v, o, lane);
    return v;
}
__device__ __forceinline__ int opaque_tid_w(int wv) { int t; asm volatile("v_mbcnt_lo_u32_b32 %0, -1, 0\n\tv_mbcnt_hi_u32_b32 %0, -1, %0\n\tv_lshl_or_b32 %0, %1, 6, %0" : "=&v"(t) : "s"(wv)); return t; }
__device__ __forceinline__ int opaque_s(int v) { asm volatile("" : "+s"(v)); return v; }
__device__ __forceinline__ int crow(int r, int hi) { return (r & 3) + 8 * (r >> 2) + 4 * hi; }
__device__ __forceinline__ s16x4 vtr(const LAS char* p) { return __builtin_bit_cast(s16x4, __builtin_amdgcn_ds_read_tr16_b64_v4i16((LAS v4i16_t*)p)); }
__device__ __forceinline__ bf16x8 tr_frag(const LAS char* p0, const LAS char* p1) { const s16x4 a = vtr(p0), b = vtr(p1); return (bf16x8){a[0], a[1], a[2], a[3], b[0], b[1], b[2], b[3]}; }
__device__ __forceinline__ bf16x8 pack8(float a0, float a1, float a2, float a3, float a4, float a5, float a6, float a7) {
    v4u w; w.x = pk2(a0, a1); w.y = pk2(a2, a3); w.z = pk2(a4, a5); w.w = pk2(a6, a7); return __builtin_bit_cast(bf16x8, w);
}
#define MFMA32(a, b, c) __builtin_amdgcn_mfma_f32_32x32x16_bf16((a), (b), (c), 0, 0, 0)
#define MFMA16(a, b, c) __builtin_amdgcn_mfma_f32_16x16x32_bf16((a), (b), (c), 0, 0, 0)

#define XB_TMO      128
#define XB_XCNT(j)  (256  + 64 * (j))
#define XB_XSUB(j)  (1280 + 64 * (j))
#define XB_XGEN(j)  (2304 + 64 * (j))
#define XB_TOP      3328
#define XB_TOPGEN   3392
#define XCD_BAR_WORDS 3456
#define XB_SPIN_CAP (1u << 18)

__device__ __forceinline__ unsigned xb_ld(unsigned* p)              { return __hip_atomic_load(p, __ATOMIC_RELAXED, __HIP_MEMORY_SCOPE_AGENT); }
__device__ __forceinline__ unsigned xb_add(unsigned* p, unsigned v) { return __hip_atomic_fetch_add(p, v, __ATOMIC_RELAXED, __HIP_MEMORY_SCOPE_AGENT); }
__device__ __forceinline__ unsigned xb_xcc_id() { return (unsigned)__builtin_amdgcn_s_getreg((3 << 11) | 20) & 0xFu; }
#define XB_SPIN(cond, bar) do { unsigned _sp = 0; while (cond) { __builtin_amdgcn_s_sleep(1); \
    if ((++_sp & 255u) == 0u) { if (xb_ld(&(bar)[XB_TMO])) break; if (_sp > XB_SPIN_CAP) { atomicAdd(&(bar)[XB_TMO], 1u); break; } } } } while (0)

struct XcdBarrier {
    unsigned* bar; unsigned x;
    volatile LAS unsigned* st;
};

__device__ __forceinline__ XcdBarrier xcd_barrier_post(unsigned* bar, volatile LAS unsigned* st) {
    XcdBarrier b; b.bar = bar; b.x = xb_xcc_id(); b.st = st;
    if (threadIdx.x == 0) (void)xb_add(&bar[XB_XCNT(b.x)], 1u);
    return b;
}
__device__ __forceinline__ void xcd_barrier_complete(unsigned* bar, unsigned x, unsigned& nloc, unsigned& nx) {
    const unsigned G = gridDim.x * gridDim.y * gridDim.z;
    unsigned sum, cnt, mine, sp = 0u;
    for (;;) {
        sum = 0u; cnt = 0u; mine = 0u;
#pragma unroll
        for (unsigned j = 0; j < 16; ++j) { const unsigned c = xb_ld(&bar[XB_XCNT(j)]); sum += c; cnt += (c > 0u) ? 1u : 0u; mine = (j == x) ? c : mine; }
        if (sum == G) break;
        __builtin_amdgcn_s_sleep(1);
        if ((++sp & 255u) == 0u) { if (xb_ld(&bar[XB_TMO])) break; if (sp > XB_SPIN_CAP) { atomicAdd(&bar[XB_TMO], 1u); break; } }
    }
    nloc = mine > 0u ? mine : 1u; nx = cnt > 0u ? cnt : 1u;
}

__device__ __forceinline__ void xcd_barrier(const XcdBarrier& b, const bool leader) {
    asm volatile("s_waitcnt vmcnt(0)" ::: "memory");
    __syncthreads();
    if (leader) {
        unsigned* bar = b.bar;
        __builtin_amdgcn_s_waitcnt(0);
        unsigned nloc = b.st[0], nx = b.st[1];
        if (nloc == 0u) { xcd_barrier_complete(bar, b.x, nloc, nx); b.st[0] = nloc; b.st[1] = nx; }
        const unsigned old = xb_add(&bar[XB_XSUB(b.x)], 1u);
        const unsigned gen = old / nloc;
        if (old + 1u == (gen + 1u) * nloc) {
            __builtin_amdgcn_fence(__ATOMIC_RELEASE, "agent");
            asm volatile("s_waitcnt vmcnt(0)" ::: "memory");
            const unsigned og = xb_add(&bar[XB_TOP], 1u);
            const unsigned tg = og / nx;
            if (og + 1u == (tg + 1u) * nx) xb_add(&bar[XB_TOPGEN], 1u);
            else XB_SPIN(xb_ld(&bar[XB_TOPGEN]) == tg, bar);
            __builtin_amdgcn_fence(__ATOMIC_ACQUIRE, "agent");
            xb_add(&bar[XB_XGEN(b.x)], 1u);
            asm volatile("s_waitcnt vmcnt(0)" ::: "memory");
        } else {
            XB_SPIN(xb_ld(&bar[XB_XGEN(b.x)]) == gen, bar);
            __builtin_amdgcn_fence(__ATOMIC_ACQUIRE, "agent");
            asm volatile("s_waitcnt vmcnt(0)" ::: "memory");
        }
    }
    __syncthreads();
}

__device__ __forceinline__ void tr_item(const float* __restrict__ W, int K, int N, bf16* WT, int k0, int n0, int drow0, LAS float* scr, int lane, const float* g) {
    f32x4 wv4[8];
#pragma unroll
    for (int i = 0; i < 8; ++i) wv4[i] = __builtin_nontemporal_load((const f32x4*)(W + (size_t)(k0 + (lane >> 3) + 8 * i) * N + n0 + 4 * (lane & 7)));
#pragma unroll
    for (int i = 0; i < 8; ++i) { LAS float* d = scr + ((lane >> 3) + 8 * i) * 33 + 4 * (lane & 7); d[0] = wv4[i].x; d[1] = wv4[i].y; d[2] = wv4[i].z; d[3] = wv4[i].w; }
    LDS_WAIT();
    const int c = lane & 7;
    f32x4 ga = {1.f, 1.f, 1.f, 1.f}, gb = ga;
    if (g) { ga = *(const f32x4*)(g + k0 + 8 * c); gb = *(const f32x4*)(g + k0 + 8 * c + 4); }
#pragma unroll
    for (int j = 0; j < 4; ++j) { const int n = (lane >> 3) + 8 * j; const LAS float* s = scr + (8 * c) * 33 + n;
        v4u o; o.x = pk2(s[0 * 33] * ga[0], s[1 * 33] * ga[1]); o.y = pk2(s[2 * 33] * ga[2], s[3 * 33] * ga[3]); o.z = pk2(s[4 * 33] * gb[0], s[5 * 33] * gb[1]); o.w = pk2(s[6 * 33] * gb[2], s[7 * 33] * gb[3]);
        *(v4u*)(WT + (size_t)(drow0 + n) * K + k0 + 8 * c) = o; }
    LDS_WAIT();
}
struct MatDesc { const float* W; bf16* WT; const float* g; int K, N, mode, roff; };
__device__ __forceinline__ MatDesc mat_desc(int idx, int l, const Args& a, unsigned char* wt) {
    MatDesc d; d.mode = 0; d.roff = 0; d.g = nullptr;
    switch (idx) {
    case 0:  d.W = kin(2) + (size_t)l * DM * FF;  d.WT = (bf16*)(wt + WT_13A); d.K = DM; d.N = FF; d.mode = 1; d.roff = 0; d.g = kin(1) + l * DM; break;
    case 1:  d.W = kin(3) + (size_t)l * DM * FF;  d.WT = (bf16*)(wt + WT_13A); d.K = DM; d.N = FF; d.mode = 1; d.roff = 1; d.g = kin(1) + l * DM; break;
    case 2:  d.W = kin(4) + (size_t)l * FF * DM;  d.WT = (bf16*)(wt + WT_2A);  d.K = FF; d.N = DM; break;
    case 3:  d.W = kin(6) + (size_t)l * DM * DIN; d.WT = (bf16*)(wt + WT_IN);  d.K = DM; d.N = DIN; d.g = kin(5) + l * DM; break;
    case 4:  d.W = kin(17) + (size_t)l * 256 * 768;  d.WT = (bf16*)(wt + WT_UQ);  d.K = 256; d.N = 768; break;
    case 5:  d.W = kin(18) + (size_t)l * 256 * 1024; d.WT = (bf16*)(wt + WT_UKV); d.K = 256; d.N = 1024; break;
    case 6:  d.W = kin(21) + (size_t)l * 512 * 1024; d.WT = (bf16*)(wt + WT_BR);  d.K = 512; d.N = 1024; d.roff = 0; break;
    case 7:  d.W = kin(22) + (size_t)l * 512 * 1024; d.WT = (bf16*)(wt + WT_BR);  d.K = 512; d.N = 1024; d.roff = 1024; break;
    case 8:  d.W = kin(23) + (size_t)l * 512 * 1024; d.WT = (bf16*)(wt + WT_BR);  d.K = 512; d.N = 1024; d.roff = 2048; break;
    case 9:  d.W = kin(24) + (size_t)l * DM * DM;  d.WT = (bf16*)(wt + WT_OUT); d.K = DM; d.N = DM; break;
    case 10: d.W = kin(26) + (size_t)l * DM * FF;  d.WT = (bf16*)(wt + WT_13B); d.K = DM; d.N = FF; d.mode = 1; d.roff = 0; d.g = kin(25) + l * DM; break;
    case 11: d.W = kin(27) + (size_t)l * DM * FF;  d.WT = (bf16*)(wt + WT_13B); d.K = DM; d.N = FF; d.mode = 1; d.roff = 1; d.g = kin(25) + l * DM; break;
    default: d.W = kin(28) + (size_t)l * FF * DM;  d.WT = (bf16*)(wt + WT_2B);  d.K = FF; d.N = DM; break;
    }
    return d;
}
__device__ __forceinline__ void convert_set(const Args& a, int l, LAS unsigned char* lds, const int wv, const unsigned mask, const int pw, const int np, const bool do_pad) {
    const int tid = opaque_tid_w(wv), lane = tid & 63, wave = __builtin_amdgcn_readfirstlane(tid >> 6), gtid = blockIdx.x * NTHR + tid, gthreads = gridDim.x * NTHR;
    unsigned char* wt = ((unsigned char*)kin(30)) + WS_WT;
    LAS float* scr = (LAS float*)(lds + wave * 8704);
    int it = pw;
    for (int mi = 0; mi < 13; ++mi) {
        if (!((mask >> mi) & 1u)) continue;
        const MatDesc d = mat_desc(mi, l, a, wt);
        const int nblk = d.N / 32, cnt = (d.K / 64) * nblk;
        for (; it < cnt; it += np) {
            const int kb = it / nblk, nb = it - kb * nblk, n0 = 32 * nb;
            const int drow0 = d.mode ? (256 * (n0 >> 7) + 128 * d.roff + (n0 & 127)) : (d.roff + n0);
            tr_item(d.W, d.K, d.N, d.WT, 64 * kb, n0, drow0, scr, lane, d.g);
        }
        it -= cnt;
    }
    if (do_pad) {
        v4u* pad = (v4u*)(wt + WT_IN + (size_t)DIN * DM * 2);
        const int npad = (ZP - DIN) * DM * 2 / 16;
        unsigned zz = 0u; asm volatile("" : "+v"(zz));
        for (int i = gtid; i < npad; i += gthreads) pad[i] = (v4u){zz, zz, zz, zz};
    }
}
__device__ __forceinline__ void convert_tail(const Args& a, int l, LAS unsigned char* lds, const int wv, const unsigned mask, const int nwg) {
    const int G = gridDim.x, bx = opaque_s(blockIdx.x), rem = nwg % G;
    if (rem != 0 && bx < rem) return;
    const int pw = (rem == 0 ? bx : bx - rem) * NWAVES + wv, np = (rem == 0 ? G : G - rem) * NWAVES;
    convert_set(a, l, lds, wv, mask, pw, np, false);
}
__device__ __forceinline__ void xprep_phase(const float* x, bf16* XB, unsigned* SS, const int wv) {
    const int tid = opaque_tid_w(wv), lane = tid & 63, wave = __builtin_amdgcn_readfirstlane(tid >> 6), gw = blockIdx.x * NWAVES + wave, NGW = gridDim.x * NWAVES;
    for (int m = gw; m < M; m += NGW) {
        const f32x4* xr = (const f32x4*)(x + (size_t)m * DM) + lane;
        f32x4 v[4]; float s = 0.f;
#pragma unroll
        for (int j = 0; j < 4; ++j) { v[j] = xr[64 * j]; s += (v[j].x * v[j].x + v[j].y * v[j].y) + (v[j].z * v[j].z + v[j].w * v[j].w); }
        s = wave_sum(s, lane); if (lane == 0) __hip_atomic_store(SS + m, (unsigned)(s * 4096.0f + 0.5f), __ATOMIC_RELAXED, __HIP_MEMORY_SCOPE_AGENT);
        v2u* o = (v2u*)(XB + (size_t)m * DM) + lane;
#pragma unroll
        for (int j = 0; j < 4; ++j) { v2u w; w.x = pk2(v[j].x, v[j].y); w.y = pk2(v[j].z, v[j].w); o[64 * j] = w; }
    }
}
__device__ __forceinline__ void token_prep_phase(const Args& a, int l, bf16* Z, const int wv) {
    const int tid = opaque_tid_w(wv), lane = tid & 63, wave = __builtin_amdgcn_readfirstlane(tid >> 6), gw = blockIdx.x * NWAVES + wave, NGW = gridDim.x * NWAVES;
    const float* gna = (lane < 32 ? kin(7) : kin(8)) + l * 64 + ((16 * lane) & 63);
    const float* gc = (lane < 32 ? kin(15) : kin(16)) + l * 256 + ((8 * lane) & 255);
    float g1[16], g2[8];
#pragma unroll
    for (int j = 0; j < 16; ++j) g1[j] = gna[j] * (lane < 32 ? 0.125f * LOG2E : 1.0f);
#pragma unroll
    for (int j = 0; j < 8; ++j) g2[j] = gc[j];
    for (int m0 = gw; m0 < M; m0 += 4 * NGW) {
        v4u w0[4], w1[4], wc_[4];
#pragma unroll
        for (int t = 0; t < 4; ++t) { const bf16* zr = Z + (size_t)(m0 + t * NGW) * ZP; w0[t] = *(const v4u*)(zr + 16 * lane); w1[t] = *(const v4u*)(zr + 16 * lane + 8); wc_[t] = *(const v4u*)(zr + ZCQ + 8 * lane); }
#pragma unroll
        for (int t = 0; t < 4; ++t) { bf16* zr = Z + (size_t)(m0 + t * NGW) * ZP;
        { float v[16]; const unsigned ww[8] = {w0[t].x, w0[t].y, w0[t].z, w0[t].w, w1[t].x, w1[t].y, w1[t].z, w1[t].w};
          float ss = 0.f;
#pragma unroll
          for (int j = 0; j < 8; ++j) { v[2 * j] = pg8::bflo(ww[j]); v[2 * j + 1] = pg8::bfhi(ww[j]); ss += v[2 * j] * v[2 * j] + v[2 * j + 1] * v[2 * j + 1]; }
          ss += pg8::sx(ss, 1, lane); ss += pg8::sx(ss, 2, lane);
          const float r = 1.0f / sqrtf(ss * (1.0f / 64.0f) + EPS);
          v4u o0, o1;
          o0.x = pk2(v[0] * r * g1[0], v[1] * r * g1[1]); o0.y = pk2(v[2] * r * g1[2], v[3] * r * g1[3]); o0.z = pk2(v[4] * r * g1[4], v[5] * r * g1[5]); o0.w = pk2(v[6] * r * g1[6], v[7] * r * g1[7]);
          o1.x = pk2(v[8] * r * g1[8], v[9] * r * g1[9]); o1.y = pk2(v[10] * r * g1[10], v[11] * r * g1[11]); o1.z = pk2(v[12] * r * g1[12], v[13] * r * g1[13]); o1.w = pk2(v[14] * r * g1[14], v[15] * r * g1[15]);
          *(v4u*)(zr + 16 * lane) = o0; *(v4u*)(zr + 16 * lane + 8) = o1; }
        { float v[8]; const unsigned ww[4] = {wc_[t].x, wc_[t].y, wc_[t].z, wc_[t].w}; float ss = 0.f;
#pragma unroll
          for (int j = 0; j < 4; ++j) { v[2 * j] = pg8::bflo(ww[j]); v[2 * j + 1] = pg8::bfhi(ww[j]); ss += v[2 * j] * v[2 * j] + v[2 * j + 1] * v[2 * j + 1]; }
#pragma unroll
          for (int o = 1; o < 32; o <<= 1) ss += pg8::sx(ss, o, lane);
          const float r = 1.0f / sqrtf(ss * (1.0f / 256.0f) + EPS);
          v4u o; o.x = pk2(v[0] * r * g2[0], v[1] * r * g2[1]); o.y = pk2(v[2] * r * g2[2], v[3] * r * g2[3]); o.z = pk2(v[4] * r * g2[4], v[5] * r * g2[5]); o.w = pk2(v[6] * r * g2[6], v[7] * r * g2[7]);
          *(v4u*)(zr + ZCQ + 8 * lane) = o; } }
    }
}

constexpr int GP = 144;
constexpr int GL_QF = 0, GL_QB = 9216, GL_KF = 18432, GL_KB = 27648, GL_A = 36864  , GL_V = 55296  , GL_G = 73728;
constexpr int GL_BF = GL_G, GL_BB = GL_G + 16640, GL_GLF = GL_G + 33280, GL_GLB = GL_G + 37376, BP = 65;
constexpr int GL_S = GL_G;
constexpr int GL_O = 0;
__device__ __forceinline__ float log_sigmoid(float x) { return fminf(x, 0.f) - 0.6931471805599453f * __builtin_amdgcn_logf(1.0f + __builtin_amdgcn_exp2f(-1.4426950408889634f * fabsf(x))); }

__device__ __forceinline__ void gla_item(const Args& a, int l, int mode, int b, int h, int c, bf16* Z, float* U, const bf16* SP, float* Dd, LAS unsigned char* lds_u, const int wv) {
    LAS char* lds = (LAS char*)lds_u;
    const int tid = opaque_tid_w(wv), lane = tid & 63, wave = __builtin_amdgcn_readfirstlane(tid >> 6), r32 = lane & 31, hi = lane >> 5, i16 = lane & 15, blk = (lane >> 4) & 1;
    const int bh = b * 4 + h; const size_t tok0 = (size_t)b * SEQ + 64 * c;
    LAS float* sBf = (LAS float*)(lds + GL_BF); LAS float* sBb = (LAS float*)(lds + GL_BB); LAS float* sGlf = (LAS float*)(lds + GL_GLF); LAS float* sGlb = (LAS float*)(lds + GL_GLB);
    for (int idx = tid; idx < 2048; idx += NTHR) { const int dx = idx >> 10, t = (idx >> 4) & 63, r = idx & 15;
        const float v = bf2f(Z[(tok0 + t) * ZP + (dx ? ZGBL : ZGFL) + r]); (dx ? sGlb : sGlf)[t * 16 + r] = v; }
#pragma unroll
    for (int i = 0; i < 2; ++i) { const int idx = tid + NTHR * i, t = idx >> 4, ch = idx & 15;
        *(LAS v4u*)(lds + GL_V + t * 288 + ch * 16) = *(const v4u*)(Z + (tok0 + t) * ZP + ZGV + 128 * h + 8 * ch); }
    const int j = tid & 63, tg = tid >> 6;
    float upf[16], upb[16];
    { const float* pf = kin(10) + (size_t)l * 16 * 256 + 64 * h + j; const float* pb = kin(12) + (size_t)l * 16 * 256 + 64 * h + j;
#pragma unroll
      for (int r = 0; r < 16; ++r) { upf[r] = pf[r * 256]; upb[r] = pb[r * 256]; } }
    const float biasf = kin(11)[l * 256 + 64 * h + j], biasb = kin(13)[l * 256 + 64 * h + j];
    bf16 qraw[8], kraw[8];
#pragma unroll
    for (int i = 0; i < 8; ++i) { const int t = tg + 8 * i; qraw[i] = Z[(tok0 + t) * ZP + ZGQ + 64 * h + j]; kraw[i] = Z[(tok0 + t) * ZP + ZGK + 64 * h + j]; }
    __syncthreads();
#pragma unroll
    for (int i = 0; i < 8; ++i) { const int t = tg + 8 * i; float lf = biasf, lb = biasb;
#pragma unroll
        for (int r = 0; r < 16; ++r) { lf += sGlf[t * 16 + r] * upf[r]; lb += sGlb[t * 16 + r] * upb[r]; }
        sBf[t * BP + j] = log_sigmoid(lf) * (1.0f / 16.0f); sBb[t * BP + j] = log_sigmoid(lb) * (1.0f / 16.0f); }
    __syncthreads();
    { LAS float* sB = (wave < 4) ? sBf : sBb; const int jb = (wave & 3) * 16;
      float x[16];
#pragma unroll
      for (int cc = 0; cc < 16; ++cc) x[cc] = sB[lane * BP + jb + cc];
#pragma unroll
      for (int d = 1; d < 64; d <<= 1) {
#pragma unroll
          for (int cc = 0; cc < 16; ++cc) { const float y = __builtin_bit_cast(float, __builtin_amdgcn_ds_bpermute(((wave < 4) ? (lane - d) : (lane + d)) << 2, __builtin_bit_cast(int, x[cc]))); const bool ok = (wave < 4) ? (lane >= d) : (lane + d < 64); x[cc] += ok ? y : 0.f; } }
#pragma unroll
      for (int cc = 0; cc < 16; ++cc) sB[lane * BP + jb + cc] = x[cc]; }
    __syncthreads();
    { const float bl = sBf[63 * BP + j], bs0 = sBb[j];
#pragma unroll
      for (int i = 0; i < 8; ++i) { const int t = tg + 8 * i;
          const float q = bf2f(qraw[i]) * 0.125f, k = bf2f(kraw[i]);
          const float bf = sBf[t * BP + j], bs = sBb[t * BP + j];
          if (mode == 1) {
              *(LAS bf16*)(lds + GL_QF + t * GP + j * 2) = f2bf(q * __expf(bf)); *(LAS bf16*)(lds + GL_KF + t * GP + j * 2) = f2bf(k * __expf(-bf));
              *(LAS bf16*)(lds + GL_QB + t * GP + j * 2) = f2bf(q * __expf(bs)); *(LAS bf16*)(lds + GL_KB + t * GP + j * 2) = f2bf(k * __expf(-bs));
          } else {
              *(LAS bf16*)(lds + GL_A + j * GP + t * 2) = f2bf(k * __expf(bl - bf)); *(LAS bf16*)(lds + GL_A + 9216 + j * GP + t * 2) = f2bf(k * __expf(bs0 - bs));
          } }
      if (mode == 0 && tg == 0) { Dd[((size_t)(0 * 16 + bh) * 64 + c) * 64 + j] = __expf(bl); Dd[((size_t)(1 * 16 + bh) * 64 + c) * 64 + j] = __expf(bs0); } }
    __syncthreads();
    if (mode == 0) {
        const int dir = wave >> 2, dvt = wave & 3;
        float* Ub = U + ((size_t)(dir * 16 + bh) * 64 + c) * 8192;
#pragma unroll
        for (int dkt = 0; dkt < 2; ++dkt) { f32x16 acc = {};
#pragma unroll
            for (int s = 0; s < 4; ++s) {
                const bf16x8 A = *(const LAS bf16x8*)(lds + GL_A + dir * 9216 + (32 * dkt + r32) * GP + (16 * s + 8 * hi) * 2);
                const LAS char* vp = lds + GL_V + (16 * s + 8 * hi + (i16 >> 2)) * 288 + (32 * dvt + 16 * blk + 4 * (i16 & 3)) * 2;
                const bf16x8 B = tr_frag(vp, vp + 4 * 288);
                acc = MFMA32(A, B, acc); }
#pragma unroll
            for (int r = 0; r < 16; ++r) Ub[(32 * dkt + crow(r, hi)) * 128 + 32 * dvt + r32] = acc[r]; }
        __syncthreads();
        return;
    }
    { const int dir = wave >> 2, ti = (wave >> 1) & 1, tj = wave & 1; f32x16 acc = {};
      const int qo = dir ? GL_QB : GL_QF, ko = dir ? GL_KB : GL_KF;
#pragma unroll
      for (int s = 0; s < 4; ++s) {
          const bf16x8 A = *(const LAS bf16x8*)(lds + qo + (32 * ti + r32) * GP + (16 * s + 8 * hi) * 2);
          const bf16x8 B = *(const LAS bf16x8*)(lds + ko + (32 * tj + r32) * GP + (16 * s + 8 * hi) * 2);
          acc = MFMA32(A, B, acc); }
      const int jj = 32 * tj + r32;
#pragma unroll
      for (int r = 0; r < 16; ++r) { const int ii = 32 * ti + crow(r, hi); const bool keep = dir ? (jj > ii) : (jj <= ii);
          *(LAS bf16*)(lds + GL_A + dir * 9216 + ii * GP + jj * 2) = f2bf(keep ? acc[r] : 0.f); } }
#pragma unroll
    for (int i = 0; i < 4; ++i) { const int idx = tid + NTHR * i, dir = idx >> 10, e8 = idx & 1023, dk = e8 >> 4, c8 = e8 & 15;
        *(LAS v4u*)(lds + GL_S + dir * 18432 + dk * 288 + c8 * 16) = *(const v4u*)(SP + ((size_t)(dir * 16 + bh) * 64 + c) * 8192 + dk * 128 + 8 * c8); }
    __syncthreads();
    f32x16 oacc = {};
    const int ti = wave >> 2, dvt = wave & 3;
#pragma unroll
    for (int dir = 0; dir < 2; ++dir) {
        const int qo = dir ? GL_QB : GL_QF;
#pragma unroll
        for (int s = 0; s < 4; ++s) {
            const bf16x8 A1 = *(const LAS bf16x8*)(lds + GL_A + dir * 9216 + (32 * ti + r32) * GP + (16 * s + 8 * hi) * 2);
            const LAS char* vp = lds + GL_V + (16 * s + 8 * hi + (i16 >> 2)) * 288 + (32 * dvt + 16 * blk + 4 * (i16 & 3)) * 2;
            oacc = MFMA32(A1, tr_frag(vp, vp + 4 * 288), oacc);
            const bf16x8 A2 = *(const LAS bf16x8*)(lds + qo + (32 * ti + r32) * GP + (16 * s + 8 * hi) * 2);
            const LAS char* sp = lds + GL_S + dir * 18432 + (16 * s + 8 * hi + (i16 >> 2)) * 288 + (32 * dvt + 16 * blk + 4 * (i16 & 3)) * 2;
            oacc = MFMA32(A2, tr_frag(sp, sp + 4 * 288), oacc); } }
    __syncthreads();
#pragma unroll
    for (int r = 0; r < 16; ++r) *(LAS float*)(lds + GL_O + ((32 * ti + crow(r, hi)) * 132 + 32 * dvt + r32) * 4) = oacc[r];
    __syncthreads();
    { const int row = tid >> 3, seg = tid & 7; float v[16]; float ss = 0.f;
#pragma unroll
      for (int q4 = 0; q4 < 4; ++q4) { const f32x4 t = *(const LAS f32x4*)(lds + GL_O + (row * 132 + 16 * seg + 4 * q4) * 4); v[4 * q4] = t.x; v[4 * q4 + 1] = t.y; v[4 * q4 + 2] = t.z; v[4 * q4 + 3] = t.w; }
#pragma unroll
      for (int q = 0; q < 16; ++q) ss += v[q] * v[q];
      ss += pg8::sx(ss, 1, lane); ss += pg8::sx(ss, 2, lane); ss += pg8::sx(ss, 4, lane);
      const float rr = 1.0f / sqrtf(ss * (1.0f / 128.0f) + EPS);
      bf16* zr = Z + (tok0 + row) * ZP;
      const v4u g0 = *(const v4u*)(zr + ZGR + 128 * h + 16 * seg), g1 = *(const v4u*)(zr + ZGR + 128 * h + 16 * seg + 8);
      const unsigned gw_[8] = {g0.x, g0.y, g0.z, g0.w, g1.x, g1.y, g1.z, g1.w};
      const float* gn = kin(14) + l * 128 + 16 * seg;
      unsigned ow[8];
#pragma unroll
      for (int q = 0; q < 8; ++q) { const float ga = pg8::bflo(gw_[q]), gb = pg8::bfhi(gw_[q]);
          const float ya = (v[2 * q] * rr * gn[2 * q]) * (ga * pg8::fsigmoid(ga)), yb = (v[2 * q + 1] * rr * gn[2 * q + 1]) * (gb * pg8::fsigmoid(gb));
          ow[q] = pk2(ya, yb); }
      *(v4u*)(zr + ZGV + 128 * h + 16 * seg) = (v4u){ow[0], ow[1], ow[2], ow[3]}; *(v4u*)(zr + ZGV + 128 * h + 16 * seg + 8) = (v4u){ow[4], ow[5], ow[6], ow[7]}; }
    __syncthreads();
}
__device__ __forceinline__ void gla_scan_phase(const float* U, bf16* SP, const float* Dd, const int wv) {
    const int gtid = blockIdx.x * NTHR + opaque_tid_w(wv), gthreads = gridDim.x * NTHR;
    for (int ch = gtid; ch < 2 * 16 * 4096; ch += gthreads) {
        const int e = ch & 4095, db = ch >> 12, dir = db >> 4;
        const float* Ub = U + (size_t)db * 64 * 8192 + 2 * e; unsigned* Sb = (unsigned*)SP + (size_t)db * 64 * 4096 + e; const float* Db = Dd + (size_t)db * 64 * 64 + (e >> 6);
        float s0 = 0.f, s1 = 0.f;
        for (int cc = 0; cc < 64; cc += 16) { float u0[16], u1[16], d[16];
#pragma unroll
            for (int k = 0; k < 16; ++k) { const int c = dir ? 63 - (cc + k) : cc + k; const float* p = Ub + (size_t)c * 8192; u0[k] = p[0]; u1[k] = p[1]; d[k] = Db[c * 64]; }
#pragma unroll
            for (int k = 0; k < 16; ++k) { const int c = dir ? 63 - (cc + k) : cc + k; Sb[(size_t)c * 4096] = pk2(s0, s1); s0 = d[k] * s0 + u0[k]; s1 = d[k] * s1 + u1[k]; } }
    }
}

__device__ __forceinline__ void na_phase(const Args& a, int l, bf16* Z, LAS unsigned char* lds_u, bf16* O, int OP, const int wv) {
    const int tid = opaque_tid_w(wv), lane = tid & 63, wave = __builtin_amdgcn_readfirstlane(tid >> 6), NGW = gridDim.x * NWAVES;
    const int bxs = opaque_s(blockIdx.x), Gs = gridDim.x, vcu = (Gs % 8 == 0) ? (bxs % 8) * (Gs / 8) + bxs / 8 : bxs, gw = vcu * NWAVES + wave;
    LAS char* wvl = (LAS char*)lds_u + wave * 16384;
    const int l15 = lane & 15, quad = lane >> 4;
    for (int it = gw; it < 8192; it += NGW) {
        const int j = it & 3, r = (it >> 2) & 63, h = (it >> 8) & 7, b = it >> 11;
        const int r0 = min(max(r - 4, 0), 56), k0 = min(max(16 * j - 8, 0), 32);
        const size_t tq = (size_t)b * SEQ + r * 64 + 16 * j + l15;
        const bf16* qp = Z + tq * ZP + ZQ_NA + 64 * h + 8 * quad;
        const bf16x8 qf0 = *(const bf16x8*)qp, qf1 = *(const bf16x8*)(qp + 32);
        f32x4 s[16];
#pragma unroll
        for (int kt = 0; kt < 16; ++kt) { const size_t tk = (size_t)b * SEQ + (r0 + (kt >> 1)) * 64 + k0 + 16 * (kt & 1) + l15;
            const bf16* kp = Z + tk * ZP + ZK_NA + 64 * h + 8 * quad;
            const bf16x8 kf0 = *(const bf16x8*)kp, kf1 = *(const bf16x8*)(kp + 32);
            f32x4 acc = {0.f, 0.f, 0.f, 0.f}; acc = MFMA16(kf0, qf0, acc); acc = MFMA16(kf1, qf1, acc); s[kt] = acc; if ((kt & 7) == 7) asm volatile("" ::: "memory"); }
        v4u vreg[16];
#pragma unroll
        for (int i = 0; i < 16; ++i) { const int id = lane + 64 * i, tl = id >> 3, ch = id & 7;
            const size_t tk = (size_t)b * SEQ + (r0 + (tl >> 5)) * 64 + k0 + (tl & 31); vreg[i] = *(const v4u*)(Z + tk * ZP + ZV_NA + 64 * h + 8 * ch); }
        const int qc = 16 * j + l15, c0 = min(max(qc - 8, 0), 48);
        const float* rp = kin(9) + (size_t)((l * 8 + h) * 15) * 31;
        float mx = -1e30f;
#pragma unroll
        for (int kt = 0; kt < 16; ++kt)
#pragma unroll
            for (int i = 0; i < 4; ++i) { const int kc = k0 + 16 * (kt & 1) + 4 * quad + i, kr = r0 + (kt >> 1), dr = kr - r + 7, dc = min(max(kc - qc + 15, 0), 30);
                const bool ok = (kc >= c0) && (kc < c0 + 16);
                const float v = ok ? s[kt][i] + rp[dr * 31 + dc] * LOG2E : -1e30f; s[kt][i] = v; mx = fmaxf(mx, v); }
        mx = fmaxf(mx, pg8::sx(mx, 16, lane)); mx = fmaxf(mx, pg8::sx(mx, 32, lane));
        float lsum = 0.f;
#pragma unroll
        for (int kt = 0; kt < 16; ++kt)
#pragma unroll
            for (int i = 0; i < 4; ++i) { const float p = __builtin_amdgcn_exp2f(s[kt][i] - mx); s[kt][i] = p; lsum += p; }
        lsum += pg8::sx(lsum, 16, lane); lsum += pg8::sx(lsum, 32, lane);
        const float inv = 1.0f / lsum;
        f32x4 o[4];
#pragma unroll
        for (int c = 0; c < 4; ++c) o[c] = (f32x4){0.f, 0.f, 0.f, 0.f};
#define NA_LOADV(half) do { _Pragma("unroll") for (int i = 0; i < 16; ++i) { const int id = lane + 64 * i, tl = id >> 3, ch = id & 7; \
            const size_t tk = (size_t)b * SEQ + (r0 + 4 * (half) + (tl >> 5)) * 64 + k0 + (tl & 31); vreg[i] = *(const v4u*)(Z + tk * ZP + ZV_NA + 64 * h + 8 * ch); } } while (0)
#define NA_STOREV() do { _Pragma("unroll") for (int i = 0; i < 16; ++i) { const int id = lane + 64 * i, tl = id >> 3, ch = id & 7; *(LAS v4u*)(wvl + tl * 128 + ch * 16) = vreg[i]; } } while (0)
#pragma unroll
        for (int half = 0; half < 2; ++half) {
            LDS_WAIT();
            NA_STOREV();
            if (half == 0) NA_LOADV(1);
            LDS_WAIT();
#pragma unroll
            for (int s4 = 0; s4 < 4; ++s4) { const int sw = 4 * half + s4;
                const bf16x8 pf = pack8(s[2 * sw][0], s[2 * sw][1], s[2 * sw][2], s[2 * sw][3], s[2 * sw + 1][0], s[2 * sw + 1][1], s[2 * sw + 1][2], s[2 * sw + 1][3]);
#pragma unroll
                for (int c = 0; c < 4; ++c) { const LAS char* vp = wvl + (32 * s4 + 4 * quad + (l15 >> 2)) * 128 + (16 * c + 4 * (l15 & 3)) * 2;
                    o[c] = MFMA16(tr_frag(vp, vp + 16 * 128), pf, o[c]); } }
        }
#undef NA_LOADV
#undef NA_STOREV
        bf16* op = O + tq * OP + 64 * h + 4 * quad;
#pragma unroll
        for (int c = 0; c < 4; ++c) { v2u w; w.x = pk2(o[c][0] * inv, o[c][1] * inv); w.y = pk2(o[c][2] * inv, o[c][3] * inv); *(v2u*)(op + 16 * c) = w; }
    }
    LDS_WAIT();
}

__device__ __forceinline__ void mla_prep_phase(const Args& a, int l, const bf16* Z, bf16* QR, const bf16* KVR, bf16* KF, const int wv) {
    const int tid = opaque_tid_w(wv), lane = tid & 63, wave = __builtin_amdgcn_readfirstlane(tid >> 6), gw = blockIdx.x * NWAVES + wave, NGW = gridDim.x * NWAVES;
    const float* qn = kin(19) + l * 192; const float* kn = kin(20) + l * 192;
    const float gq0 = qn[2 * lane], gq1 = qn[2 * lane + 1], gq2 = qn[128 + lane];
    const float gk0 = kn[2 * lane], gk1 = kn[2 * lane + 1], gk2 = kn[128 + lane];
    const float inv_freq = exp2f(-(float)(lane & 31) * (13.287712379549449f / 32.0f));
    const float qs = 0.07216878364870322f * LOG2E;
    for (int m0 = gw; m0 < M; m0 += 2 * NGW) {
        unsigned qw[2][4], kw[2][4]; float qrp[2][4], krp[2], sn[2], cs[2];
#pragma unroll
        for (int t = 0; t < 2; ++t) { const int m = m0 + t * NGW;
            krp[t] = bf2f(Z[(size_t)m * ZP + ZKR + lane]);
#pragma unroll
            for (int h = 0; h < 4; ++h) { const bf16* qp = QR + (size_t)m * 768 + 192 * h; qw[t][h] = *(const unsigned*)(qp + 2 * lane); qrp[t][h] = bf2f(qp[128 + lane]);
                kw[t][h] = *(const unsigned*)(KVR + (size_t)m * 1024 + 256 * h + 2 * lane); }
            sincosf((float)(m & (SEQ - 1)) * inv_freq, &sn[t], &cs[t]); }
        float sq[2][4], sk[2][4];
#pragma unroll
        for (int t = 0; t < 2; ++t)
#pragma unroll
            for (int h = 0; h < 4; ++h) { const float a0 = pg8::bflo(qw[t][h]), a1 = pg8::bfhi(qw[t][h]), b0 = pg8::bflo(kw[t][h]), b1 = pg8::bfhi(kw[t][h]);
                sq[t][h] = a0 * a0 + a1 * a1 + qrp[t][h] * qrp[t][h]; sk[t][h] = b0 * b0 + b1 * b1 + krp[t] * krp[t]; }
#pragma unroll
        for (int o = 1; o < 64; o <<= 1)
#pragma unroll
            for (int t = 0; t < 2; ++t)
#pragma unroll
                for (int h = 0; h < 4; ++h) { sq[t][h] += pg8::sx(sq[t][h], o, lane); sk[t][h] += pg8::sx(sk[t][h], o, lane); }
#pragma unroll
        for (int t = 0; t < 2; ++t) { const int m = m0 + t * NGW;
#pragma unroll
            for (int h = 0; h < 4; ++h) {
                { bf16* qp = QR + (size_t)m * 768 + 192 * h; const float r = 1.0f / sqrtf(sq[t][h] * (1.0f / 192.0f) + EPS);
                  const float x = qrp[t][h] * r * gq2, y = pg8::sx(x, 32, lane); const float ro = (lane < 32) ? (x * cs[t] - y * sn[t]) : (y * sn[t] + x * cs[t]);
                  *(unsigned*)(qp + 2 * lane) = pk2(pg8::bflo(qw[t][h]) * r * gq0 * qs, pg8::bfhi(qw[t][h]) * r * gq1 * qs); qp[128 + lane] = f2bf(ro * qs); }
                { bf16* ko = KF + (size_t)m * 768 + 192 * h; const float r = 1.0f / sqrtf(sk[t][h] * (1.0f / 192.0f) + EPS);
                  const float x = krp[t] * r * gk2, y = pg8::sx(x, 32, lane); const float ro = (lane < 32) ? (x * cs[t] - y * sn[t]) : (y * sn[t] + x * cs[t]);
                  *(unsigned*)(ko + 2 * lane) = pk2(pg8::bflo(kw[t][h]) * r * gk0, pg8::bfhi(kw[t][h]) * r * gk1); ko[128 + lane] = f2bf(ro); } } }
    }
}

constexpr int MK_P = 400, MV_P = 288, MK_BYTES = 64 * MK_P, MV_BYTES = 64 * MV_P, MV_OFF = 2 * MK_BYTES;
__device__ __forceinline__ void mla_attn_unit(LAS unsigned char* lds_u, const bf16* QF, const bf16* KF, const bf16* KVR, bf16* Z, int b, int h, int qb, const int wv) {
    LAS char* lds = (LAS char*)lds_u;
    const int tid = opaque_tid_w(wv), lane = tid & 63, wave = __builtin_amdgcn_readfirstlane(tid >> 6), r32 = lane & 31, hi = lane >> 5, i16 = lane & 15, blk = (lane >> 4) & 1;
    const size_t tokb = (size_t)b * SEQ;
    const size_t qtok = tokb + 256 * qb + 32 * wave + r32;
    bf16x8 qf[12];
    { const bf16* qp = QF + qtok * 768 + 192 * h + 8 * hi;
#pragma unroll
      for (int s = 0; s < 12; ++s) qf[s] = *(const bf16x8*)(qp + 16 * s); }
    f32x16 o[4];
#pragma unroll
    for (int c = 0; c < 4; ++c) o[c] = f32x16{};
    float mrun = -1e30f, lrun = 0.f;
    int krow[3], kch[3];
#pragma unroll
    for (int i = 0; i < 3; ++i) { const int id = tid + NTHR * i; krow[i] = id / 24; kch[i] = id - krow[i] * 24; }
    const bf16* kbase = KF + tokb * 768 + 192 * h; const bf16* vbase = KVR + tokb * 1024 + 256 * h + 128;
    v4u kreg[3], vreg[2];
#define MLA_LOAD(t) do { _Pragma("unroll") for (int i = 0; i < 3; ++i) kreg[i] = *(const v4u*)(kbase + (size_t)(64 * (t) + krow[i]) * 768 + 8 * kch[i]); \
        _Pragma("unroll") for (int i = 0; i < 2; ++i) { const int id = tid + NTHR * i; vreg[i] = *(const v4u*)(vbase + (size_t)(64 * (t) + (id >> 4)) * 1024 + 8 * (id & 15)); } } while (0)
#define MLA_STORE(kbuf, vbuf) do { _Pragma("unroll") for (int i = 0; i < 3; ++i) *(LAS v4u*)(lds + (kbuf) * MK_BYTES + krow[i] * MK_P + kch[i] * 16) = kreg[i]; \
        _Pragma("unroll") for (int i = 0; i < 2; ++i) { const int id = tid + NTHR * i; *(LAS v4u*)(lds + MV_OFF + (vbuf) * MV_BYTES + (id >> 4) * MV_P + (id & 15) * 16) = vreg[i]; } } while (0)
#define SB() __builtin_amdgcn_sched_barrier(0)
    bf16x8 fr8[8];
#define MLA_VLD(vb_, j, n) do { const LAS char* vp = (vb_) + (16 * ((n) & 3) + 4 * hi + (i16 >> 2)) * MV_P + (32 * ((n) >> 2) + 16 * blk + 4 * (i16 & 3)) * 2; fr8[j] = tr_frag(vp, vp + 8 * MV_P); } while (0)
#define MLA_PV(vb_) do { _Pragma("unroll") for (int j = 0; j < 8; ++j) MLA_VLD(vb_, j, j); SB(); \
        _Pragma("unroll") for (int n = 0; n < 16; ++n) { o[n >> 2] = MFMA32(fr8[n & 7], pf[n & 3], o[n >> 2]); if (n < 8) MLA_VLD(vb_, n & 7, n + 8); SB(); } } while (0)
    const bool late = wave >= 4;
    bf16x8 pf[4] = {};
    MLA_LOAD(0); MLA_STORE(0, 0);
    __syncthreads();
    int vcur = 0, vprev = 2;
    for (int t = 0; t < 64; ++t) {
        const int cur = t & 1;
        if (t + 1 < 64) MLA_LOAD(t + 1);
        const LAS char* kb = lds + cur * MK_BYTES; const LAS char* vb = lds + MV_OFF + vcur * MV_BYTES;
        if (late && t > 0) MLA_PV(lds + MV_OFF + vprev * MV_BYTES);
        f32x16 p0 = f32x16{}, p1 = f32x16{};
#define MLA_KLD(j, s, half) fr8[j] = *(const LAS bf16x8*)(kb + ((half) * 32 + r32) * MK_P + (16 * (s) + 8 * hi) * 2)
#pragma unroll
        for (int i = 0; i < 4; ++i) { MLA_KLD(2 * i, i, 0); MLA_KLD(2 * i + 1, i, 1); }
        SB();
#pragma unroll
        for (int g = 0; g < 3; ++g)
#pragma unroll
            for (int i = 0; i < 4; ++i) {
                p0 = MFMA32(fr8[2 * i], qf[4 * g + i], p0); if (g < 2) MLA_KLD(2 * i, 4 * (g + 1) + i, 0);
                p1 = MFMA32(fr8[2 * i + 1], qf[4 * g + i], p1); if (g < 2) MLA_KLD(2 * i + 1, 4 * (g + 1) + i, 1);
                SB(); }
#undef MLA_KLD
        float mx = fmaxf(p0[0], p1[0]);
#pragma unroll
        for (int r = 1; r < 16; ++r) mx = fmaxf(mx, fmaxf(p0[r], p1[r]));
        mx = fmaxf(mx, pg8::sx(mx, 32, lane));
        if (__any(mx > mrun)) {
            const float mn_ = fmaxf(mrun, mx), f = __builtin_amdgcn_exp2f(mrun - mn_); mrun = mn_; lrun *= f;
#pragma unroll
            for (int c = 0; c < 4; ++c)
#pragma unroll
                for (int r = 0; r < 16; ++r) o[c][r] *= f;
        }
        const float mn = mrun;
        float ls = 0.f;
#pragma unroll
        for (int r = 0; r < 16; ++r) { p0[r] = __builtin_amdgcn_exp2f(p0[r] - mn); p1[r] = __builtin_amdgcn_exp2f(p1[r] - mn); ls += p0[r] + p1[r]; }
        lrun += ls;
        pf[0] = pack8(p0[0], p0[1], p0[2], p0[3], p0[4], p0[5], p0[6], p0[7]); pf[1] = pack8(p0[8], p0[9], p0[10], p0[11], p0[12], p0[13], p0[14], p0[15]);
        pf[2] = pack8(p1[0], p1[1], p1[2], p1[3], p1[4], p1[5], p1[6], p1[7]); pf[3] = pack8(p1[8], p1[9], p1[10], p1[11], p1[12], p1[13], p1[14], p1[15]);
        if (!late) MLA_PV(vb);
        const int vnext = (vcur == 2) ? 0 : vcur + 1;
        if (t + 1 < 64) MLA_STORE(cur ^ 1, vnext);
        vprev = vcur; vcur = vnext;
        __syncthreads();
    }
    if (late) MLA_PV(lds + MV_OFF + vprev * MV_BYTES);
#undef MLA_LOAD
#undef MLA_STORE
#undef MLA_PV
#undef MLA_VLD
#undef SB
    lrun += pg8::sx(lrun, 32, lane);
    const float inv = 1.0f / lrun;
    bf16* op = Z + qtok * ZP + ZCQ + 128 * h + 4 * hi;
#pragma unroll
    for (int c = 0; c < 4; ++c)
#pragma unroll
        for (int g4 = 0; g4 < 4; ++g4) { v2u w; w.x = pk2(o[c][4 * g4] * inv, o[c][4 * g4 + 1] * inv); w.y = pk2(o[c][4 * g4 + 2] * inv, o[c][4 * g4 + 3] * inv);
            *(v2u*)(op + 32 * c + 8 * g4) = w; }
}

__device__ __forceinline__ void zero_f32(float* p, int n, const int wv) { const int t0 = opaque_s(blockIdx.x) * NTHR + opaque_tid_w(wv); for (int i = t0; i < n; i += gridDim.x * NTHR) __hip_atomic_store((unsigned*)p + i, 0u, __ATOMIC_RELAXED, __HIP_MEMORY_SCOPE_AGENT); }
#ifndef DUP_MASK
#define DUP_MASK 0
#endif
#ifndef PH_MASK
#define PH_MASK 0xFFFF
#endif
#if DUP_MASK & 8
#define GSYNC() do { xcd_barrier(xbar, leader); xcd_barrier(xbar, leader); } while (0)
#else
#define GSYNC() xcd_barrier(xbar, leader)
#endif
__global__ void __launch_bounds__(NTHR, 2) mega_fwd(Args a) {
    extern __shared__ __attribute__((aligned(16))) unsigned char lds_raw[];
    LAS unsigned char* lds = (LAS unsigned char*)lds_raw;
    cg::grid_group grid = cg::this_grid();
    const int wv = __builtin_amdgcn_readfirstlane((int)threadIdx.x >> 6);
    const bool leader = (threadIdx.x == 0);
    if (threadIdx.x < 2) ((volatile LAS unsigned*)(lds + 131072))[threadIdx.x] = 0u;
    __syncthreads();
    XcdBarrier xbar; xbar.bar = (unsigned*)((unsigned char*)kin(30)); xbar.x = xb_xcc_id(); xbar.st = (volatile LAS unsigned*)(lds + 131072);
    if (blockIdx.x == 0) for (int i = threadIdx.x; i < 4096; i += NTHR) __hip_atomic_store(xbar.bar + i, 0u, __ATOMIC_RELAXED, __HIP_MEMORY_SCOPE_AGENT);
    const int G = gridDim.x, bx = blockIdx.x;
    const int vcu = (G % 8 == 0) ? (bx % 8) * (G / 8) + bx / 8 : bx;
#define ws ((unsigned char*)kin(30))
#define XB ((bf16*)(ws + WS_XN))
#define MIXB ((bf16*)(ws + WS_QR))
#define Z ((bf16*)(ws + WS_Z))
#define Hb ((bf16*)(ws + WS_Z))
#define SSa ((unsigned*)(ws + WS_PS))
#define SSb (SSa + M)
#define SSc (SSa + 2 * M)
#define QR ((bf16*)(ws + WS_QR))
#define KVR ((bf16*)(ws + WS_KVR))
#define KF ((bf16*)(ws + WS_KF))
#define U ((float*)(ws + WS_U))
#define MIXF ((float*)(ws + WS_U))
#define Dd ((float*)(ws + WS_DD))
#define wt (ws + WS_WT)
#define out ((float*)kin(29))
#ifdef TSEL_MASK
    unsigned long long tacc = 0, tprev = __builtin_amdgcn_s_memrealtime();
#endif
    for (int step = 0; step < DEPTH * 12; ++step) {
        const int l = step / 12, ph = step - l * 12;
        const float* xin = (l == 0) ? kin(0) : out;
        switch (ph) {
        case 0: {
#if (PH_MASK >> 0) & 1
        if (l == 0) { convert_set(a, l, lds, wv, 0x80Bu  , opaque_s(bx) * NWAVES + wv, G * NWAVES, true);
                      xprep_phase(kin(0), XB, SSc, wv); zero_f32((float*)SSa, 2 * M, wv); }
#endif
        } break;
        case 1: case 10: {
#if (PH_MASK >> 1) & 1
        { const bool second = (ph == 10);
          pg8::Gemm g{XB, (const bf16*)(wt + (second ? WT_13B : WT_13A)), M, 2 * FF, DM, DM, DM}; pg8::StaticOrder S; S.init(M, 2 * FF, opaque_s(G), opaque_s(bx));
          pg8::EpiSwiGLU E{Hb, FF, second ? SSb : SSc}; pg8::gemm_phase<pg8::EpiSwiGLU, pg8::StaticOrder, true, true>(lds, g, S, E, wv);
#if DUP_MASK & 1
          __syncthreads(); pg8::gemm_phase<pg8::EpiSwiGLU, pg8::StaticOrder, true, true>(lds, g, S, E, wv);
#endif
          __syncthreads();
          convert_tail(a, l, lds, wv, second ? 0x1000u   : 0x404u  , (M / 256) * (2 * FF / 256));
          if (second && l + 1 < DEPTH) convert_tail(a, l + 1, lds, wv, 0x001u  , (M / 256) * (2 * FF / 256));
        }
#endif
        } break;
        case 2: case 9: case 11: {
#if (PH_MASK >> 2) & 1
        { const bool isout = (ph == 9);
          const bf16* Ap = isout ? MIXB : Hb; const size_t wo = isout ? WT_OUT : (ph == 2 ? WT_2A : WT_2B); const int Kd = isout ? DM : FF;
          pg8::Gemm g{Ap, (const bf16*)(wt + wo), M, DM, Kd, Kd, Kd}; pg8::StaticOrder S; S.init(M, DM, opaque_s(G), opaque_s(bx));
          unsigned* SSp = SSa + (isout ? M : (ph == 2 ? 0 : 2 * M));
          pg8::EpiResid E{(ph == 2) ? xin : (const float*)out, out, DM, isout ? 1.0f : 0.5f, XB, SSp}; pg8::gemm_phase<pg8::EpiResid, pg8::StaticOrder, true, true>(lds, g, S, E, wv); }
        if (ph == 11 && l + 1 < DEPTH) {
            __syncthreads();
            convert_set(a, l + 1, lds, wv, 0x80Au, opaque_s(bx) * NWAVES + wv, G * NWAVES, true);
        }
#endif
        } break;
        case 3: {
#if (PH_MASK >> 4) & 1
        { pg8::Gemm g{XB, (const bf16*)(wt + WT_IN), M, ZP, DM, DM, DM}; pg8::StaticOrder S; S.init(M, ZP, opaque_s(G), opaque_s(bx));
          pg8::EpiBf16<true> E{Z, ZP, SSa}; pg8::gemm_phase<pg8::EpiBf16<true>, pg8::StaticOrder, true, true>(lds, g, S, E, wv); }
        __syncthreads();
        convert_tail(a, l, lds, wv, 0x3F0u  , (M / 256) * (ZP / 256));
#endif
        } break;
        case 4: {
#if (PH_MASK >> 5) & 1
        zero_f32((float*)SSa, 3 * M, wv);
        token_prep_phase(a, l, Z, wv);
        for (int it = opaque_s(bx); it < 1024; it += G) gla_item(a, l, 0, it >> 8, (it >> 6) & 3, it & 63, Z, U, (const bf16*)XB, Dd, lds, wv);
#if DUP_MASK & 32
        for (int it = opaque_s(bx); it < 1024; it += G) gla_item(a, l, 0, it >> 8, (it >> 6) & 3, it & 63, Z, U, (const bf16*)XB, Dd, lds, wv);
#endif
#endif
        } break;
        case 5: {
#if (PH_MASK >> 6) & 1
        { pg8::Gemm g{Z + ZCQ, (const bf16*)(wt + WT_UQ), M, 768, 256, ZP, 256}; pg8::StaticOrder S; S.init(M, 768, opaque_s(G), opaque_s(bx));
          pg8::EpiBf16<false> E{QR, 768, nullptr}; pg8::gemm_phase<pg8::EpiBf16<false>, pg8::StaticOrder, true, true>(lds, g, S, E, wv); }
        __syncthreads();
        { pg8::Gemm g{Z + ZCKV, (const bf16*)(wt + WT_UKV), M, 1024, 256, ZP, 256}; pg8::StaticOrder S; S.init(M, 1024, opaque_s(G), opaque_s(bx));
          pg8::EpiBf16<false> E{KVR, 1024, nullptr}; pg8::gemm_phase<pg8::EpiBf16<false>, pg8::StaticOrder, true, true>(lds, g, S, E, wv); }
        __syncthreads();
        for (int st = 0; st < 2; ++st) {
            if ((st == 0) == (wv < 4)) gla_scan_phase(U, (bf16*)XB, Dd, wv);
            else na_phase(a, l, Z, lds, Z + ZQ_NA, ZP, wv);
        }
#endif
        } break;
        case 6: {
#if (PH_MASK >> 7) & 1
        for (int st = 0; st < 2; ++st) {
            if ((st == 0) == ((opaque_s(bx) & 1) == 0)) mla_prep_phase(a, l, Z, QR, KVR, KF, wv);
            else for (int it = opaque_s(bx); it < 1024; it += G) gla_item(a, l, 1, it >> 8, (it >> 6) & 3, it & 63, Z, U, (const bf16*)XB, Dd, lds, wv);
            __syncthreads();
        }
#endif
        } break;
        case 7: {
#if (PH_MASK >> 8) & 1
        for (int u = opaque_s(vcu); u < 256; u += G) { mla_attn_unit(lds, QR, KF, KVR, Z, (u >> 4) >> 2, (u >> 4) & 3, u & 15, wv); __syncthreads(); }
#if DUP_MASK & 2
        for (int u = opaque_s(vcu); u < 256; u += G) { mla_attn_unit(lds, QR, KF, KVR, Z, (u >> 4) >> 2, (u >> 4) & 3, u & 15, wv); __syncthreads(); }
#endif
#endif
        } break;
        case 8: {
#if (PH_MASK >> 9) & 1
        { pg8::Gemm g{Z, (const bf16*)(wt + WT_BR), M, 1024, 512, ZP, 512}; pg8::MergeOrder S{opaque_s(G), opaque_s(vcu), ZQ_NA, ZGV, ZCQ};
          pg8::EpiMerge E{Z, ZP, ZGATE, MIXB}; pg8::gemm_phase<pg8::EpiMerge, pg8::MergeOrder, true, true>(lds, g, S, E, wv); }
#endif
        } break;
        default: break;
        }
        if (ph == 0 && l > 0) continue;
        if (step == 0) { grid.sync(); if (leader) (void)xb_add(&xbar.bar[XB_XCNT(xbar.x)], 1u); }
        else GSYNC();
#ifdef TSEL_MASK
        { const unsigned long long tnow = __builtin_amdgcn_s_memrealtime(); if ((TSEL_MASK >> ph) & 1) tacc += tnow - tprev; tprev = tnow; }
#endif
    }
#ifdef TSEL_MASK
    if (blockIdx.x == 0) { const unsigned long long t0 = __builtin_amdgcn_s_memrealtime(); while (__builtin_amdgcn_s_memrealtime() - t0 < 9ull * tacc) __builtin_amdgcn_s_sleep(8); }
#endif
}

#undef ws
#undef XB
#undef MIXB
#undef Z
#undef Hb
#undef SSa
#undef SSb
#undef SSc
#undef QR
#undef KVR
#undef KF
#undef U
#undef MIXF
#undef Dd
#undef wt
#undef out
extern "C" void kernel_launch(void* const* d_in, const int* in_sizes, int n_in, void* d_out, int out_size, void* d_ws, size_t ws_size, hipStream_t stream) {
    static int grid = 0;
    if (grid == 0) {
        if (n_in != 29 || out_size != M * DM || ws_size < WS_END) { fprintf(stderr, "kernel_launch: unexpected shapes / workspace (%d inputs, out %d, ws %zu)\n", n_in, out_size, ws_size); grid = -1; return; }
        int dev = 0, cus = 0, per_cu = 0;
        (void)hipGetDevice(&dev); (void)hipDeviceGetAttribute(&cus, hipDeviceAttributeMultiprocessorCount, dev);
        (void)hipFuncSetAttribute((const void*)mega_fwd, hipFuncAttributeMaxDynamicSharedMemorySize, LDS_BYTES);
        if (hipOccupancyMaxActiveBlocksPerMultiprocessor(&per_cu, (const void*)mega_fwd, NTHR, LDS_BYTES) != hipSuccess || per_cu < 1) per_cu = 1;
        (void)hipGetLastError();
        grid = cus * per_cu; if (grid > 256) grid = 256;
        if (grid <= 0) grid = 256;
    }
    if (grid < 0) return;
    Args a{};
    for (int i = 0; i < 29; ++i) a.in[i] = (const float*)d_in[i];
    a.out = (float*)d_out; a.ws = (unsigned char*)d_ws;
    void* args[] = {&a};
    hipError_t e = hipLaunchCooperativeKernel((const void*)mega_fwd, dim3(grid), dim3(NTHR), args, LDS_BYTES, stream);
    if (e != hipSuccess) fprintf(stderr, "cooperative launch failed: %s (grid %d)\n", hipGetErrorString(e), grid);
}
```

```cpp
#include <hip/hip_runtime.h>
#include <hip/hip_cooperative_groups.h>
#include <cstdio>
#include <cstdint>
namespace cg = cooperative_groups;

namespace pg8 {
#define PG8_LAS __attribute__((address_space(3)))
typedef unsigned short bf16_t;
typedef short bf16x8 __attribute__((ext_vector_type(8)));
typedef float f32x4 __attribute__((ext_vector_type(4)));
typedef unsigned u32x4 __attribute__((ext_vector_type(4)));
typedef unsigned u32x2 __attribute__((ext_vector_type(2)));
constexpr int BM = 256, BK = 64, HALF = 128, HTB = HALF * BK * 2  , STAGE_BYTES = 8 * HTB, NXCD = 8, WGM = 8;

__host__ __device__ __forceinline__ int lds_byte(int r, int c) { const int st = (r >> 4) * 2 + (c >> 5), rr = r & 15, cc = c & 31, ob = rr * 64 + cc * 2; return st * 1024 + (ob ^ (((ob >> 9) & 1) << 5)); }
__host__ __device__ __forceinline__ void stage_rc(int b, int& R, int& C) { const int st = b / 1024, sb = b % 1024, swz = sb ^ (((sb >> 9) & 1) << 5); R = (st >> 1) * 16 + swz / 64; C = (st & 1) * 32 + (swz % 64) / 2; }
__host__ __device__ __forceinline__ int perm32(int rho) { const int n = rho >> 4, i = rho & 15; return 8 * (i >> 2) + 4 * n + (i & 3); }

struct Unit { int pm, pn; };
struct Gemm { const bf16_t* A; const bf16_t* Bt; int M, N, K, lda, ldb; };

struct StaticOrder {
    int nM, nN, nwg, G, c;
    __host__ __device__ void init(int M, int N, int G_, int c_) { nM = M / BM; nN = N / BM; nwg = nM * nN; G = G_; c = c_; }
    __host__ __device__ __forceinline__ bool next(int i, Unit& u) const {
        const long L = (long)i * G + c; if (L >= nwg) return false;
        int wgid = (int)L; { const int q = nwg / NXCD, r = nwg % NXCD, xcd = wgid % NXCD, off = wgid / NXCD; wgid = (xcd < r ? xcd * (q + 1) : r * (q + 1) + (xcd - r) * q) + off; }
        const int nig = WGM * nN, gid = wgid / nig, fm = gid * WGM, gsz = (nM - fm) < WGM ? (nM - fm) : WGM;
        u.pm = fm + ((wgid % nig) % gsz); u.pn = (wgid % nig) / gsz; return true;
    }
    __device__ __forceinline__ size_t aoff(const Unit& u, const Gemm& g) const { return (size_t)u.pm * BM * g.lda * 2; }
    __device__ __forceinline__ size_t boff(const Unit& u, const Gemm& g) const { return (size_t)u.pn * BM * g.ldb * 2; }
    __device__ __forceinline__ void a_ready(const Unit&) const {}
    __device__ __forceinline__ void done(const Unit&) const {}
};
struct MlaUpOrder : StaticOrder {
    int acq, ackv;
    __device__ __forceinline__ size_t aoff(const Unit& u, const Gemm& g) const { return ((size_t)u.pm * BM * g.lda + (u.pn < 3 ? acq : ackv)) * 2; }
};
struct MergeOrder {
    int G, c; int acol0, acol1, acol2;
    __device__ __forceinline__ bool next(int k, Unit& u) const { const int t = c + (k / 3) * G; if (t >= 256) return false; const int i = k % 3; u.pm = i * 64 + (t >> 2); u.pn = i * 4 + (t & 3); return true; }
    __device__ __forceinline__ size_t aoff(const Unit& u, const Gemm& g) const { const int i = u.pm >> 6; const int ac = acol0 + i * (acol1 - acol0) + (i >> 1) * (acol2 - 2 * acol1 + acol0); return ((size_t)(u.pm & 63) * BM * g.lda + ac) * 2; }
    __device__ __forceinline__ size_t boff(const Unit& u, const Gemm& g) const { return (size_t)u.pn * BM * g.ldb * 2; }
    __device__ __forceinline__ void a_ready(const Unit&) const {}
    __device__ __forceinline__ void done(const Unit&) const {}
};

__device__ __forceinline__ unsigned cvt_pk_bf16(float lo, float hi) { unsigned r; asm volatile("v_cvt_pk_bf16_f32 %0, %1, %2" : "=v"(r) : "v"(lo), "v"(hi)); return r; }
__device__ __forceinline__ float sx(float v, int mask, int lane) { return __builtin_bit_cast(float, __builtin_amdgcn_ds_bpermute((lane ^ mask) << 2, __builtin_bit_cast(int, v))); }
__device__ __forceinline__ float bflo(unsigned w) { return __builtin_bit_cast(float, w << 16); }
__device__ __forceinline__ float bfhi(unsigned w) { return __builtin_bit_cast(float, w & 0xffff0000u); }
__device__ __forceinline__ float fsigmoid(float x) { return __builtin_amdgcn_rcpf(1.0f + __builtin_amdgcn_exp2f(-1.4426950408889634f * x)); }

struct RowSS { unsigned raw[8]; };
struct NoState {};
__device__ __forceinline__ void load_rowss(RowSS& st, const unsigned* SS, const Unit& u, int wr) {
    int ln; asm volatile("v_mbcnt_lo_u32_b32 %0, -1, 0\n\tv_mbcnt_hi_u32_b32 %0, -1, %0" : "=&v"(ln)); const int row0 = u.pm * BM + wr * 64 + (ln & 15);
#pragma unroll
    for (int ai = 0; ai < 2; ++ai)
#pragma unroll
        for (int m = 0; m < 4; ++m) st.raw[ai * 4 + m] = __hip_atomic_load(SS + row0 + ai * HALF + m * 16, __ATOMIC_RELAXED, __HIP_MEMORY_SCOPE_AGENT);
}
__device__ __forceinline__ float rs_of(unsigned raw) { return 1.0f / sqrtf((float)raw * (1.0f / (4096.0f * 1024.0f)) + 1e-6f); }
template <bool SCALE> struct EpiBf16 {
    static constexpr bool PERM = true, AFTER_DRAIN = false, KEEP = false;
    bf16_t* O; int ldc; const unsigned* SS;
    typedef RowSS State;
    __device__ __forceinline__ void pre(State& st, const Unit& u, int wr) const { if (SCALE) load_rowss(st, SS, u, wr); }
    __device__ __forceinline__ void operator()(const f32x4 (&acc)[2][2][4][2], const Unit& u, int wr, int wc, int fr_, int fq_, const State& st) const {
        int ln; asm volatile("v_mbcnt_lo_u32_b32 %0, -1, 0\n\tv_mbcnt_hi_u32_b32 %0, -1, %0" : "=&v"(ln)); const int fr = ln & 15, fq = ln >> 4;
        const int row0 = u.pm * BM + wr * 64 + fr; const int col0 = u.pn * BM + wc * 32 + 8 * fq;
#pragma unroll
        for (int ai = 0; ai < 2; ++ai)
#pragma unroll
            for (int m = 0; m < 4; ++m) { bf16_t* rowp = O + (size_t)(row0 + ai * HALF + m * 16) * ldc + col0;
                float rs = 1.0f; if (SCALE) rs = rs_of(st.raw[ai * 4 + m]);
#pragma unroll
                for (int bj = 0; bj < 2; ++bj) { const f32x4 v0 = acc[ai][bj][m][0] * rs, v1 = acc[ai][bj][m][1] * rs;
                    u32x4 w; w.x = cvt_pk_bf16(v0[0], v0[1]); w.y = cvt_pk_bf16(v0[2], v0[3]); w.z = cvt_pk_bf16(v1[0], v1[1]); w.w = cvt_pk_bf16(v1[2], v1[3]);
                    *(u32x4*)(rowp + bj * HALF) = w; } }
    }
};
struct EpiMlaUp {
    static constexpr bool PERM = true, AFTER_DRAIN = false, KEEP = false;
    bf16_t* Q; bf16_t* KV;
    typedef NoState State;
    __device__ __forceinline__ void pre(State&, const Unit&, int) const {}
    __device__ __forceinline__ void operator()(const f32x4 (&acc)[2][2][4][2], const Unit& u, int wr, int wc, int fr_, int fq_, const State&) const {
        int ln; asm volatile("v_mbcnt_lo_u32_b32 %0, -1, 0\n\tv_mbcnt_hi_u32_b32 %0, -1, %0" : "=&v"(ln)); const int fr = ln & 15, fq = ln >> 4;
        const bool isq = u.pn < 3; bf16_t* O = isq ? Q : KV; const int ldc = isq ? 768 : 1024, pt = isq ? u.pn : u.pn - 3;
        const int row0 = u.pm * BM + wr * 64 + fr; const int col0 = pt * BM + wc * 32 + 8 * fq;
#pragma unroll
        for (int ai = 0; ai < 2; ++ai)
#pragma unroll
            for (int m = 0; m < 4; ++m) { bf16_t* rowp = O + (size_t)(row0 + ai * HALF + m * 16) * ldc + col0;
#pragma unroll
                for (int bj = 0; bj < 2; ++bj) { const f32x4 v0 = acc[ai][bj][m][0], v1 = acc[ai][bj][m][1];
                    u32x4 w; w.x = cvt_pk_bf16(v0[0], v0[1]); w.y = cvt_pk_bf16(v0[2], v0[3]); w.z = cvt_pk_bf16(v1[0], v1[1]); w.w = cvt_pk_bf16(v1[2], v1[3]);
                    *(u32x4*)(rowp + bj * HALF) = w; } }
    }
};
struct EpiSwiGLU {
    static constexpr bool PERM = true, AFTER_DRAIN = false, KEEP = false;
    bf16_t* O; int ldc; const unsigned* SS;
    typedef RowSS State;
    __device__ __forceinline__ void pre(State& st, const Unit& u, int wr) const { load_rowss(st, SS, u, wr); }
    __device__ __forceinline__ void operator()(const f32x4 (&acc)[2][2][4][2], const Unit& u, int wr, int wc, int fr_, int fq_, const State& st) const {
        int ln; asm volatile("v_mbcnt_lo_u32_b32 %0, -1, 0\n\tv_mbcnt_hi_u32_b32 %0, -1, %0" : "=&v"(ln)); const int fr = ln & 15, fq = ln >> 4;
        const int row0 = u.pm * BM + wr * 64 + fr; const int col0 = u.pn * HALF + wc * 32 + 8 * fq;
#pragma unroll
        for (int ai = 0; ai < 2; ++ai)
#pragma unroll
            for (int m = 0; m < 4; ++m) { bf16_t* rowp = O + (size_t)(row0 + ai * HALF + m * 16) * ldc + col0;
                const float rs = rs_of(st.raw[ai * 4 + m]);
                float h[8];
#pragma unroll
                for (int n = 0; n < 2; ++n)
#pragma unroll
                    for (int j = 0; j < 4; ++j) { const float gt = acc[ai][0][m][n][j] * rs, up = acc[ai][1][m][n][j] * rs; h[4 * n + j] = gt * fsigmoid(gt) * up; }
                u32x4 w; w.x = cvt_pk_bf16(h[0], h[1]); w.y = cvt_pk_bf16(h[2], h[3]); w.z = cvt_pk_bf16(h[4], h[5]); w.w = cvt_pk_bf16(h[6], h[7]);
                *(u32x4*)rowp = w; }
    }
};
struct EpiResid {
    static constexpr bool PERM = false, AFTER_DRAIN = false, KEEP = false;
    const float* base; float* out; int ldc; float alpha; bf16_t* XB; unsigned* SS;
    typedef NoState State;
    __device__ __forceinline__ void pre(State&, const Unit&, int) const {}
    __device__ __forceinline__ void operator()(const f32x4 (&acc)[2][2][4][2], const Unit& u, int wr, int wc, int fr_, int fq_, const State&) const {
        int ln; asm volatile("v_mbcnt_lo_u32_b32 %0, -1, 0\n\tv_mbcnt_hi_u32_b32 %0, -1, %0" : "=&v"(ln)); const int fr = ln & 15, fq = ln >> 4;
        const int row0 = u.pm * BM + wr * 64 + fr, col0 = u.pn * BM + wc * 32 + 4 * fq;
        float al = alpha; asm volatile("" : "+v"(al));
        bf16_t* xb = XB; unsigned* ssp = SS; asm volatile("" : "+s"(xb), "+s"(ssp));
#pragma unroll
        for (int ai = 0; ai < 2; ++ai)
#pragma unroll
            for (int m = 0; m < 4; ++m) { const size_t off = (size_t)(row0 + ai * HALF + m * 16) * ldc + col0; float ss = 0.f;
#pragma unroll
                for (int bj = 0; bj < 2; ++bj)
#pragma unroll
                    for (int n = 0; n < 2; ++n) { const f32x4 b = *(const f32x4*)(base + off + bj * HALF + n * 16); const f32x4 v = b + acc[ai][bj][m][n] * al;
                        *(f32x4*)(out + off + bj * HALF + n * 16) = v; ss += (v[0] * v[0] + v[1] * v[1]) + (v[2] * v[2] + v[3] * v[3]);
                        u32x2 w; w.x = cvt_pk_bf16(v[0], v[1]); w.y = cvt_pk_bf16(v[2], v[3]); *(u32x2*)(xb + off + bj * HALF + n * 16) = w; }
                { const int ln = fq * 16 + fr; ss += sx(ss, 16, ln); ss += sx(ss, 32, ln); }
                if (fq == 0) (void)__hip_atomic_fetch_add(ssp + row0 + ai * HALF + m * 16, (unsigned)(ss * 4096.0f + 0.5f), __ATOMIC_RELAXED, __HIP_MEMORY_SCOPE_AGENT); }
    }
};
struct EpiMerge {
    static constexpr bool PERM = false, AFTER_DRAIN = false, KEEP = true;
    const bf16_t* Z; int ldz, gcol; bf16_t* MIXB;
    typedef NoState State;
    __device__ __forceinline__ void pre(State&, const Unit&, int) const {}
    __device__ __forceinline__ bool zero_after(const Unit& u) const { return (u.pm >> 6) == 2; }
    __device__ __forceinline__ void operator()(f32x4 (&acc)[2][2][4][2], const Unit& u, int wr, int wc, int fr_, int fq_, const State&) const {
        int ln; asm volatile("v_mbcnt_lo_u32_b32 %0, -1, 0\n\tv_mbcnt_hi_u32_b32 %0, -1, %0" : "=&v"(ln)); const int fr = ln & 15, fq = ln >> 4;
        const int i = u.pm >> 6, pm = u.pm & 63, pn = u.pn & 3;
        const int row0 = pm * BM + wr * 64 + fr, col0 = pn * BM + wc * 32 + 4 * fq;
#pragma unroll
        for (int ai = 0; ai < 2; ++ai)
#pragma unroll
            for (int m = 0; m < 4; ++m) { const int row = row0 + ai * HALF + m * 16;
#pragma unroll
                for (int bj = 0; bj < 2; ++bj)
#pragma unroll
                    for (int n = 0; n < 2; ++n) { const int col = col0 + bj * HALF + n * 16;
                        const bf16_t* gp = Z + (size_t)row * ldz + gcol + i * 1024 + col;
                        const u32x2 ga = *(const u32x2*)gp;
                        f32x4 ea; ea[0] = __builtin_amdgcn_exp2f(-1.4426950408889634f * bflo(ga.x)); ea[1] = __builtin_amdgcn_exp2f(-1.4426950408889634f * bfhi(ga.x));
                        ea[2] = __builtin_amdgcn_exp2f(-1.4426950408889634f * bflo(ga.y)); ea[3] = __builtin_amdgcn_exp2f(-1.4426950408889634f * bfhi(ga.y));
                        f32x4 v = acc[ai][bj][m][n];
                        if (i < 2) { const u32x2 gb = *(const u32x2*)(gp + 1024);
                            f32x4 eb; eb[0] = __builtin_amdgcn_exp2f(-1.4426950408889634f * bflo(gb.x)); eb[1] = __builtin_amdgcn_exp2f(-1.4426950408889634f * bfhi(gb.x));
                            eb[2] = __builtin_amdgcn_exp2f(-1.4426950408889634f * bflo(gb.y)); eb[3] = __builtin_amdgcn_exp2f(-1.4426950408889634f * bfhi(gb.y));
#pragma unroll
                            for (int j = 0; j < 4; ++j) v[j] *= (1.0f + eb[j]) * __builtin_amdgcn_rcpf(1.0f + ea[j]);
                            acc[ai][bj][m][n] = v;
                        } else {
#pragma unroll
                            for (int j = 0; j < 4; ++j) v[j] *= __builtin_amdgcn_rcpf(1.0f + ea[j]);
                            u32x2 w; w.x = cvt_pk_bf16(v[0], v[1]); w.y = cvt_pk_bf16(v[2], v[3]); *(u32x2*)(MIXB + (size_t)row * 1024 + col) = w; } } }
    }
};

template <class Epi, class Sched, bool ALIGN_EPI = false, bool SP2 = false>
__device__ __forceinline__ void gemm_phase(PG8_LAS unsigned char* lds, const Gemm g, const Sched& S, const Epi& E, const int wv) {
    int tid_o; asm volatile("v_mbcnt_lo_u32_b32 %0, -1, 0\n\tv_mbcnt_hi_u32_b32 %0, -1, %0\n\tv_lshl_or_b32 %0, %1, 6, %0" : "=&v"(tid_o) : "s"(wv)); const int tid = tid_o, wid = __builtin_amdgcn_readfirstlane(tid >> 6), lane = tid & 63, wr = wid >> 2, wc = wid & 3, fr = lane & 15, fq = lane >> 4;
    const int K = g.K, nt = K / BK;
    unsigned voffA[2], voffB[2];
#pragma unroll
    for (int i = 0; i < 2; ++i) { int R, C; stage_rc(tid * 16 + i * 8192, R, C); const int Rb = Epi::PERM ? ((R & ~31) + perm32(R & 31)) : R;
        voffA[i] = (unsigned)(R * g.lda + C) * 2u; voffB[i] = (unsigned)(Rb * g.ldb + C) * 2u; }
    const size_t kstep = (size_t)(BK * 2);
    const size_t hstepA = (size_t)HALF * g.lda * 2, hstepB = (size_t)HALF * g.ldb * 2;
    const unsigned ldsw = (unsigned)wid * 1024u;
    const int aoff = lds_byte(wr * 64 + fr, fq * 8), boff = lds_byte(wc * 32 + fr, fq * 8);
#define PG8_SA(b, h) (((b) * 2 + (h)) * HTB)
#define PG8_SB(b, h) ((4 + (b) * 2 + (h)) * HTB)
#define PG8_STAGE(bufoff, gbase, voff) do { _Pragma("unroll") for (int _i = 0; _i < 2; ++_i) \
        __builtin_amdgcn_global_load_lds((const unsigned*)((const char*)(gbase) + (voff)[_i]), (PG8_LAS unsigned*)(lds + (bufoff) + ldsw + _i * 8192), 16, 0, 0); } while (0)
#define PG8_LDA(dst, b, h) do { _Pragma("unroll") for (int m = 0; m < 4; ++m) _Pragma("unroll") for (int k = 0; k < 2; ++k) dst[m][k] = *(const PG8_LAS bf16x8*)(lds + PG8_SA(b, h) + aoff + m * 2048 + k * 1024); } while (0)
#define PG8_LDB(dst, b, h) do { _Pragma("unroll") for (int n = 0; n < 2; ++n) _Pragma("unroll") for (int k = 0; k < 2; ++k) dst[n][k] = *(const PG8_LAS bf16x8*)(lds + PG8_SB(b, h) + boff + n * 2048 + k * 1024); } while (0)
#define PG8_MMA(ai, bj, At, Bt) do { __builtin_amdgcn_s_setprio(1); _Pragma("unroll") for (int m = 0; m < 4; ++m) _Pragma("unroll") for (int n = 0; n < 2; ++n) _Pragma("unroll") for (int k = 0; k < 2; ++k) \
        acc[ai][bj][m][n] = __builtin_amdgcn_mfma_f32_16x16x32_bf16(Bt[n][k], At[m][k], acc[ai][bj][m][n], 0, 0, 0); __builtin_amdgcn_s_setprio(0); } while (0)
#define PG8_WAIT_V(n) asm volatile("s_waitcnt vmcnt(" #n ")" ::: "memory")
#define PG8_WAIT_L(n) asm volatile("s_waitcnt lgkmcnt(" #n ")" ::: "memory")
#define PG8_BAR __builtin_amdgcn_s_barrier()
#define PG8_SCHED __builtin_amdgcn_sched_barrier(0)
    Unit cur, nxt; int ui = 0;
    if (!S.next(0, cur)) return;
    f32x4 acc[2][2][4][2];
#pragma unroll
    for (int a = 0; a < 2; ++a)
#pragma unroll
        for (int b = 0; b < 2; ++b)
#pragma unroll
            for (int m = 0; m < 4; ++m)
#pragma unroll
                for (int n = 0; n < 2; ++n) acc[a][b][m][n] = (f32x4){0.f, 0.f, 0.f, 0.f};
    bf16x8 At[4][2], B0[2][2], B1[2][2];
    const char* cA = (const char*)g.A + S.aoff(cur, g); const char* cB = (const char*)g.Bt + S.boff(cur, g);
    S.a_ready(cur);
    typename Epi::State est; E.pre(est, cur, wr);
    if constexpr (SP2) {
        PG8_STAGE(PG8_SB(0, 0), cB, voffB); PG8_STAGE(PG8_SB(0, 1), cB + hstepB, voffB); PG8_STAGE(PG8_SA(0, 0), cA, voffA); PG8_STAGE(PG8_SA(0, 1), cA + hstepA, voffA);
        if (wr == 1) PG8_BAR;
        PG8_WAIT_V(2); PG8_BAR;
        PG8_STAGE(PG8_SB(1, 0), cB + kstep, voffB); PG8_STAGE(PG8_SA(1, 0), cA + kstep, voffA); PG8_STAGE(PG8_SB(1, 1), cB + hstepB + kstep, voffB);
        PG8_WAIT_V(6); PG8_BAR;
    } else {
        PG8_STAGE(PG8_SB(0, 0), cB, voffB); PG8_STAGE(PG8_SA(0, 0), cA, voffA); PG8_STAGE(PG8_SB(0, 1), cB + hstepB, voffB); PG8_STAGE(PG8_SA(0, 1), cA + hstepA, voffA);
        if (wr == 1) PG8_BAR;
        PG8_WAIT_V(4); PG8_BAR;
        PG8_STAGE(PG8_SB(1, 0), cB + kstep, voffB); PG8_STAGE(PG8_SA(1, 0), cA + kstep, voffA); PG8_STAGE(PG8_SB(1, 1), cB + hstepB + kstep, voffB);
        PG8_WAIT_V(6); PG8_BAR;
    }
    for (;;) {
        const bool has_next = S.next(ui + 1, nxt);
        const char* nA = has_next ? (const char*)g.A + S.aoff(nxt, g) : cA; const char* nB = has_next ? (const char*)g.Bt + S.boff(nxt, g) : cB;
        for (int t = 0; t < nt; t += 2) {
            const bool last = (t == nt - 2);
            const char* a1 = cA + (size_t)(t + 1) * kstep;
            const char* a2 = last ? nA : cA + (size_t)(t + 2) * kstep; const char* b2 = last ? nB : cB + (size_t)(t + 2) * kstep;
            const char* a3 = a2 + kstep; const char* b3 = b2 + kstep;
            if (last && has_next) S.a_ready(nxt);
            if constexpr (SP2) {
            PG8_LDB(B0, 0, 0); PG8_LDB(B1, 0, 1); PG8_SCHED; PG8_LDA(At, 0, 0); PG8_STAGE(PG8_SA(1, 1), a1 + hstepA, voffA);
            PG8_WAIT_V(8); PG8_WAIT_L(0); PG8_BAR; PG8_MMA(0, 0, At, B0); PG8_MMA(0, 1, At, B1); PG8_BAR; PG8_SCHED;
            PG8_LDA(At, 0, 1); PG8_STAGE(PG8_SB(0, 0), b2, voffB); PG8_STAGE(PG8_SB(0, 1), b2 + hstepB, voffB); PG8_STAGE(PG8_SA(0, 0), a2, voffA);
            PG8_WAIT_V(8); PG8_WAIT_L(0); PG8_BAR; PG8_MMA(1, 0, At, B0); PG8_MMA(1, 1, At, B1); PG8_BAR; PG8_SCHED;
            PG8_LDB(B0, 1, 0); PG8_LDB(B1, 1, 1); PG8_SCHED; PG8_LDA(At, 1, 0); PG8_STAGE(PG8_SA(0, 1), a2 + hstepA, voffA);
            PG8_WAIT_V(8); PG8_WAIT_L(0); PG8_BAR; PG8_MMA(0, 0, At, B0); PG8_MMA(0, 1, At, B1); PG8_BAR; PG8_SCHED;
            PG8_LDA(At, 1, 1); PG8_STAGE(PG8_SB(1, 0), b3, voffB); PG8_STAGE(PG8_SB(1, 1), b3 + hstepB, voffB); PG8_STAGE(PG8_SA(1, 0), a3, voffA);
            PG8_WAIT_V(8); PG8_WAIT_L(0); PG8_BAR; PG8_MMA(1, 0, At, B0); PG8_MMA(1, 1, At, B1); PG8_BAR; PG8_SCHED;
            } else {
            PG8_LDB(B0, 0, 0); PG8_SCHED; PG8_LDA(At, 0, 0); PG8_STAGE(PG8_SA(1, 1), a1 + hstepA, voffA);
            PG8_WAIT_L(8); PG8_BAR; PG8_WAIT_L(0); PG8_MMA(0, 0, At, B0); PG8_BAR; PG8_SCHED;
            PG8_LDB(B1, 0, 1); PG8_STAGE(PG8_SB(0, 0), b2, voffB);
            PG8_BAR; PG8_WAIT_L(0); PG8_MMA(0, 1, At, B1); PG8_BAR;
            PG8_LDA(At, 0, 1); PG8_STAGE(PG8_SA(0, 0), a2, voffA);
            PG8_BAR; PG8_WAIT_L(0); PG8_MMA(1, 0, At, B0); PG8_BAR; PG8_SCHED;
            PG8_STAGE(PG8_SB(0, 1), b2 + hstepB, voffB);
            PG8_WAIT_V(6); PG8_BAR; PG8_MMA(1, 1, At, B1); PG8_BAR;
            PG8_LDB(B0, 1, 0); PG8_SCHED; PG8_LDA(At, 1, 0); PG8_STAGE(PG8_SA(0, 1), a2 + hstepA, voffA);
            PG8_WAIT_L(8); PG8_BAR; PG8_WAIT_L(0); PG8_MMA(0, 0, At, B0); PG8_BAR; PG8_SCHED;
            PG8_LDB(B1, 1, 1); PG8_STAGE(PG8_SB(1, 0), b3, voffB);
            PG8_BAR; PG8_WAIT_L(0); PG8_MMA(0, 1, At, B1); PG8_BAR;
            PG8_LDA(At, 1, 1); PG8_STAGE(PG8_SA(1, 0), a3, voffA);
            PG8_BAR; PG8_WAIT_L(0); PG8_MMA(1, 0, At, B0); PG8_BAR; PG8_SCHED;
            PG8_STAGE(PG8_SB(1, 1), b3 + hstepB, voffB);
            PG8_WAIT_V(6); PG8_BAR; PG8_MMA(1, 1, At, B1); PG8_BAR;
            }
        }
        if constexpr (ALIGN_EPI) { if (wr == 0) PG8_BAR; }
        if constexpr (!Epi::AFTER_DRAIN) { E(acc, cur, wr, wc, fr, fq, est); S.done(cur); }
        if (!has_next) break;
        bool zacc = true; if constexpr (Epi::KEEP) zacc = E.zero_after(cur);
        if (zacc)
#pragma unroll
        for (int a = 0; a < 2; ++a)
#pragma unroll
            for (int b = 0; b < 2; ++b)
#pragma unroll
                for (int m = 0; m < 4; ++m)
#pragma unroll
                    for (int n = 0; n < 2; ++n) acc[a][b][m][n] = (f32x4){0.f, 0.f, 0.f, 0.f};
        cur = nxt; cA = nA; cB = nB; ++ui; E.pre(est, cur, wr);
        if constexpr (ALIGN_EPI) { if (wr == 1) PG8_BAR; }
    }
    PG8_WAIT_V(0);
    if constexpr (!ALIGN_EPI) { if (wr == 0) PG8_BAR; }
    PG8_BAR;
    if constexpr (Epi::AFTER_DRAIN) { E.fused(acc, cur, wr, wc, fr, fq, lds, wid, lane); S.done(cur); }
#undef PG8_SA
#undef PG8_SB
#undef PG8_STAGE
#undef PG8_LDA
#undef PG8_LDB
#undef PG8_MMA
#undef PG8_WAIT_V
#undef PG8_WAIT_L
#undef PG8_BAR
#undef PG8_SCHED
}
}

#define LAS __attribute__((address_space(3)))
typedef unsigned short bf16;
typedef unsigned v4u __attribute__((ext_vector_type(4)));
typedef unsigned v2u __attribute__((ext_vector_type(2)));
typedef float f32x4 __attribute__((ext_vector_type(4)));
typedef float f32x16 __attribute__((ext_vector_type(16)));
typedef short bf16x8 __attribute__((ext_vector_type(8)));
typedef short s16x4 __attribute__((ext_vector_type(4)));
typedef short v4i16_t __attribute__((ext_vector_type(4)));

constexpr int NWAVES = 8, NTHR = 512;
constexpr int M = 16384, DM = 1024, FF = 2816, DIN = 6752, ZP = 6912, SEQ = 4096, DEPTH = 4;
constexpr float EPS = 1e-6f, LOG2E = 1.4426950408889634f;
constexpr int ZQ_NA = 0, ZK_NA = 512, ZV_NA = 1024, ZGQ = 1536, ZGK = 1792, ZGV = 2048, ZGR = 2560, ZGFL = 3072, ZGBL = 3088, ZCQ = 3104, ZCKV = 3360, ZKR = 3616, ZGATE = 3680;
constexpr size_t MiB = 1u << 20;
constexpr size_t WS_WT = 1 * MiB, WS_XN = 57 * MiB, WS_Z = 89 * MiB, WS_QR = 305 * MiB, WS_KVR = 329 * MiB, WS_KF = 361 * MiB, WS_U = 385 * MiB, WS_DD = 449 * MiB, WS_PS = 450 * MiB, WS_END = 453 * MiB;
constexpr size_t WT_13A = 0, WT_2A = 11534336, WT_IN = 17301504, WT_UQ = 31457280, WT_UKV = 31850496, WT_BR = 32374784, WT_OUT = 35520512, WT_13B = 37617664, WT_2B = 49152000;
constexpr int LDS_BYTES = 135168;

struct Args { const float* in[29]; float* out; unsigned char* ws; };
__device__ __forceinline__ const float* kin(int i) { typedef const __attribute__((address_space(4))) unsigned long long* kp_t; kp_t kp = (kp_t)__builtin_amdgcn_kernarg_segment_ptr(); const unsigned long long v = *(volatile kp_t)(kp + i); return (const float*)(const __attribute__((address_space(1))) float*)v; }

#define LDS_WAIT() asm volatile("s_waitcnt lgkmcnt(0)" ::: "memory")
__device__ __forceinline__ unsigned pk2(float lo, float hi) { return pg8::cvt_pk_bf16(lo, hi); }
__device__ __forceinline__ float bf2f(bf16 h) { return __builtin_bit_cast(float, (unsigned)h << 16); }
__device__ __forceinline__ bf16 f2bf(float f) { return (bf16)(pk2(f, 0.f) & 0xffffu); }
__device__ __forceinline__ float wave_sum(float v, int lane) {
#pragma unroll
    for (int o = 1; o < 64; o <<= 1) v += pg8::sx(v, o, lane);
    return v;
}
__device__ __forceinline__ int opaque_tid_w(int wv) { int t; asm volatile("v_mbcnt_lo_u32_b32 %0, -1, 0\n\tv_mbcnt_hi_u32_b32 %0, -1, %0\n\tv_lshl_or_b32 %0, %1, 6, %0" : "=&v"(t) : "s"(wv)); return t; }
__device__ __forceinline__ int opaque_s(int v) { asm volatile("" : "+s"(v)); return v; }
__device__ __forceinline__ int crow(int r, int hi) { return (r & 3) + 8 * (r >> 2) + 4 * hi; }
__device__ __forceinline__ s16x4 vtr(const LAS char* p) { return __builtin_bit_cast(s16x4, __builtin_amdgcn_ds_read_tr16_b64_v4i16((LAS v4i16_t*)p)); }
__device__ __forceinline__ bf16x8 tr_frag(const LAS char* p0, const LAS char* p1) { const s16x4 a = vtr(p0), b = vtr(p1); return (bf16x8){a[0], a[1], a[2], a[3], b[0], b[1], b[2], b[3]}; }
__device__ __forceinline__ bf16x8 pack8(float a0, float a1, float a2, float a3, float a4, float a5, float a6, float a7) {
    v4u w; w.x = pk2(a0, a1); w.y = pk2(a2, a3); w.z = pk2(a4, a5); w.w = pk2(a6, a7); return __builtin_bit_cast(bf16x8, w);
}
#define MFMA32(a, b, c) __builtin_amdgcn_mfma_f32_32x32x16_bf16((a), (b), (c), 0, 0, 0)
#define MFMA16(a, b, c) __builtin_amdgcn_mfma_f32_16x16x32_bf16((a), (b), (c), 0, 0, 0)

#define XB_TMO      128
#define XB_XCNT(j)  (256  + 64 * (j))
#define XB_XSUB(j)  (1280 + 64 * (j))
#define XB_XGEN(j)  (2304 + 64 * (j))
#define XB_TOP      3328
#define XB_TOPGEN   3392
#define XCD_BAR_WORDS 3456
#define XB_SPIN_CAP (1u << 18)

__device__ __forceinline__ unsigned xb_ld(unsigned* p)              { return __hip_atomic_load(p, __ATOMIC_RELAXED, __HIP_MEMORY_SCOPE_AGENT); }
__device__ __forceinline__ unsigned xb_add(unsigned* p, unsigned v) { return __hip_atomic_fetch_add(p, v, __ATOMIC_RELAXED, __HIP_MEMORY_SCOPE_AGENT); }
__device__ __forceinline__ unsigned xb_xcc_id() { return (unsigned)__builtin_amdgcn_s_getreg((3 << 11) | 20) & 0xFu; }
#define XB_SPIN(cond, bar) do { unsigned _sp = 0; while (cond) { __builtin_amdgcn_s_sleep(1); \
    if ((++_sp & 255u) == 0u) { if (xb_ld(&(bar)[XB_TMO])) break; if (_sp > XB_SPIN_CAP) { atomicAdd(&(bar)[XB_TMO], 1u); break; } } } } while (0)

struct XcdBarrier {
    unsigned* bar; unsigned x;
    volatile LAS unsigned* st;
};

__device__ __forceinline__ XcdBarrier xcd_barrier_post(unsigned* bar, volatile LAS unsigned* st) {
    XcdBarrier b; b.bar = bar; b.x = xb_xcc_id(); b.st = st;
    if (threadIdx.x == 0) (void)xb_add(&bar[XB_XCNT(b.x)], 1u);
    return b;
}
__device__ __forceinline__ void xcd_barrier_complete(unsigned* bar, unsigned x, unsigned& nloc, unsigned& nx) {
    const unsigned G = gridDim.x * gridDim.y * gridDim.z;
    unsigned sum, cnt, mine, sp = 0u;
    for (;;) {
        sum = 0u; cnt = 0u; mine = 0u;
#pragma unroll
        for (unsigned j = 0; j < 16; ++j) { const unsigned c = xb_ld(&bar[XB_XCNT(j)]); sum += c; cnt += (c > 0u) ? 1u : 0u; mine = (j == x) ? c : mine; }
        if (sum == G) break;
        __builtin_amdgcn_s_sleep(1);
        if ((++sp & 255u) == 0u) { if (xb_ld(&bar[XB_TMO])) break; if (sp > XB_SPIN_CAP) { atomicAdd(&bar[XB_TMO], 1u); break; } }
    }
    nloc = mine > 0u ? mine : 1u; nx = cnt > 0u ? cnt : 1u;
}

__device__ __forceinline__ void xcd_barrier(const XcdBarrier& b, const bool leader) {
    asm volatile("s_waitcnt vmcnt(0)" ::: "memory");
    __syncthreads();
    if (leader) {
        unsigned* bar = b.bar;
        __builtin_amdgcn_s_waitcnt(0);
        unsigned nloc = b.st[0], nx = b.st[1];
        if (nloc == 0u) { xcd_barrier_complete(bar, b.x, nloc, nx); b.st[0] = nloc; b.st[1] = nx; }
        const unsigned old = xb_add(&bar[XB_XSUB(b.x)], 1u);
        const unsigned gen = old / nloc;
        if (old + 1u == (gen + 1u) * nloc) {
            __builtin_amdgcn_fence(__ATOMIC_RELEASE, "agent");
            asm volatile("s_waitcnt vmcnt(0)" ::: "memory");
            const unsigned og = xb_add(&bar[XB_TOP], 1u);
            const unsigned tg = og / nx;
            if (og + 1u == (tg + 1u) * nx) xb_add(&bar[XB_TOPGEN], 1u);
            else XB_SPIN(xb_ld(&bar[XB_TOPGEN]) == tg, bar);
            __builtin_amdgcn_fence(__ATOMIC_ACQUIRE, "agent");
            xb_add(&bar[XB_XGEN(b.x)], 1u);
            asm volatile("s_waitcnt vmcnt(0)" ::: "memory");
        } else {
            XB_SPIN(xb_ld(&bar[XB_XGEN(b.x)]) == gen, bar);
            __builtin_amdgcn_fence(__ATOMIC_ACQUIRE, "agent");
            asm volatile("s_waitcnt vmcnt(0)" ::: "memory");
        }
    }
    __syncthreads();
}

__device__ __forceinline__ void tr_item(const float* __restrict__ W, int K, int N, bf16* WT, int k0, int n0, int drow0, LAS float* scr, int lane, const float* g) {
    f32x4 wv4[8];
#pragma unroll
    for (int i = 0; i < 8; ++i) wv4[i] = __builtin_nontemporal_load((const f32x4*)(W + (size_t)(k0 + (lane >> 3) + 8 * i) * N + n0 + 4 * (lane & 7)));
#pragma unroll
    for (int i = 0; i < 8; ++i) { LAS float* d = scr + ((lane >> 3) + 8 * i) * 33 + 4 * (lane & 7); d[0] = wv4[i].x; d[1] = wv4[i].y; d[2] = wv4[i].z; d[3] = wv4[i].w; }
    LDS_WAIT();
    const int c = lane & 7;
    f32x4 ga = {1.f, 1.f, 1.f, 1.f}, gb = ga;
    if (g) { ga = *(const f32x4*)(g + k0 + 8 * c); gb = *(const f32x4*)(g + k0 + 8 * c + 4); }
#pragma unroll
    for (int j = 0; j < 4; ++j) { const int n = (lane >> 3) + 8 * j; const LAS float* s = scr + (8 * c) * 33 + n;
        v4u o; o.x = pk2(s[0 * 33] * ga[0], s[1 * 33] * ga[1]); o.y = pk2(s[2 * 33] * ga[2], s[3 * 33] * ga[3]); o.z = pk2(s[4 * 33] * gb[0], s[5 * 33] * gb[1]); o.w = pk2(s[6 * 33] * gb[2], s[7 * 33] * gb[3]);
        *(v4u*)(WT + (size_t)(drow0 + n) * K + k0 + 8 * c) = o; }
    LDS_WAIT();
}
struct MatDesc { const float* W; bf16* WT; const float* g; int K, N, mode, roff; };
__device__ __forceinline__ MatDesc mat_desc(int idx, int l, const Args& a, unsigned char* wt) {
    MatDesc d; d.mode = 0; d.roff = 0; d.g = nullptr;
    switch (idx) {
    case 0:  d.W = kin(2) + (size_t)l * DM * FF;  d.WT = (bf16*)(wt + WT_13A); d.K = DM; d.N = FF; d.mode = 1; d.roff = 0; d.g = kin(1) + l * DM; break;
    case 1:  d.W = kin(3) + (size_t)l * DM * FF;  d.WT = (bf16*)(wt + WT_13A); d.K = DM; d.N = FF; d.mode = 1; d.roff = 1; d.g = kin(1) + l * DM; break;
    case 2:  d.W = kin(4) + (size_t)l * FF * DM;  d.WT = (bf16*)(wt + WT_2A);  d.K = FF; d.N = DM; break;
    case 3:  d.W = kin(6) + (size_t)l * DM * DIN; d.WT = (bf16*)(wt + WT_IN);  d.K = DM; d.N = DIN; d.g = kin(5) + l * DM; break;
    case 4:  d.W = kin(17) + (size_t)l * 256 * 768;  d.WT = (bf16*)(wt + WT_UQ);  d.K = 256; d.N = 768; break;
    case 5:  d.W = kin(18) + (size_t)l * 256 * 1024; d.WT = (bf16*)(wt + WT_UKV); d.K = 256; d.N = 1024; break;
    case 6:  d.W = kin(21) + (size_t)l * 512 * 1024; d.WT = (bf16*)(wt + WT_BR);  d.K = 512; d.N = 1024; d.roff = 0; break;
    case 7:  d.W = kin(22) + (size_t)l * 512 * 1024; d.WT = (bf16*)(wt + WT_BR);  d.K = 512; d.N = 1024; d.roff = 1024; break;
    case 8:  d.W = kin(23) + (size_t)l * 512 * 1024; d.WT = (bf16*)(wt + WT_BR);  d.K = 512; d.N = 1024; d.roff = 2048; break;
    case 9:  d.W = kin(24) + (size_t)l * DM * DM;  d.WT = (bf16*)(wt + WT_OUT); d.K = DM; d.N = DM; break;
    case 10: d.W = kin(26) + (size_t)l * DM * FF;  d.WT = (bf16*)(wt + WT_13B); d.K = DM; d.N = FF; d.mode = 1; d.roff = 0; d.g = kin(25) + l * DM; break;
    case 11: d.W = kin(27) + (size_t)l * DM * FF;  d.WT = (bf16*)(wt + WT_13B); d.K = DM; d.N = FF; d.mode = 1; d.roff = 1; d.g = kin(25) + l * DM; break;
    default: d.W = kin(28) + (size_t)l * FF * DM;  d.WT = (bf16*)(wt + WT_2B);  d.K = FF; d.N = DM; break;
    }
    return d;
}
__device__ __forceinline__ void convert_set(const Args& a, int l, LAS unsigned char* lds, const int wv, const unsigned mask, const int pw, const int np, const bool do_pad) {
    const int tid = opaque_tid_w(wv), lane = tid & 63, wave = __builtin_amdgcn_readfirstlane(tid >> 6), gtid = blockIdx.x * NTHR + tid, gthreads = gridDim.x * NTHR;
    unsigned char* wt = ((unsigned char*)kin(30)) + WS_WT;
    LAS float* scr = (LAS float*)(lds + wave * 8704);
    int it = pw;
    for (int mi = 0; mi < 13; ++mi) {
        if (!((mask >> mi) & 1u)) continue;
        const MatDesc d = mat_desc(mi, l, a, wt);
        const int nblk = d.N / 32, cnt = (d.K / 64) * nblk;
        for (; it < cnt; it += np) {
            const int kb = it / nblk, nb = it - kb * nblk, n0 = 32 * nb;
            const int drow0 = d.mode ? (256 * (n0 >> 7) + 128 * d.roff + (n0 & 127)) : (d.roff + n0);
            tr_item(d.W, d.K, d.N, d.WT, 64 * kb, n0, drow0, scr, lane, d.g);
        }
        it -= cnt;
    }
    if (do_pad) {
        v4u* pad = (v4u*)(wt + WT_IN + (size_t)DIN * DM * 2);
        const int npad = (ZP - DIN) * DM * 2 / 16;
        unsigned zz = 0u; asm volatile("" : "+v"(zz));
        for (int i = gtid; i < npad; i += gthreads) pad[i] = (v4u){zz, zz, zz, zz};
    }
}
__device__ __forceinline__ void convert_tail(const Args& a, int l, LAS unsigned char* lds, const int wv, const unsigned mask, const int nwg) {
    const int G = gridDim.x, bx = opaque_s(blockIdx.x), rem = nwg % G;
    if (rem != 0 && bx < rem) return;
    const int pw = (rem == 0 ? bx : bx - rem) * NWAVES + wv, np = (rem == 0 ? G : G - rem) * NWAVES;
    convert_set(a, l, lds, wv, mask, pw, np, false);
}
__device__ __forceinline__ void xprep_phase(const float* x, bf16* XB, unsigned* SS, const int wv) {
    const int tid = opaque_tid_w(wv), lane = tid & 63, wave = __builtin_amdgcn_readfirstlane(tid >> 6), gw = blockIdx.x * NWAVES + wave, NGW = gridDim.x * NWAVES;
    for (int m = gw; m < M; m += NGW) {
        const f32x4* xr = (const f32x4*)(x + (size_t)m * DM) + lane;
        f32x4 v[4]; float s = 0.f;
#pragma unroll
        for (int j = 0; j < 4; ++j) { v[j] = xr[64 * j]; s += (v[j].x * v[j].x + v[j].y * v[j].y) + (v[j].z * v[j].z + v[j].w * v[j].w); }
        s = wave_sum(s, lane); if (lane == 0) __hip_atomic_store(SS + m, (unsigned)(s * 4096.0f + 0.5f), __ATOMIC_RELAXED, __HIP_MEMORY_SCOPE_AGENT);
        v2u* o = (v2u*)(XB + (size_t)m * DM) + lane;
#pragma unroll
        for (int j = 0; j < 4; ++j) { v2u w; w.x = pk2(v[j].x, v[j].y); w.y = pk2(v[j].z, v[j].w); o[64 * j] = w; }
    }
}
__device__ __forceinline__ void token_prep_phase(const Args& a, int l, bf16* Z, const int wv) {
    const int tid = opaque_tid_w(wv), lane = tid & 63, wave = __builtin_amdgcn_readfirstlane(tid >> 6), gw = blockIdx.x * NWAVES + wave, NGW = gridDim.x * NWAVES;
    const float* gna = (lane < 32 ? kin(7) : kin(8)) + l * 64 + ((16 * lane) & 63);
    const float* gc = (lane < 32 ? kin(15) : kin(16)) + l * 256 + ((8 * lane) & 255);
    float g1[16], g2[8];
#pragma unroll
    for (int j = 0; j < 16; ++j) g1[j] = gna[j] * (lane < 32 ? 0.125f * LOG2E : 1.0f);
#pragma unroll
    for (int j = 0; j < 8; ++j) g2[j] = gc[j];
    for (int m0 = gw; m0 < M; m0 += 4 * NGW) {
        v4u w0[4], w1[4], wc_[4];
#pragma unroll
        for (int t = 0; t < 4; ++t) { const bf16* zr = Z + (size_t)(m0 + t * NGW) * ZP; w0[t] = *(const v4u*)(zr + 16 * lane); w1[t] = *(const v4u*)(zr + 16 * lane + 8); wc_[t] = *(const v4u*)(zr + ZCQ + 8 * lane); }
#pragma unroll
        for (int t = 0; t < 4; ++t) { bf16* zr = Z + (size_t)(m0 + t * NGW) * ZP;
        { float v[16]; const unsigned ww[8] = {w0[t].x, w0[t].y, w0[t].z, w0[t].w, w1[t].x, w1[t].y, w1[t].z, w1[t].w};
          float ss = 0.f;
#pragma unroll
          for (int j = 0; j < 8; ++j) { v[2 * j] = pg8::bflo(ww[j]); v[2 * j + 1] = pg8::bfhi(ww[j]); ss += v[2 * j] * v[2 * j] + v[2 * j + 1] * v[2 * j + 1]; }
          ss += pg8::sx(ss, 1, lane); ss += pg8::sx(ss, 2, lane);
          const float r = 1.0f / sqrtf(ss * (1.0f / 64.0f) + EPS);
          v4u o0, o1;
          o0.x = pk2(v[0] * r * g1[0], v[1] * r * g1[1]); o0.y = pk2(v[2] * r * g1[2], v[3] * r * g1[3]); o0.z = pk2(v[4] * r * g1[4], v[5] * r * g1[5]); o0.w = pk2(v[6] * r * g1[6], v[7] * r * g1[7]);
          o1.x = pk2(v[8] * r * g1[8], v[9] * r * g1[9]); o1.y = pk2(v[10] * r * g1[10], v[11] * r * g1[11]); o1.z = pk2(v[12] * r * g1[12], v[13] * r * g1[13]); o1.w = pk2(v[14] * r * g1[14], v[15] * r * g1[15]);
          *(v4u*)(zr + 16 * lane) = o0; *(v4u*)(zr + 16 * lane + 8) = o1; }
        { float v[8]; const unsigned ww[4] = {wc_[t].x, wc_[t].y, wc_[t].z, wc_[t].w}; float ss = 0.f;
#pragma unroll
          for (int j = 0; j < 4; ++j) { v[2 * j] = pg8::bflo(ww[j]); v[2 * j + 1] = pg8::bfhi(ww[j]); ss += v[2 * j] * v[2 * j] + v[2 * j + 1] * v[2 * j + 1]; }
#pragma unroll
          for (int o = 1; o < 32; o <<= 1) ss += pg8::sx(ss, o, lane);
          const float r = 1.0f / sqrtf(ss * (1.0f / 256.0f) + EPS);
          v4u o; o.x = pk2(v[0] * r * g2[0], v[1] * r * g2[1]); o.y = pk2(v[2] * r * g2[2], v[3] * r * g2[3]); o.z = pk2(v[4] * r * g2[4], v[5] * r * g2[5]); o.w = pk2(v[6] * r * g2[6], v[7] * r * g2[7]);
          *(v4u*)(zr + ZCQ + 8 * lane) = o; } }
    }
}

constexpr int GP = 144;
constexpr int GL_QF = 0, GL_QB = 9216, GL_KF = 18432, GL_KB = 27648, GL_A = 36864  , GL_V = 55296  , GL_G = 73728;
constexpr int GL_BF = GL_G, GL_BB = GL_G + 16640, GL_GLF = GL_G + 33280, GL_GLB = GL_G + 37376, BP = 65;
constexpr int GL_S = GL_G;
constexpr int GL_O = 0;
__device__ __forceinline__ float log_sigmoid(float x) { return fminf(x, 0.f) - 0.6931471805599453f * __builtin_amdgcn_logf(1.0f + __builtin_amdgcn_exp2f(-1.4426950408889634f * fabsf(x))); }

__device__ __forceinline__ void gla_item(const Args& a, int l, int mode, int b, int h, int c, bf16* Z, float* U, const bf16* SP, float* Dd, LAS unsigned char* lds_u, const int wv) {
    LAS char* lds = (LAS char*)lds_u;
    const int tid = opaque_tid_w(wv), lane = tid & 63, wave = __builtin_amdgcn_readfirstlane(tid >> 6), r32 = lane & 31, hi = lane >> 5, i16 = lane & 15, blk = (lane >> 4) & 1;
    const int bh = b * 4 + h; const size_t tok0 = (size_t)b * SEQ + 64 * c;
    LAS float* sBf = (LAS float*)(lds + GL_BF); LAS float* sBb = (LAS float*)(lds + GL_BB); LAS float* sGlf = (LAS float*)(lds + GL_GLF); LAS float* sGlb = (LAS float*)(lds + GL_GLB);
    for (int idx = tid; idx < 2048; idx += NTHR) { const int dx = idx >> 10, t = (idx >> 4) & 63, r = idx & 15;
        const float v = bf2f(Z[(tok0 + t) * ZP + (dx ? ZGBL : ZGFL) + r]); (dx ? sGlb : sGlf)[t * 16 + r] = v; }
#pragma unroll
    for (int i = 0; i < 2; ++i) { const int idx = tid + NTHR * i, t = idx >> 4, ch = idx & 15;
        *(LAS v4u*)(lds + GL_V + t * 288 + ch * 16) = *(const v4u*)(Z + (tok0 + t) * ZP + ZGV + 128 * h + 8 * ch); }
    const int j = tid & 63, tg = tid >> 6;
    float upf[16], upb[16];
    { const float* pf = kin(10) + (size_t)l * 16 * 256 + 64 * h + j; const float* pb = kin(12) + (size_t)l * 16 * 256 + 64 * h + j;
#pragma unroll
      for (int r = 0; r < 16; ++r) { upf[r] = pf[r * 256]; upb[r] = pb[r * 256]; } }
    const float biasf = kin(11)[l * 256 + 64 * h + j], biasb = kin(13)[l * 256 + 64 * h + j];
    bf16 qraw[8], kraw[8];
#pragma unroll
    for (int i = 0; i < 8; ++i) { const int t = tg + 8 * i; qraw[i] = Z[(tok0 + t) * ZP + ZGQ + 64 * h + j]; kraw[i] = Z[(tok0 + t) * ZP + ZGK + 64 * h + j]; }
    __syncthreads();
#pragma unroll
    for (int i = 0; i < 8; ++i) { const int t = tg + 8 * i; float lf = biasf, lb = biasb;
#pragma unroll
        for (int r = 0; r < 16; ++r) { lf += sGlf[t * 16 + r] * upf[r]; lb += sGlb[t * 16 + r] * upb[r]; }
        sBf[t * BP + j] = log_sigmoid(lf) * (1.0f / 16.0f); sBb[t * BP + j] = log_sigmoid(lb) * (1.0f / 16.0f); }
    __syncthreads();
    { LAS float* sB = (wave < 4) ? sBf : sBb; const int jb = (wave & 3) * 16;
      float x[16];
#pragma unroll
      for (int cc = 0; cc < 16; ++cc) x[cc] = sB[lane * BP + jb + cc];
#pragma unroll
      for (int d = 1; d < 64; d <<= 1) {
#pragma unroll
          for (int cc = 0; cc < 16; ++cc) { const float y = __builtin_bit_cast(float, __builtin_amdgcn_ds_bpermute(((wave < 4) ? (lane - d) : (lane + d)) << 2, __builtin_bit_cast(int, x[cc]))); const bool ok = (wave < 4) ? (lane >= d) : (lane + d < 64); x[cc] += ok ? y : 0.f; } }
#pragma unroll
      for (int cc = 0; cc < 16; ++cc) sB[lane * BP + jb + cc] = x[cc]; }
    __syncthreads();
    { const float bl = sBf[63 * BP + j], bs0 = sBb[j];
#pragma unroll
      for (int i = 0; i < 8; ++i) { const int t = tg + 8 * i;
          const float q = bf2f(qraw[i]) * 0.125f, k = bf2f(kraw[i]);
          const float bf = sBf[t * BP + j], bs = sBb[t * BP + j];
          if (mode == 1) {
              *(LAS bf16*)(lds + GL_QF + t * GP + j * 2) = f2bf(q * __expf(bf)); *(LAS bf16*)(lds + GL_KF + t * GP + j * 2) = f2bf(k * __expf(-bf));
              *(LAS bf16*)(lds + GL_QB + t * GP + j * 2) = f2bf(q * __expf(bs)); *(LAS bf16*)(lds + GL_KB + t * GP + j * 2) = f2bf(k * __expf(-bs));
          } else {
              *(LAS bf16*)(lds + GL_A + j * GP + t * 2) = f2bf(k * __expf(bl - bf)); *(LAS bf16*)(lds + GL_A + 9216 + j * GP + t * 2) = f2bf(k * __expf(bs0 - bs));
          } }
      if (mode == 0 && tg == 0) { Dd[((size_t)(0 * 16 + bh) * 64 + c) * 64 + j] = __expf(bl); Dd[((size_t)(1 * 16 + bh) * 64 + c) * 64 + j] = __expf(bs0); } }
    __syncthreads();
    if (mode == 0) {
        const int dir = wave >> 2, dvt = wave & 3;
        float* Ub = U + ((size_t)(dir * 16 + bh) * 64 + c) * 8192;
#pragma unroll
        for (int dkt = 0; dkt < 2; ++dkt) { f32x16 acc = {};
#pragma unroll
            for (int s = 0; s < 4; ++s) {
                const bf16x8 A = *(const LAS bf16x8*)(lds + GL_A + dir * 9216 + (32 * dkt + r32) * GP + (16 * s + 8 * hi) * 2);
                const LAS char* vp = lds + GL_V + (16 * s + 8 * hi + (i16 >> 2)) * 288 + (32 * dvt + 16 * blk + 4 * (i16 & 3)) * 2;
                const bf16x8 B = tr_frag(vp, vp + 4 * 288);
                acc = MFMA32(A, B, acc); }
#pragma unroll
            for (int r = 0; r < 16; ++r) Ub[(32 * dkt + crow(r, hi)) * 128 + 32 * dvt + r32] = acc[r]; }
        __syncthreads();
        return;
    }
    { const int dir = wave >> 2, ti = (wave >> 1) & 1, tj = wave & 1; f32x16 acc = {};
      const int qo = dir ? GL_QB : GL_QF, ko = dir ? GL_KB : GL_KF;
#pragma unroll
      for (int s = 0; s < 4; ++s) {
          const bf16x8 A = *(const LAS bf16x8*)(lds + qo + (32 * ti + r32) * GP + (16 * s + 8 * hi) * 2);
          const bf16x8 B = *(const LAS bf16x8*)(lds + ko + (32 * tj + r32) * GP + (16 * s + 8 * hi) * 2);
          acc = MFMA32(A, B, acc); }
      const int jj = 32 * tj + r32;
#pragma unroll
      for (int r = 0; r < 16; ++r) { const int ii = 32 * ti + crow(r, hi); const bool keep = dir ? (jj > ii) : (jj <= ii);
          *(LAS bf16*)(lds + GL_A + dir * 9216 + ii * GP + jj * 2) = f2bf(keep ? acc[r] : 0.f); } }
#pragma unroll
    for (int i = 0; i < 4; ++i) { const int idx = tid + NTHR * i, dir = idx >> 10, e8 = idx & 1023, dk = e8 >> 4, c8 = e8 & 15;
        *(LAS v4u*)(lds + GL_S + dir * 18432 + dk * 288 + c8 * 16) = *(const v4u*)(SP + ((size_t)(dir * 16 + bh) * 64 + c) * 8192 + dk * 128 + 8 * c8); }
    __syncthreads();
    f32x16 oacc = {};
    const int ti = wave >> 2, dvt = wave & 3;
#pragma unroll
    for (int dir = 0; dir < 2; ++dir) {
        const int qo = dir ? GL_QB : GL_QF;
#pragma unroll
        for (int s = 0; s < 4; ++s) {
            const bf16x8 A1 = *(const LAS bf16x8*)(lds + GL_A + dir * 9216 + (32 * ti + r32) * GP + (16 * s + 8 * hi) * 2);
            const LAS char* vp = lds + GL_V + (16 * s + 8 * hi + (i16 >> 2)) * 288 + (32 * dvt + 16 * blk + 4 * (i16 & 3)) * 2;
            oacc = MFMA32(A1, tr_frag(vp, vp + 4 * 288), oacc);
            const bf16x8 A2 = *(const LAS bf16x8*)(lds + qo + (32 * ti + r32) * GP + (16 * s + 8 * hi) * 2);
            const LAS char* sp = lds + GL_S + dir * 18432 + (16 * s + 8 * hi + (i16 >> 2)) * 288 + (32 * dvt + 16 * blk + 4 * (i16 & 3)) * 2;
            oacc = MFMA32(A2, tr_frag(sp, sp + 4 * 288), oacc); } }
    __syncthreads();
#pragma unroll
    for (int r = 0; r < 16; ++r) *(LAS float*)(lds + GL_O + ((32 * ti + crow(r, hi)) * 132 + 32 * dvt + r32) * 4) = oacc[r];
    __syncthreads();
    { const int row = tid >> 3, seg = tid & 7; float v[16]; float ss = 0.f;
#pragma unroll
      for (int q4 = 0; q4 < 4; ++q4) { const f32x4 t = *(const LAS f32x4*)(lds + GL_O + (row * 132 + 16 * seg + 4 * q4) * 4); v[4 * q4] = t.x; v[4 * q4 + 1] = t.y; v[4 * q4 + 2] = t.z; v[4 * q4 + 3] = t.w; }
#pragma unroll
      for (int q = 0; q < 16; ++q) ss += v[q] * v[q];
      ss += pg8::sx(ss, 1, lane); ss += pg8::sx(ss, 2, lane); ss += pg8::sx(ss, 4, lane);
      const float rr = 1.0f / sqrtf(ss * (1.0f / 128.0f) + EPS);
      bf16* zr = Z + (tok0 + row) * ZP;
      const v4u g0 = *(const v4u*)(zr + ZGR + 128 * h + 16 * seg), g1 = *(const v4u*)(zr + ZGR + 128 * h + 16 * seg + 8);
      const unsigned gw_[8] = {g0.x, g0.y, g0.z, g0.w, g1.x, g1.y, g1.z, g1.w};
      const float* gn = kin(14) + l * 128 + 16 * seg;
      unsigned ow[8];
#pragma unroll
      for (int q = 0; q < 8; ++q) { const float ga = pg8::bflo(gw_[q]), gb = pg8::bfhi(gw_[q]);
          const float ya = (v[2 * q] * rr * gn[2 * q]) * (ga * pg8::fsigmoid(ga)), yb = (v[2 * q + 1] * rr * gn[2 * q + 1]) * (gb * pg8::fsigmoid(gb));
          ow[q] = pk2(ya, yb); }
      *(v4u*)(zr + ZGV + 128 * h + 16 * seg) = (v4u){ow[0], ow[1], ow[2], ow[3]}; *(v4u*)(zr + ZGV + 128 * h + 16 * seg + 8) = (v4u){ow[4], ow[5], ow[6], ow[7]}; }
    __syncthreads();
}
__device__ __forceinline__ void gla_scan_phase(const float* U, bf16* SP, const float* Dd, const int wv) {
    const int gtid = blockIdx.x * NTHR + opaque_tid_w(wv), gthreads = gridDim.x * NTHR;
    for (int ch = gtid; ch < 2 * 16 * 4096; ch += gthreads) {
        const int e = ch & 4095, db = ch >> 12, dir = db >> 4;
        const float* Ub = U + (size_t)db * 64 * 8192 + 2 * e; unsigned* Sb = (unsigned*)SP + (size_t)db * 64 * 4096 + e; const float* Db = Dd + (size_t)db * 64 * 64 + (e >> 6);
        float s0 = 0.f, s1 = 0.f;
        for (int cc = 0; cc < 64; cc += 16) { float u0[16], u1[16], d[16];
#pragma unroll
            for (int k = 0; k < 16; ++k) { const int c = dir ? 63 - (cc + k) : cc + k; const float* p = Ub + (size_t)c * 8192; u0[k] = p[0]; u1[k] = p[1]; d[k] = Db[c * 64]; }
#pragma unroll
            for (int k = 0; k < 16; ++k) { const int c = dir ? 63 - (cc + k) : cc + k; Sb[(size_t)c * 4096] = pk2(s0, s1); s0 = d[k] * s0 + u0[k]; s1 = d[k] * s1 + u1[k]; } }
    }
}

__device__ __forceinline__ void na_phase(const Args& a, int l, bf16* Z, LAS unsigned char* lds_u, bf16* O, int OP, const int wv) {
    const int tid = opaque_tid_w(wv), lane = tid & 63, wave = __builtin_amdgcn_readfirstlane(tid >> 6), NGW = gridDim.x * NWAVES;
    const int bxs = opaque_s(blockIdx.x), Gs = gridDim.x, vcu = (Gs % 8 == 0) ? (bxs % 8) * (Gs / 8) + bxs / 8 : bxs, gw = vcu * NWAVES + wave;
    LAS char* wvl = (LAS char*)lds_u + wave * 16384;
    const int l15 = lane & 15, quad = lane >> 4;
    for (int it = gw; it < 8192; it += NGW) {
        const int j = it & 3, r = (it >> 2) & 63, h = (it >> 8) & 7, b = it >> 11;
        const int r0 = min(max(r - 4, 0), 56), k0 = min(max(16 * j - 8, 0), 32);
        const size_t tq = (size_t)b * SEQ + r * 64 + 16 * j + l15;
        const bf16* qp = Z + tq * ZP + ZQ_NA + 64 * h + 8 * quad;
        const bf16x8 qf0 = *(const bf16x8*)qp, qf1 = *(const bf16x8*)(qp + 32);
        f32x4 s[16];
#pragma unroll
        for (int kt = 0; kt < 16; ++kt) { const size_t tk = (size_t)b * SEQ + (r0 + (kt >> 1)) * 64 + k0 + 16 * (kt & 1) + l15;
            const bf16* kp = Z + tk * ZP + ZK_NA + 64 * h + 8 * quad;
            const bf16x8 kf0 = *(const bf16x8*)kp, kf1 = *(const bf16x8*)(kp + 32);
            f32x4 acc = {0.f, 0.f, 0.f, 0.f}; acc = MFMA16(kf0, qf0, acc); acc = MFMA16(kf1, qf1, acc); s[kt] = acc; if ((kt & 7) == 7) asm volatile("" ::: "memory"); }
        v4u vreg[16];
#pragma unroll
        for (int i = 0; i < 16; ++i) { const int id = lane + 64 * i, tl = id >> 3, ch = id & 7;
            const size_t tk = (size_t)b * SEQ + (r0 + (tl >> 5)) * 64 + k0 + (tl & 31); vreg[i] = *(const v4u*)(Z + tk * ZP + ZV_NA + 64 * h + 8 * ch); }
        const int qc = 16 * j + l15, c0 = min(max(qc - 8, 0), 48);
        const float* rp = kin(9) + (size_t)((l * 8 + h) * 15) * 31;
        float mx = -1e30f;
#pragma unroll
        for (int kt = 0; kt < 16; ++kt)
#pragma unroll
            for (int i = 0; i < 4; ++i) { const int kc = k0 + 16 * (kt & 1) + 4 * quad + i, kr = r0 + (kt >> 1), dr = kr - r + 7, dc = min(max(kc - qc + 15, 0), 30);
                const bool ok = (kc >= c0) && (kc < c0 + 16);
                const float v = ok ? s[kt][i] + rp[dr * 31 + dc] * LOG2E : -1e30f; s[kt][i] = v; mx = fmaxf(mx, v); }
        mx = fmaxf(mx, pg8::sx(mx, 16, lane)); mx = fmaxf(mx, pg8::sx(mx, 32, lane));
        float lsum = 0.f;
#pragma unroll
        for (int kt = 0; kt < 16; ++kt)
#pragma unroll
            for (int i = 0; i < 4; ++i) { const float p = __builtin_amdgcn_exp2f(s[kt][i] - mx); s[kt][i] = p; lsum += p; }
        lsum += pg8::sx(lsum, 16, lane); lsum += pg8::sx(lsum, 32, lane);
        const float inv = 1.0f / lsum;
        f32x4 o[4];
#pragma unroll
        for (int c = 0; c < 4; ++c) o[c] = (f32x4){0.f, 0.f, 0.f, 0.f};
#define NA_LOADV(half) do { _Pragma("unroll") for (int i = 0; i < 16; ++i) { const int id = lane + 64 * i, tl = id >> 3, ch = id & 7; \
            const size_t tk = (size_t)b * SEQ + (r0 + 4 * (half) + (tl >> 5)) * 64 + k0 + (tl & 31); vreg[i] = *(const v4u*)(Z + tk * ZP + ZV_NA + 64 * h + 8 * ch); } } while (0)
#define NA_STOREV() do { _Pragma("unroll") for (int i = 0; i < 16; ++i) { const int id = lane + 64 * i, tl = id >> 3, ch = id & 7; *(LAS v4u*)(wvl + tl * 128 + ch * 16) = vreg[i]; } } while (0)
#pragma unroll
        for (int half = 0; half < 2; ++half) {
            LDS_WAIT();
            NA_STOREV();
            if (half == 0) NA_LOADV(1);
            LDS_WAIT();
#pragma unroll
            for (int s4 = 0; s4 < 4; ++s4) { const int sw = 4 * half + s4;
                const bf16x8 pf = pack8(s[2 * sw][0], s[2 * sw][1], s[2 * sw][2], s[2 * sw][3], s[2 * sw + 1][0], s[2 * sw + 1][1], s[2 * sw + 1][2], s[2 * sw + 1][3]);
#pragma unroll
                for (int c = 0; c < 4; ++c) { const LAS char* vp = wvl + (32 * s4 + 4 * quad + (l15 >> 2)) * 128 + (16 * c + 4 * (l15 & 3)) * 2;
                    o[c] = MFMA16(tr_frag(vp, vp + 16 * 128), pf, o[c]); } }
        }
#undef NA_LOADV
#undef NA_STOREV
        bf16* op = O + tq * OP + 64 * h + 4 * quad;
#pragma unroll
        for (int c = 0; c < 4; ++c) { v2u w; w.x = pk2(o[c][0] * inv, o[c][1] * inv); w.y = pk2(o[c][2] * inv, o[c][3] * inv); *(v2u*)(op + 16 * c) = w; }
    }
    LDS_WAIT();
}

__device__ __forceinline__ void mla_prep_phase(const Args& a, int l, const bf16* Z, bf16* QR, const bf16* KVR, bf16* KF, const int wv) {
    const int tid = opaque_tid_w(wv), lane = tid & 63, wave = __builtin_amdgcn_readfirstlane(tid >> 6), gw = blockIdx.x * NWAVES + wave, NGW = gridDim.x * NWAVES;
    const float* qn = kin(19) + l * 192; const float* kn = kin(20) + l * 192;
    const float gq0 = qn[2 * lane], gq1 = qn[2 * lane + 1], gq2 = qn[128 + lane];
    const float gk0 = kn[2 * lane], gk1 = kn[2 * lane + 1], gk2 = kn[128 + lane];
    const float inv_freq = exp2f(-(float)(lane & 31) * (13.287712379549449f / 32.0f));
    const float qs = 0.07216878364870322f * LOG2E;
    for (int m0 = gw; m0 < M; m0 += 2 * NGW) {
        unsigned qw[2][4], kw[2][4]; float qrp[2][4], krp[2], sn[2], cs[2];
#pragma unroll
        for (int t = 0; t < 2; ++t) { const int m = m0 + t * NGW;
            krp[t] = bf2f(Z[(size_t)m * ZP + ZKR + lane]);
#pragma unroll
            for (int h = 0; h < 4; ++h) { const bf16* qp = QR + (size_t)m * 768 + 192 * h; qw[t][h] = *(const unsigned*)(qp + 2 * lane); qrp[t][h] = bf2f(qp[128 + lane]);
                kw[t][h] = *(const unsigned*)(KVR + (size_t)m * 1024 + 256 * h + 2 * lane); }
            sincosf((float)(m & (SEQ - 1)) * inv_freq, &sn[t], &cs[t]); }
        float sq[2][4], sk[2][4];
#pragma unroll
        for (int t = 0; t < 2; ++t)
#pragma unroll
            for (int h = 0; h < 4; ++h) { const float a0 = pg8::bflo(qw[t][h]), a1 = pg8::bfhi(qw[t][h]), b0 = pg8::bflo(kw[t][h]), b1 = pg8::bfhi(kw[t][h]);
                sq[t][h] = a0 * a0 + a1 * a1 + qrp[t][h] * qrp[t][h]; sk[t][h] = b0 * b0 + b1 * b1 + krp[t] * krp[t]; }
#pragma unroll
        for (int o = 1; o < 64; o <<= 1)
#pragma unroll
            for (int t = 0; t < 2; ++t)
#pragma unroll
                for (int h = 0; h < 4; ++h) { sq[t][h] += pg8::sx(sq[t][h], o, lane); sk[t][h] += pg8::sx(sk[t][h], o, lane); }
#pragma unroll
        for (int t = 0; t < 2; ++t) { const int m = m0 + t * NGW;
#pragma unroll
            for (int h = 0; h < 4; ++h) {
                { bf16* qp = QR + (size_t)m * 768 + 192 * h; const float r = 1.0f / sqrtf(sq[t][h] * (1.0f / 192.0f) + EPS);
                  const float x = qrp[t][h] * r * gq2, y = pg8::sx(x, 32, lane); const float ro = (lane < 32) ? (x * cs[t] - y * sn[t]) : (y * sn[t] + x * cs[t]);
                  *(unsigned*)(qp + 2 * lane) = pk2(pg8::bflo(qw[t][h]) * r * gq0 * qs, pg8::bfhi(qw[t][h]) * r * gq1 * qs); qp[128 + lane] = f2bf(ro * qs); }
                { bf16* ko = KF + (size_t)m * 768 + 192 * h; const float r = 1.0f / sqrtf(sk[t][h] * (1.0f / 192.0f) + EPS);
                  const float x = krp[t] * r * gk2, y = pg8::sx(x, 32, lane); const float ro = (lane < 32) ? (x * cs[t] - y * sn[t]) : (y * sn[t] + x * cs[t]);
                  *(unsigned*)(ko + 2 * lane) = pk2(pg8::bflo(kw[t][h]) * r * gk0, pg8::bfhi(kw[t][h]) * r * gk1); ko[128 + lane] = f2bf(ro); } } }
    }
}

constexpr int MK_P = 400, MV_P = 288, MK_BYTES = 64 * MK_P, MV_BYTES = 64 * MV_P, MV_OFF = 2 * MK_BYTES;
__device__ __forceinline__ void mla_attn_unit(LAS unsigned char* lds_u, const bf16* QF, const bf16* KF, const bf16* KVR, bf16* Z, int b, int h, int qb, const int wv) {
    LAS char* lds = (LAS char*)lds_u;
    const int tid = opaque_tid_w(wv), lane = tid & 63, wave = __builtin_amdgcn_readfirstlane(tid >> 6), r32 = lane & 31, hi = lane >> 5, i16 = lane & 15, blk = (lane >> 4) & 1;
    const size_t tokb = (size_t)b * SEQ;
    const size_t qtok = tokb + 256 * qb + 32 * wave + r32;
    bf16x8 qf[12];
    { const bf16* qp = QF + qtok * 768 + 192 * h + 8 * hi;
#pragma unroll
      for (int s = 0; s < 12; ++s) qf[s] = *(const bf16x8*)(qp + 16 * s); }
    f32x16 o[4];
#pragma unroll
    for (int c = 0; c < 4; ++c) o[c] = f32x16{};
    float mrun = -1e30f, lrun = 0.f;
    int krow[3], kch[3];
#pragma unroll
    for (int i = 0; i < 3; ++i) { const int id = tid + NTHR * i; krow[i] = id / 24; kch[i] = id - krow[i] * 24; }
    const bf16* kbase = KF + tokb * 768 + 192 * h; const bf16* vbase = KVR + tokb * 1024 + 256 * h + 128;
    v4u kreg[3], vreg[2];
#define MLA_LOAD(t) do { _Pragma("unroll") for (int i = 0; i < 3; ++i) kreg[i] = *(const v4u*)(kbase + (size_t)(64 * (t) + krow[i]) * 768 + 8 * kch[i]); \
        _Pragma("unroll") for (int i = 0; i < 2; ++i) { const int id = tid + NTHR * i; vreg[i] = *(const v4u*)(vbase + (size_t)(64 * (t) + (id >> 4)) * 1024 + 8 * (id & 15)); } } while (0)
#define MLA_STORE(kbuf, vbuf) do { _Pragma("unroll") for (int i = 0; i < 3; ++i) *(LAS v4u*)(lds + (kbuf) * MK_BYTES + krow[i] * MK_P + kch[i] * 16) = kreg[i]; \
        _Pragma("unroll") for (int i = 0; i < 2; ++i) { const int id = tid + NTHR * i; *(LAS v4u*)(lds + MV_OFF + (vbuf) * MV_BYTES + (id >> 4) * MV_P + (id & 15) * 16) = vreg[i]; } } while (0)
#define SB() __builtin_amdgcn_sched_barrier(0)
    bf16x8 fr8[8];
#define MLA_VLD(vb_, j, n) do { const LAS char* vp = (vb_) + (16 * ((n) & 3) + 4 * hi + (i16 >> 2)) * MV_P + (32 * ((n) >> 2) + 16 * blk + 4 * (i16 & 3)) * 2; fr8[j] = tr_frag(vp, vp + 8 * MV_P); } while (0)
#define MLA_PV(vb_) do { _Pragma("unroll") for (int j = 0; j < 8; ++j) MLA_VLD(vb_, j, j); SB(); \
        _Pragma("unroll") for (int n = 0; n < 16; ++n) { o[n >> 2] = MFMA32(fr8[n & 7], pf[n & 3], o[n >> 2]); if (n < 8) MLA_VLD(vb_, n & 7, n + 8); SB(); } } while (0)
    const bool late = wave >= 4;
    bf16x8 pf[4] = {};
    MLA_LOAD(0); MLA_STORE(0, 0);
    __syncthreads();
    int vcur = 0, vprev = 2;
    for (int t = 0; t < 64; ++t) {
        const int cur = t & 1;
        if (t + 1 < 64) MLA_LOAD(t + 1);
        const LAS char* kb = lds + cur * MK_BYTES; const LAS char* vb = lds + MV_OFF + vcur * MV_BYTES;
        if (late && t > 0) MLA_PV(lds + MV_OFF + vprev * MV_BYTES);
        f32x16 p0 = f32x16{}, p1 = f32x16{};
#define MLA_KLD(j, s, half) fr8[j] = *(const LAS bf16x8*)(kb + ((half) * 32 + r32) * MK_P + (16 * (s) + 8 * hi) * 2)
#pragma unroll
        for (int i = 0; i < 4; ++i) { MLA_KLD(2 * i, i, 0); MLA_KLD(2 * i + 1, i, 1); }
        SB();
#pragma unroll
        for (int g = 0; g < 3; ++g)
#pragma unroll
            for (int i = 0; i < 4; ++i) {
                p0 = MFMA32(fr8[2 * i], qf[4 * g + i], p0); if (g < 2) MLA_KLD(2 * i, 4 * (g + 1) + i, 0);
                p1 = MFMA32(fr8[2 * i + 1], qf[4 * g + i], p1); if (g < 2) MLA_KLD(2 * i + 1, 4 * (g + 1) + i, 1);
                SB(); }
#undef MLA_KLD
        float mx = fmaxf(p0[0], p1[0]);
#pragma unroll
        for (int r = 1; r < 16; ++r) mx = fmaxf(mx, fmaxf(p0[r], p1[r]));
        mx = fmaxf(mx, pg8::sx(mx, 32, lane));
        if (__any(mx > mrun)) {
            const float mn_ = fmaxf(mrun, mx), f = __builtin_amdgcn_exp2f(mrun - mn_); mrun = mn_; lrun *= f;
#pragma unroll
            for (int c = 0; c < 4; ++c)
#pragma unroll
                for (int r = 0; r < 16; ++r) o[c][r] *= f;
        }
        const float mn = mrun;
        float ls = 0.f;
#pragma unroll
        for (int r = 0; r < 16; ++r) { p0[r] = __builtin_amdgcn_exp2f(p0[r] - mn); p1[r] = __builtin_amdgcn_exp2f(p1[r] - mn); ls += p0[r] + p1[r]; }
        lrun += ls;
        pf[0] = pack8(p0[0], p0[1], p0[2], p0[3], p0[4], p0[5], p0[6], p0[7]); pf[1] = pack8(p0[8], p0[9], p0[10], p0[11], p0[12], p0[13], p0[14], p0[15]);
        pf[2] = pack8(p1[0], p1[1], p1[2], p1[3], p1[4], p1[5], p1[6], p1[7]); pf[3] = pack8(p1[8], p1[9], p1[10], p1[11], p1[12], p1[13], p1[14], p1[15]);
        if (!late) MLA_PV(vb);
        const int vnext = (vcur == 2) ? 0 : vcur + 1;
        if (t + 1 < 64) MLA_STORE(cur ^ 1, vnext);
        vprev = vcur; vcur = vnext;
        __syncthreads();
    }
    if (late) MLA_PV(lds + MV_OFF + vprev * MV_BYTES);
#undef MLA_LOAD
#undef MLA_STORE
#undef MLA_PV
#undef MLA_VLD
#undef SB
    lrun += pg8::sx(lrun, 32, lane);
    const float inv = 1.0f / lrun;
    bf16* op = Z + qtok * ZP + ZCQ + 128 * h + 4 * hi;
#pragma unroll
    for (int c = 0; c < 4; ++c)
#pragma unroll
        for (int g4 = 0; g4 < 4; ++g4) { v2u w; w.x = pk2(o[c][4 * g4] * inv, o[c][4 * g4 + 1] * inv); w.y = pk2(o[c][4 * g4 + 2] * inv, o[c][4 * g4 + 3] * inv);
            *(v2u*)(op + 32 * c + 8 * g4) = w; }
}

__device__ __forceinline__ void zero_f32(float* p, int n, const int wv) { const int t0 = opaque_s(blockIdx.x) * NTHR + opaque_tid_w(wv); for (int i = t0; i < n; i += gridDim.x * NTHR) __hip_atomic_store((unsigned*)p + i, 0u, __ATOMIC_RELAXED, __HIP_MEMORY_SCOPE_AGENT); }
#ifndef DUP_MASK
#define DUP_MASK 0
#endif
#ifndef PH_MASK
#define PH_MASK 0xFFFF
#endif
#if DUP_MASK & 8
#define GSYNC() do { xcd_barrier(xbar, leader); xcd_barrier(xbar, leader); } while (0)
#else
#define GSYNC() xcd_barrier(xbar, leader)
#endif
__global__ void __launch_bounds__(NTHR, 2) mega_fwd(Args a) {
    extern __shared__ __attribute__((aligned(16))) unsigned char lds_raw[];
    LAS unsigned char* lds = (LAS unsigned char*)lds_raw;
    cg::grid_group grid = cg::this_grid();
    const int wv = __builtin_amdgcn_readfirstlane((int)threadIdx.x >> 6);
    const bool leader = (threadIdx.x == 0);
    if (threadIdx.x < 2) ((volatile LAS unsigned*)(lds + 131072))[threadIdx.x] = 0u;
    __syncthreads();
    XcdBarrier xbar; xbar.bar = (unsigned*)((unsigned char*)kin(30)); xbar.x = xb_xcc_id(); xbar.st = (volatile LAS unsigned*)(lds + 131072);
    if (blockIdx.x == 0) for (int i = threadIdx.x; i < 4096; i += NTHR) __hip_atomic_store(xbar.bar + i, 0u, __ATOMIC_RELAXED, __HIP_MEMORY_SCOPE_AGENT);
    const int G = gridDim.x, bx = blockIdx.x;
    const int vcu = (G % 8 == 0) ? (bx % 8) * (G / 8) + bx / 8 : bx;
#define ws ((unsigned char*)kin(30))
#define XB ((bf16*)(ws + WS_XN))
#define MIXB ((bf16*)(ws + WS_QR))
#define Z ((bf16*)(ws + WS_Z))
#define Hb ((bf16*)(ws + WS_Z))
#define SSa ((unsigned*)(ws + WS_PS))
#define SSb (SSa + M)
#define SSc (SSa + 2 * M)
#define QR ((bf16*)(ws + WS_QR))
#define KVR ((bf16*)(ws + WS_KVR))
#define KF ((bf16*)(ws + WS_KF))
#define U ((float*)(ws + WS_U))
#define MIXF ((float*)(ws + WS_U))
#define Dd ((float*)(ws + WS_DD))
#define wt (ws + WS_WT)
#define out ((float*)kin(29))
#ifdef TSEL_MASK
    unsigned long long tacc = 0, tprev = __builtin_amdgcn_s_memrealtime();
#endif
    for (int step = 0; step < DEPTH * 12; ++step) {
        const int l = step / 12, ph = step - l * 12;
        const float* xin = (l == 0) ? kin(0) : out;
        switch (ph) {
        case 0: {
#if (PH_MASK >> 0) & 1
        if (l == 0) { convert_set(a, l, lds, wv, 0x80Bu  , opaque_s(bx) * NWAVES + wv, G * NWAVES, true);
                      xprep_phase(kin(0), XB, SSc, wv); zero_f32((float*)SSa, 2 * M, wv); }
#endif
        } break;
        case 1: case 10: {
#if (PH_MASK >> 1) & 1
        { const bool second = (ph == 10);
          pg8::Gemm g{XB, (const bf16*)(wt + (second ? WT_13B : WT_13A)), M, 2 * FF, DM, DM, DM}; pg8::StaticOrder S; S.init(M, 2 * FF, opaque_s(G), opaque_s(bx));
          pg8::EpiSwiGLU E{Hb, FF, second ? SSb : SSc}; pg8::gemm_phase<pg8::EpiSwiGLU, pg8::StaticOrder, true, true>(lds, g, S, E, wv);
#if DUP_MASK & 1
          __syncthreads(); pg8::gemm_phase<pg8::EpiSwiGLU, pg8::StaticOrder, true, true>(lds, g, S, E, wv);
#endif
          __syncthreads();
          convert_tail(a, l, lds, wv, second ? 0x1000u   : 0x404u  , (M / 256) * (2 * FF / 256));
          if (second && l + 1 < DEPTH) convert_tail(a, l + 1, lds, wv, 0x001u  , (M / 256) * (2 * FF / 256));
        }
#endif
        } break;
        case 2: case 9: case 11: {
#if (PH_MASK >> 2) & 1
        { const bool isout = (ph == 9);
          const bf16* Ap = isout ? MIXB : Hb; const size_t wo = isout ? WT_OUT : (ph == 2 ? WT_2A : WT_2B); const int Kd = isout ? DM : FF;
          pg8::Gemm g{Ap, (const bf16*)(wt + wo), M, DM, Kd, Kd, Kd}; pg8::StaticOrder S; S.init(M, DM, opaque_s(G), opaque_s(bx));
          unsigned* SSp = SSa + (isout ? M : (ph == 2 ? 0 : 2 * M));
          pg8::EpiResid E{(ph == 2) ? xin : (const float*)out, out, DM, isout ? 1.0f : 0.5f, XB, SSp}; pg8::gemm_phase<pg8::EpiResid, pg8::StaticOrder, true, true>(lds, g, S, E, wv); }
        if (ph == 11 && l + 1 < DEPTH) {
            __syncthreads();
            convert_set(a, l + 1, lds, wv, 0x80Au, opaque_s(bx) * NWAVES + wv, G * NWAVES, true);
        }
#endif
        } break;
        case 3: {
#if (PH_MASK >> 4) & 1
        { pg8::Gemm g{XB, (const bf16*)(wt + WT_IN), M, ZP, DM, DM, DM}; pg8::StaticOrder S; S.init(M, ZP, opaque_s(G), opaque_s(bx));
          pg8::EpiBf16<true> E{Z, ZP, SSa}; pg8::gemm_phase<pg8::EpiBf16<true>, pg8::StaticOrder, true, true>(lds, g, S, E, wv); }
        __syncthreads();
        convert_tail(a, l, lds, wv, 0x3F0u  , (M / 256) * (ZP / 256));
#endif
        } break;
        case 4: {
#if (PH_MASK >> 5) & 1
        zero_f32((float*)SSa, 3 * M, wv);
        token_prep_phase(a, l, Z, wv);
        for (int it = opaque_s(bx); it < 1024; it += G) gla_item(a, l, 0, it >> 8, (it >> 6) & 3, it & 63, Z, U, (const bf16*)XB, Dd, lds, wv);
#if DUP_MASK & 32
        for (int it = opaque_s(bx); it < 1024; it += G) gla_item(a, l, 0, it >> 8, (it >> 6) & 3, it & 63, Z, U, (const bf16*)XB, Dd, lds, wv);
#endif
#endif
        } break;
        case 5: {
#if (PH_MASK >> 6) & 1
        { pg8::Gemm g{Z, (const bf16*)(wt + WT_UQ), M, 1792, 256, ZP, 256}; pg8::MlaUpOrder S; S.init(M, 1792, opaque_s(G), opaque_s(bx)); S.acq = ZCQ; S.ackv = ZCKV;
          pg8::EpiMlaUp E{QR, KVR}; pg8::gemm_phase<pg8::EpiMlaUp, pg8::MlaUpOrder, true, true>(lds, g, S, E, wv); }
        __syncthreads();
        for (int st = 0; st < 2; ++st) {
            if ((st == 0) == (wv < 4)) gla_scan_phase(U, (bf16*)XB, Dd, wv);
            else na_phase(a, l, Z, lds, Z + ZQ_NA, ZP, wv);
        }
#endif
        } break;
        case 6: {
#if (PH_MASK >> 7) & 1
        for (int st = 0; st < 2; ++st) {
            if ((st == 0) == ((opaque_s(bx) & 1) == 0)) mla_prep_phase(a, l, Z, QR, KVR, KF, wv);
            else for (int it = opaque_s(bx); it < 1024; it += G) gla_item(a, l, 1, it >> 8, (it >> 6) & 3, it & 63, Z, U, (const bf16*)XB, Dd, lds, wv);
            __syncthreads();
        }
#endif
        } break;
        case 7: {
#if (PH_MASK >> 8) & 1
        for (int u = opaque_s(vcu); u < 256; u += G) { mla_attn_unit(lds, QR, KF, KVR, Z, (u >> 4) >> 2, (u >> 4) & 3, u & 15, wv); __syncthreads(); }
#if DUP_MASK & 2
        for (int u = opaque_s(vcu); u < 256; u += G) { mla_attn_unit(lds, QR, KF, KVR, Z, (u >> 4) >> 2, (u >> 4) & 3, u & 15, wv); __syncthreads(); }
#endif
#endif
        } break;
        case 8: {
#if (PH_MASK >> 9) & 1
        { pg8::Gemm g{Z, (const bf16*)(wt + WT_BR), M, 1024, 512, ZP, 512}; pg8::MergeOrder S{opaque_s(G), opaque_s(vcu), ZQ_NA, ZGV, ZCQ};
          pg8::EpiMerge E{Z, ZP, ZGATE, MIXB}; pg8::gemm_phase<pg8::EpiMerge, pg8::MergeOrder, true, true>(lds, g, S, E, wv); }
#endif
        } break;
        default: break;
        }
        if (ph == 0 && l > 0) continue;
        if (step == 0) { grid.sync(); if (leader) (void)xb_add(&xbar.bar[XB_XCNT(xbar.x)], 1u); }
        else GSYNC();
#ifdef TSEL_MASK
        { const unsigned long long tnow = __builtin_amdgcn_s_memrealtime(); if ((TSEL_MASK >> ph) & 1) tacc += tnow - tprev; tprev = tnow; }
#endif
    }
#ifdef TSEL_MASK
    if (blockIdx.x == 0) { const unsigned long long t0 = __builtin_amdgcn_s_memrealtime(); while (__builtin_amdgcn_s_memrealtime() - t0 < 9ull * tacc) __builtin_amdgcn_s_sleep(8); }
#endif
}

#undef ws
#undef XB
#undef MIXB
#undef Z
#undef Hb
#undef SSa
#undef SSb
#undef SSc
#undef QR
#undef KVR
#undef KF
#undef U
#undef MIXF
#undef Dd
#undef wt
#undef out
extern "C" void kernel_launch(void* const* d_in, const int* in_sizes, int n_in, void* d_out, int out_size, void* d_ws, size_t ws_size, hipStream_t stream) {
    static int grid = 0;
    if (grid == 0) {
        if (n_in != 29 || out_size != M * DM || ws_size < WS_END) { fprintf(stderr, "kernel_launch: unexpected shapes / workspace (%d inputs, out %d, ws %zu)\n", n_in, out_size, ws_size); grid = -1; return; }
        int dev = 0, cus = 0, per_cu = 0;
        (void)hipGetDevice(&dev); (void)hipDeviceGetAttribute(&cus, hipDeviceAttributeMultiprocessorCount, dev);
        (void)hipFuncSetAttribute((const void*)mega_fwd, hipFuncAttributeMaxDynamicSharedMemorySize, LDS_BYTES);
        if (hipOccupancyMaxActiveBlocksPerMultiprocessor(&per_cu, (const void*)mega_fwd, NTHR, LDS_BYTES) != hipSuccess || per_cu < 1) per_cu = 1;
        (void)hipGetLastError();
        grid = cus * per_cu; if (grid > 256) grid = 256;
        if (grid <= 0) grid = 256;
    }
    if (grid < 0) return;
    Args a{};
    for (int i = 0; i < 29; ++i) a.in[i] = (const float*)d_in[i];
    a.out = (float*)d_out; a.ws = (unsigned char*)d_ws;
    void* args[] = {&a};
    hipError_t e = hipLaunchCooperativeKernel((const void*)mega_fwd, dim3(grid), dim3(NTHR), args, LDS_BYTES, stream);
    if (e != hipSuccess) fprintf(stderr, "cooperative launch failed: %s (grid %d)\n", hipGetErrorString(e), grid);
}
```
